# Optimizing an MI355X kernel written in HIP

```python
import math
import jax, jax.numpy as jnp
from jax import lax
import numpy as np

D_MODEL = 2048
BATCH = 2
SEQ = 4096
DEPTH = 1

ATTN_HEADS = 16
HEAD_DIM = 64
ATTN_WIDTH = ATTN_HEADS * HEAD_DIM
SSM_GROUP_CH = 16
SSM_GROUPS = 64
SSM_WIDTH = SSM_GROUPS * SSM_GROUP_CH
SSM_STATE = 64
MIX_WIDTH = ATTN_WIDTH + SSM_WIDTH
IN_COLS = 3 * ATTN_WIDTH + SSM_WIDTH
MOBA_BLOCK = 256
MOBA_TOP_K = 3
Q_CHUNK = 128
NUM_BUCKETS = 32
MAX_DISTANCE = 128
D_FF = 5632
CONV_WIDTH = 3
RMS_EPS = 1e-6
DT_MIN = 0.001
DT_MAX = 0.1

kernel_name = "hymba_moba_s5_convffn"


def rms_norm(x, g):
    xf = x.astype(jnp.float32)
    y = xf * lax.rsqrt(jnp.mean(xf * xf, axis=-1, keepdims=True) + RMS_EPS)
    return (y * g.astype(jnp.float32)).astype(x.dtype)


def t5_bucket(dist):
    dist = jnp.maximum(dist, 0)
    max_exact = NUM_BUCKETS // 2
    log_ratio = jnp.log(jnp.maximum(dist, max_exact).astype(jnp.float32) / max_exact)
    large = max_exact + (log_ratio / math.log(MAX_DISTANCE / max_exact)
                         * (NUM_BUCKETS - max_exact)).astype(jnp.int32)
    large = jnp.minimum(large, NUM_BUCKETS - 1)
    return jnp.where(dist < max_exact, dist, large)


def moba_attention(q, k, v, bias_table):
    b_sz, n_h, seq, dh = q.shape
    l_pad = -(-seq // MOBA_BLOCK) * MOBA_BLOCK
    pad = ((0, 0), (0, 0), (0, l_pad - seq), (0, 0))
    q, k, v = jnp.pad(q, pad), jnp.pad(k, pad), jnp.pad(v, pad)
    n_blocks = l_pad // MOBA_BLOCK
    k_sel = min(MOBA_TOP_K, n_blocks)
    kb = k.reshape(b_sz, n_h, n_blocks, MOBA_BLOCK, dh)
    vb = v.reshape(b_sz, n_h, n_blocks, MOBA_BLOCK, dh)
    k_mean = jnp.mean(kb.astype(jnp.float32), axis=3)
    n_chunks = l_pad // Q_CHUNK
    q_chunks = q.reshape(b_sz, n_h, n_chunks, Q_CHUNK, dh).transpose(2, 0, 1, 3, 4)
    bias_t = bias_table.astype(jnp.float32).T
    b_ix = jnp.arange(b_sz)[:, None, None]
    h_ix = jnp.arange(n_h)[None, :, None]
    key_off = jnp.arange(MOBA_BLOCK)
    scale = dh ** -0.5

    def one_chunk(args):
        c, q_c = args
        q_pos = c * Q_CHUNK + jnp.arange(Q_CHUNK)
        own = (c * Q_CHUNK) // MOBA_BLOCK
        gate = jnp.einsum('bhqd,bhnd->bhqn', q_c.astype(jnp.float32), k_mean)
        gate = jnp.where(jnp.arange(n_blocks) < own, gate, -jnp.inf)
        _, sel = lax.top_k(gate, k_sel)
        logits = []
        for s in range(k_sel):
            blk = sel[..., s]
            k_s = kb[b_ix, h_ix, blk]
            lg = jnp.einsum('bhqd,bhqkd->bhqk', q_c, k_s).astype(jnp.float32) * scale
            k_pos = blk[..., None] * MOBA_BLOCK + key_off
            lg = lg + bias_t[h_ix[..., None], t5_bucket(q_pos[:, None] - k_pos)]
            logits.append(jnp.where(s < own, lg, -jnp.inf))
        k_own = lax.dynamic_index_in_dim(kb, own, axis=2, keepdims=False)
        v_own = lax.dynamic_index_in_dim(vb, own, axis=2, keepdims=False)
        rel = q_pos[:, None] - (own * MOBA_BLOCK + key_off)[None, :]
        lg_own = (jnp.einsum('bhqd,bhkd->bhqk', q_c, k_own).astype(jnp.float32) * scale
                  + bias_t[:, t5_bucket(rel)])
        logits.append(jnp.where(rel >= 0, lg_own, -jnp.inf))
        probs = jax.nn.softmax(jnp.concatenate(logits, axis=-1), axis=-1).astype(v.dtype)
        out = jnp.einsum('bhqk,bhkd->bhqd', probs[..., k_sel * MOBA_BLOCK:], v_own)
        for s in range(k_sel):
            v_s = vb[b_ix, h_ix, sel[..., s]]
            out = out + jnp.einsum('bhqk,bhqkd->bhqd',
                                   probs[..., s * MOBA_BLOCK:(s + 1) * MOBA_BLOCK], v_s)
        return out

    out = lax.map(one_chunk, (jnp.arange(n_chunks), q_chunks))
    out = out.transpose(1, 2, 0, 3, 4).reshape(b_sz, n_h, l_pad, dh)
    return out[:, :, :seq]


def s5_branch(u, lam_re, lam_im, log_dt, b_re, b_im, c_re, c_im, d_skip, w_glu, b_glu):
    b_sz, seq, _ = u.shape
    f32 = jnp.float32
    uf = u.astype(f32).reshape(b_sz, seq, SSM_GROUPS, SSM_GROUP_CH)
    lam = lax.complex(lam_re.astype(f32), lam_im.astype(f32))
    dt = jnp.exp(log_dt.astype(f32))[:, None]
    lam_bar = jnp.exp(lam * dt)
    b_bar = ((lam_bar - 1.0) / lam)[..., None] * lax.complex(b_re.astype(f32), b_im.astype(f32))
    bu = lax.complex(jnp.einsum('blgh,gph->blgp', uf, b_bar.real),
                     jnp.einsum('blgh,gph->blgp', uf, b_bar.imag))
    a = jnp.broadcast_to(lam_bar, bu.shape)

    def combine(e1, e2):
        a1, s1 = e1
        a2, s2 = e2
        return a2 * a1, a2 * s1 + s2

    _, states = lax.associative_scan(combine, (a, bu), axis=1)
    y = (jnp.einsum('blgp,ghp->blgh', states.real, c_re.astype(f32))
         - jnp.einsum('blgp,ghp->blgh', states.imag, c_im.astype(f32))
         + d_skip.astype(f32) * uf)
    y = jax.nn.gelu(y.reshape(b_sz, seq, SSM_WIDTH))
    y = y * jax.nn.sigmoid(y @ w_glu.astype(f32) + b_glu.astype(f32))
    return y.astype(u.dtype)


def causal_dwconv(h, w, b):
    seq = h.shape[1]
    hp = jnp.pad(h, ((0, 0), (CONV_WIDTH - 1, 0), (0, 0)))
    out = hp[:, CONV_WIDTH - 1:] * w[CONV_WIDTH - 1] + b
    for j in range(CONV_WIDTH - 1):
        out = out + hp[:, j:j + seq] * w[j]
    return out


def setup_inputs(seed: int = 0) -> dict:
    key = jax.random.key(seed)
    ks = jax.random.split(key, 24)
    nrm = jax.random.normal
    f32 = jnp.float32
    lam_im0 = jnp.pi * jnp.arange(SSM_STATE, dtype=f32)
    return {
        "x": nrm(ks[0], (BATCH, SEQ, D_MODEL), f32),
        "norm_mix": 1.0 + 0.02 * nrm(ks[1], (DEPTH, D_MODEL), f32),
        "w_in": nrm(ks[2], (DEPTH, D_MODEL, IN_COLS), f32) * D_MODEL ** -0.5,
        "rel_bias_table": 0.2 * nrm(ks[3], (NUM_BUCKETS, ATTN_HEADS), f32),
        "ssm_lam_re": -0.5 + 0.01 * nrm(ks[4], (DEPTH, SSM_GROUPS, SSM_STATE), f32),
        "ssm_lam_im": lam_im0 + 0.01 * nrm(ks[5], (DEPTH, SSM_GROUPS, SSM_STATE), f32),
        "ssm_log_dt": jax.random.uniform(ks[6], (DEPTH, SSM_GROUPS), f32,
                                         math.log(DT_MIN), math.log(DT_MAX)),
        "ssm_b_re": nrm(ks[7], (DEPTH, SSM_GROUPS, SSM_STATE, SSM_GROUP_CH), f32) * (2 * SSM_GROUP_CH) ** -0.5,
        "ssm_b_im": nrm(ks[8], (DEPTH, SSM_GROUPS, SSM_STATE, SSM_GROUP_CH), f32) * (2 * SSM_GROUP_CH) ** -0.5,
        "ssm_c_re": nrm(ks[9], (DEPTH, SSM_GROUPS, SSM_GROUP_CH, SSM_STATE), f32) * (2 * SSM_STATE) ** -0.5,
        "ssm_c_im": nrm(ks[10], (DEPTH, SSM_GROUPS, SSM_GROUP_CH, SSM_STATE), f32) * (2 * SSM_STATE) ** -0.5,
        "ssm_d": nrm(ks[11], (DEPTH, SSM_GROUPS, SSM_GROUP_CH), f32),
        "ssm_w_glu": nrm(ks[12], (DEPTH, SSM_WIDTH, SSM_WIDTH), f32) * SSM_WIDTH ** -0.5,
        "ssm_b_glu": 0.01 * nrm(ks[13], (DEPTH, SSM_WIDTH), f32),
        "norm_attn_out": 1.0 + 0.02 * nrm(ks[14], (DEPTH, ATTN_WIDTH), f32),
        "norm_ssm_out": 1.0 + 0.02 * nrm(ks[15], (DEPTH, SSM_WIDTH), f32),
        "w_out": nrm(ks[16], (DEPTH, MIX_WIDTH, D_MODEL), f32) * MIX_WIDTH ** -0.5,
        "norm_ffn": 1.0 + 0.02 * nrm(ks[17], (DEPTH, D_MODEL), f32),
        "w_ffn_up": nrm(ks[18], (DEPTH, D_MODEL, 2 * D_FF), f32) * D_MODEL ** -0.5,
        "ffn_conv_w": nrm(ks[19], (DEPTH, CONV_WIDTH, 2 * D_FF), f32) * CONV_WIDTH ** -0.5,
        "ffn_conv_b": 0.01 * nrm(ks[20], (DEPTH, 2 * D_FF), f32),
        "w_ffn_down": nrm(ks[21], (DEPTH, D_FF, D_MODEL), f32) * D_FF ** -0.5,
        "norm_final": 1.0 + 0.02 * nrm(ks[22], (D_MODEL,), f32),
    }


def reference(x, norm_mix, w_in, rel_bias_table, ssm_lam_re, ssm_lam_im, ssm_log_dt,
              ssm_b_re, ssm_b_im, ssm_c_re, ssm_c_im, ssm_d, ssm_w_glu, ssm_b_glu,
              norm_attn_out, norm_ssm_out, w_out, norm_ffn, w_ffn_up, ffn_conv_w,
              ffn_conv_b, w_ffn_down, norm_final):
    b_sz, seq, _ = x.shape
    for l in range(DEPTH):
        h = rms_norm(x, norm_mix[l])
        proj = h @ w_in[l]
        q, k, v, u = jnp.split(proj, [ATTN_WIDTH, 2 * ATTN_WIDTH, 3 * ATTN_WIDTH], axis=-1)
        to_heads = lambda t: t.reshape(b_sz, seq, ATTN_HEADS, HEAD_DIM).transpose(0, 2, 1, 3)
        attn = moba_attention(to_heads(q), to_heads(k), to_heads(v), rel_bias_table)
        attn = attn.transpose(0, 2, 1, 3).reshape(b_sz, seq, ATTN_WIDTH)
        ssm = s5_branch(u, ssm_lam_re[l], ssm_lam_im[l], ssm_log_dt[l], ssm_b_re[l], ssm_b_im[l],
                        ssm_c_re[l], ssm_c_im[l], ssm_d[l], ssm_w_glu[l], ssm_b_glu[l])
        mixed = jnp.concatenate([rms_norm(attn, norm_attn_out[l]),
                                 rms_norm(ssm, norm_ssm_out[l])], axis=-1)
        x = x + mixed @ w_out[l]
        h = rms_norm(x, norm_ffn[l])
        up = causal_dwconv(h @ w_ffn_up[l], ffn_conv_w[l], ffn_conv_b[l])
        gate, val = jnp.split(up, 2, axis=-1)
        x = x + (jax.nn.silu(gate) * val) @ w_ffn_down[l]
    return rms_norm(x, norm_final)
```

```cpp
#define MK_N_LAUNCHES 11
#include <hip/hip_runtime.h>
#include <cstdio>
#include <cstdint>
namespace pg8 {
#define PG8_LAS __attribute__((address_space(3)))
typedef unsigned short bf16_t;
typedef short bf16x8 __attribute__((ext_vector_type(8)));
typedef float f32x4 __attribute__((ext_vector_type(4)));
typedef unsigned u32x4 __attribute__((ext_vector_type(4)));
constexpr int BM = 256, BK = 64, HALF = 128, HTB = HALF * BK * 2  , STAGE_BYTES = 8 * HTB, NXCD = 8, WGM = 8;

__host__ __device__ __forceinline__ int lds_byte(int r, int c) { const int st = (r >> 4) * 2 + (c >> 5), rr = r & 15, cc = c & 31, ob = rr * 64 + cc * 2; return st * 1024 + (ob ^ (((ob >> 9) & 1) << 5)); }
__host__ __device__ __forceinline__ void stage_rc(int b, int& R, int& C) { const int st = b / 1024, sb = b % 1024, swz = sb ^ (((sb >> 9) & 1) << 5); R = (st >> 1) * 16 + swz / 64; C = (st & 1) * 32 + (swz % 64) / 2; }
__host__ __device__ __forceinline__ int perm32(int rho) { const int n = rho >> 4, i = rho & 15; return 8 * (i >> 2) + 4 * n + (i & 3); }

struct Unit { int pm, pn; };
struct Gemm { const bf16_t* A; const bf16_t* Bt; int M, N, K; };

struct StaticOrder {
    int nM, nN, nwg, G, c;
    __host__ __device__ void init(int M, int N, int G_, int c_) { nM = M / BM; nN = N / BM; nwg = nM * nN; G = G_; c = c_; }
    __host__ __device__ bool next(int i, Unit& u) const {
        const long L = (long)i * G + c; if (L >= nwg) return false;
        int wgid = (int)L; { const int q = nwg / NXCD, r = nwg % NXCD, xcd = wgid % NXCD, off = wgid / NXCD; wgid = (xcd < r ? xcd * (q + 1) : r * (q + 1) + (xcd - r) * q) + off; }
        const int nig = WGM * nN, gid = wgid / nig, fm = gid * WGM, gsz = (nM - fm) < WGM ? (nM - fm) : WGM;
        u.pm = fm + ((wgid % nig) % gsz); u.pn = (wgid % nig) / gsz; return true;
    }
    __device__ __forceinline__ void a_ready(const Unit&) const {}
    __device__ __forceinline__ void done(const Unit&) const {}
};

__device__ __forceinline__ unsigned cvt_pk_bf16(float lo, float hi) { unsigned r; asm volatile("v_cvt_pk_bf16_f32 %0, %1, %2" : "=v"(r) : "v"(lo), "v"(hi)); return r; }
typedef float f32x2 __attribute__((ext_vector_type(2)));
__device__ __forceinline__ f32x2 gelu_pk(f32x2 v) {
    const f32x2 av = __builtin_elementwise_abs(v), d = av * 0.2316418882f + 1.0f;
    f32x2 t; t.x = __builtin_amdgcn_rcpf(d.x); t.y = __builtin_amdgcn_rcpf(d.y);
    f32x2 q = t * 0.5307027145f + (-0.7265760135f); q = q * t + 0.7107068705f; q = q * t + (-0.142248368f); q = q * t + 0.127414796f; q = q * t;
    const f32x2 s = (v * v) * (-0.72134752044f);
    f32x2 e; e.x = __builtin_amdgcn_exp2f(s.x); e.y = __builtin_amdgcn_exp2f(s.y);
    const f32x2 m = v * (q * e), r = v - m;
    f32x2 o; o.x = v.x < 0.f ? m.x : r.x; o.y = v.y < 0.f ? m.y : r.y; return o;
}

template <int ACT  > struct EpiBf16 {
    static constexpr bool PERM = true, AFTER_DRAIN = false; static_assert(ACT == 0 || ACT == 1, "EpiBf16: ACT is 0 (none) or 1 (gelu_pk)");
    bf16_t* O; int ldc; const float* bias; int split_cols; size_t split_stride; float scale0;
    __device__ __forceinline__ void operator()(const f32x4 (&acc)[2][2][4][2], const Unit& u, int wr, int wc, int fr, int fq) const {
        const int row0 = u.pm * BM + wr * 64 + fr; int colt = u.pn * BM; bf16_t* base = O;
        float sc = 1.f; if (split_cols) { const int t = colt / split_cols; base += (size_t)t * split_stride; colt -= t * split_cols; if (t == 0) sc = scale0; }
        const int col0 = colt + wc * 32 + 8 * fq, bcol0 = u.pn * BM + wc * 32 + 8 * fq;
        f32x4 bv[2][2];
#pragma unroll
        for (int bj = 0; bj < 2; ++bj)
#pragma unroll
            for (int n = 0; n < 2; ++n) bv[bj][n] = bias ? *(const f32x4*)(bias + bcol0 + bj * HALF + 4 * n) : (f32x4){0.f, 0.f, 0.f, 0.f};
#pragma unroll
        for (int ai = 0; ai < 2; ++ai)
#pragma unroll
            for (int m = 0; m < 4; ++m) { bf16_t* rowp = base + (size_t)(row0 + ai * HALF + m * 16) * ldc + col0;
#pragma unroll
                for (int bj = 0; bj < 2; ++bj) { f32x4 v0 = acc[ai][bj][m][0] + bv[bj][0], v1 = acc[ai][bj][m][1] + bv[bj][1];
                    if (ACT == 1) { f32x2 a = gelu_pk((f32x2){v0[0], v0[1]}), b = gelu_pk((f32x2){v0[2], v0[3]}), c = gelu_pk((f32x2){v1[0], v1[1]}), d = gelu_pk((f32x2){v1[2], v1[3]});
                        v0 = (f32x4){a.x, a.y, b.x, b.y}; v1 = (f32x4){c.x, c.y, d.x, d.y}; }
                    v0 = v0 * sc; v1 = v1 * sc; u32x4 w; w.x = cvt_pk_bf16(v0[0], v0[1]); w.y = cvt_pk_bf16(v0[2], v0[3]); w.z = cvt_pk_bf16(v1[0], v1[1]); w.w = cvt_pk_bf16(v1[2], v1[3]);
                    *(u32x4*)(rowp + bj * HALF) = w; } }
    }
};

__device__ __forceinline__ float bf_lo(unsigned w) { return __uint_as_float(w << 16); }
__device__ __forceinline__ float bf_hi(unsigned w) { return __uint_as_float(w & 0xffff0000u); }
__device__ __forceinline__ float sigmoid_f(float v) { return __builtin_amdgcn_rcpf(1.0f + __builtin_amdgcn_exp2f(-1.4426950408889634f * v)); }
struct EpiGlu {
    static constexpr bool PERM = true, AFTER_DRAIN = false;
    const bf16_t* Y; bf16_t* Z; int ldc; const float* bias;
    __device__ __forceinline__ void operator()(const f32x4 (&acc)[2][2][4][2], const Unit& u, int wr, int wc, int fr, int fq) const {
        const int row0 = u.pm * BM + wr * 64 + fr, col0 = u.pn * BM + wc * 32 + 8 * fq;
        f32x4 bv[2][2];
#pragma unroll
        for (int bj = 0; bj < 2; ++bj)
#pragma unroll
            for (int n = 0; n < 2; ++n) bv[bj][n] = *(const f32x4*)(bias + col0 + bj * HALF + 4 * n);
#pragma unroll
        for (int ai = 0; ai < 2; ++ai)
#pragma unroll
            for (int m = 0; m < 4; ++m) { const size_t off = (size_t)(row0 + ai * HALF + m * 16) * ldc + col0;
#pragma unroll
                for (int bj = 0; bj < 2; ++bj) { const u32x4 yv = *(const u32x4*)(Y + off + bj * HALF);
                    const f32x4 v0 = acc[ai][bj][m][0] + bv[bj][0], v1 = acc[ai][bj][m][1] + bv[bj][1];
                    u32x4 w;
                    w.x = cvt_pk_bf16(bf_lo(yv.x) * sigmoid_f(v0[0]), bf_hi(yv.x) * sigmoid_f(v0[1]));
                    w.y = cvt_pk_bf16(bf_lo(yv.y) * sigmoid_f(v0[2]), bf_hi(yv.y) * sigmoid_f(v0[3]));
                    w.z = cvt_pk_bf16(bf_lo(yv.z) * sigmoid_f(v1[0]), bf_hi(yv.z) * sigmoid_f(v1[1]));
                    w.w = cvt_pk_bf16(bf_lo(yv.w) * sigmoid_f(v1[2]), bf_hi(yv.w) * sigmoid_f(v1[3]));
                    *(u32x4*)(Z + off + bj * HALF) = w; } }
    }
};
struct EpiResid1 {
    static constexpr bool PERM = true, AFTER_DRAIN = false;
    const float* X; float* X1; bf16_t* X1G; const float* gw; float* ssq; int ldc;
    __device__ __forceinline__ void operator()(const f32x4 (&acc)[2][2][4][2], const Unit& u, int wr, int wc, int fr, int fq) const {
        const int row0 = u.pm * BM + wr * 64 + fr, col0 = u.pn * BM + wc * 32 + 8 * fq;
        f32x4 gv[2][2];
#pragma unroll
        for (int bj = 0; bj < 2; ++bj)
#pragma unroll
            for (int n = 0; n < 2; ++n) gv[bj][n] = *(const f32x4*)(gw + col0 + bj * HALF + 4 * n);
#pragma unroll
        for (int ai = 0; ai < 2; ++ai)
#pragma unroll
            for (int m = 0; m < 4; ++m) { const int row = row0 + ai * HALF + m * 16; const size_t off = (size_t)row * ldc + col0; float s = 0.f;
#pragma unroll
                for (int bj = 0; bj < 2; ++bj) {
                    const f32x4 v0 = *(const f32x4*)(X + off + bj * HALF) + acc[ai][bj][m][0], v1 = *(const f32x4*)(X + off + bj * HALF + 4) + acc[ai][bj][m][1];
                    *(f32x4*)(X1 + off + bj * HALF) = v0; *(f32x4*)(X1 + off + bj * HALF + 4) = v1;
                    s += (v0[0] * v0[0] + v0[1] * v0[1]) + (v0[2] * v0[2] + v0[3] * v0[3]) + (v1[0] * v1[0] + v1[1] * v1[1]) + (v1[2] * v1[2] + v1[3] * v1[3]);
                    const f32x4 g0 = v0 * gv[bj][0], g1 = v1 * gv[bj][1]; u32x4 w;
                    w.x = cvt_pk_bf16(g0[0], g0[1]); w.y = cvt_pk_bf16(g0[2], g0[3]); w.z = cvt_pk_bf16(g1[0], g1[1]); w.w = cvt_pk_bf16(g1[2], g1[3]);
                    *(u32x4*)(X1G + off + bj * HALF) = w; }
                s += __shfl_xor(s, 16); s += __shfl_xor(s, 32);
                if (fq == 0) ssq[(size_t)row * 32 + u.pn * 4 + wc] = s; }
    }
};
struct EpiUp {
    static constexpr bool PERM = true, AFTER_DRAIN = false;
    bf16_t* O; int ldc; const float* ssq; float inv_n, eps;
    __device__ __forceinline__ void operator()(const f32x4 (&acc)[2][2][4][2], const Unit& u, int wr, int wc, int fr, int fq) const {
        const int row0 = u.pm * BM + wr * 64 + fr, col0 = u.pn * BM + wc * 32 + 8 * fq;
#pragma unroll
        for (int ai = 0; ai < 2; ++ai)
#pragma unroll
            for (int m = 0; m < 4; ++m) { const int row = row0 + ai * HALF + m * 16; const f32x4* sp = (const f32x4*)(ssq + (size_t)row * 32);
                f32x4 t = sp[0];
#pragma unroll
                for (int k = 1; k < 8; ++k) t += sp[k];
                const float rstd = __builtin_amdgcn_rsqf(((t[0] + t[1]) + (t[2] + t[3])) * inv_n + eps);
                bf16_t* rowp = O + (size_t)row * ldc + col0;
#pragma unroll
                for (int bj = 0; bj < 2; ++bj) { const f32x4 v0 = acc[ai][bj][m][0] * rstd, v1 = acc[ai][bj][m][1] * rstd; u32x4 w;
                    w.x = cvt_pk_bf16(v0[0], v0[1]); w.y = cvt_pk_bf16(v0[2], v0[3]); w.z = cvt_pk_bf16(v1[0], v1[1]); w.w = cvt_pk_bf16(v1[2], v1[3]);
                    *(u32x4*)(rowp + bj * HALF) = w; } }
    }
};
struct EpiResid2 {
    static constexpr bool PERM = true, AFTER_DRAIN = false;
    float* OUT; int ldc;
    __device__ __forceinline__ void operator()(const f32x4 (&acc)[2][2][4][2], const Unit& u, int wr, int wc, int fr, int fq) const {
        const int row0 = u.pm * BM + wr * 64 + fr, col0 = u.pn * BM + wc * 32 + 8 * fq;
#pragma unroll
        for (int ai = 0; ai < 2; ++ai)
#pragma unroll
            for (int m = 0; m < 4; ++m) { float* rowp = OUT + (size_t)(row0 + ai * HALF + m * 16) * ldc + col0;
#pragma unroll
                for (int bj = 0; bj < 2; ++bj) { f32x4* p = (f32x4*)(rowp + bj * HALF); const f32x4 a = p[0], b = p[1]; p[0] = a + acc[ai][bj][m][0]; p[1] = b + acc[ai][bj][m][1]; } }
    }
};
template <class Epi, class Sched, bool ALIGN_EPI = false, bool SP2 = false>
__device__ __forceinline__ void gemm_phase(PG8_LAS unsigned char* lds, const Gemm g, const Sched& S, const Epi& E) {
    const int tid = threadIdx.x, wid = __builtin_amdgcn_readfirstlane(tid >> 6), lane = tid & 63, wr = wid >> 2, wc = wid & 3, fr = lane & 15, fq = lane >> 4;
    const int K = g.K, nt = K / BK;
    unsigned voffA[2], voffB[2];
#pragma unroll
    for (int i = 0; i < 2; ++i) { int R, C; stage_rc(tid * 16 + i * 8192, R, C); const int Rb = Epi::PERM ? ((R & ~31) + perm32(R & 31)) : R;
        voffA[i] = (unsigned)(R * K + C) * 2u; voffB[i] = (unsigned)(Rb * K + C) * 2u; }
    const size_t kstep = (size_t)(BK * 2);
    const size_t hstep = (size_t)HALF * K * 2;
    const size_t tstep = 2 * hstep;
    const unsigned ldsw = (unsigned)wid * 1024u;
    const int aoff = lds_byte(wr * 64 + fr, fq * 8), boff = lds_byte(wc * 32 + fr, fq * 8);
#define PG8_SA(b, h) (((b) * 2 + (h)) * HTB)
#define PG8_SB(b, h) ((4 + (b) * 2 + (h)) * HTB)
#define PG8_STAGE(bufoff, gbase, voff) do { _Pragma("unroll") for (int _i = 0; _i < 2; ++_i) \
        __builtin_amdgcn_global_load_lds((const unsigned*)((const char*)(gbase) + (voff)[_i]), (PG8_LAS unsigned*)(lds + (bufoff) + ldsw + _i * 8192), 16, 0, 0); } while (0)
#define PG8_LDA(dst, b, h) do { _Pragma("unroll") for (int m = 0; m < 4; ++m) _Pragma("unroll") for (int k = 0; k < 2; ++k) dst[m][k] = *(const PG8_LAS bf16x8*)(lds + PG8_SA(b, h) + aoff + m * 2048 + k * 1024); } while (0)
#define PG8_LDB(dst, b, h) do { _Pragma("unroll") for (int n = 0; n < 2; ++n) _Pragma("unroll") for (int k = 0; k < 2; ++k) dst[n][k] = *(const PG8_LAS bf16x8*)(lds + PG8_SB(b, h) + boff + n * 2048 + k * 1024); } while (0)
#define PG8_MMA(ai, bj, At, Bt) do { __builtin_amdgcn_s_setprio(1); _Pragma("unroll") for (int m = 0; m < 4; ++m) _Pragma("unroll") for (int n = 0; n < 2; ++n) _Pragma("unroll") for (int k = 0; k < 2; ++k) \
        acc[ai][bj][m][n] = __builtin_amdgcn_mfma_f32_16x16x32_bf16(Bt[n][k], At[m][k], acc[ai][bj][m][n], 0, 0, 0); __builtin_amdgcn_s_setprio(0); } while (0)
#define PG8_WAIT_V(n) asm volatile("s_waitcnt vmcnt(" #n ")" ::: "memory")
#define PG8_WAIT_L(n) asm volatile("s_waitcnt lgkmcnt(" #n ")" ::: "memory")
#define PG8_BAR __builtin_amdgcn_s_barrier()
#define PG8_SCHED __builtin_amdgcn_sched_barrier(0)
    Unit cur, nxt; int ui = 0;
    if (!S.next(0, cur)) return;
    f32x4 acc[2][2][4][2];
#pragma unroll
    for (int a = 0; a < 2; ++a)
#pragma unroll
        for (int b = 0; b < 2; ++b)
#pragma unroll
            for (int m = 0; m < 4; ++m)
#pragma unroll
                for (int n = 0; n < 2; ++n) acc[a][b][m][n] = (f32x4){0.f, 0.f, 0.f, 0.f};
    bf16x8 At[4][2], B0[2][2], B1[2][2];
    const char* cA = (const char*)g.A + (size_t)cur.pm * tstep; const char* cB = (const char*)g.Bt + (size_t)cur.pn * tstep;
    S.a_ready(cur);
    if constexpr (SP2) {
        PG8_STAGE(PG8_SB(0, 0), cB, voffB); PG8_STAGE(PG8_SB(0, 1), cB + hstep, voffB); PG8_STAGE(PG8_SA(0, 0), cA, voffA); PG8_STAGE(PG8_SA(0, 1), cA + hstep, voffA);
        if (wr == 1) PG8_BAR;
        PG8_WAIT_V(2); PG8_BAR;
        PG8_STAGE(PG8_SB(1, 0), cB + kstep, voffB); PG8_STAGE(PG8_SA(1, 0), cA + kstep, voffA); PG8_STAGE(PG8_SB(1, 1), cB + hstep + kstep, voffB);
        PG8_WAIT_V(6); PG8_BAR;
    } else {
        PG8_STAGE(PG8_SB(0, 0), cB, voffB); PG8_STAGE(PG8_SA(0, 0), cA, voffA); PG8_STAGE(PG8_SB(0, 1), cB + hstep, voffB); PG8_STAGE(PG8_SA(0, 1), cA + hstep, voffA);
        if (wr == 1) PG8_BAR;
        PG8_WAIT_V(4); PG8_BAR;
        PG8_STAGE(PG8_SB(1, 0), cB + kstep, voffB); PG8_STAGE(PG8_SA(1, 0), cA + kstep, voffA); PG8_STAGE(PG8_SB(1, 1), cB + hstep + kstep, voffB);
        PG8_WAIT_V(6); PG8_BAR;
    }
    for (;;) {
        const bool has_next = S.next(ui + 1, nxt);
        const char* nA = has_next ? (const char*)g.A + (size_t)nxt.pm * tstep : cA; const char* nB = has_next ? (const char*)g.Bt + (size_t)nxt.pn * tstep : cB;
        for (int t = 0; t < nt; t += 2) {
            const bool last = (t == nt - 2);
            const char* a1 = cA + (size_t)(t + 1) * kstep;
            const char* a2 = last ? nA : cA + (size_t)(t + 2) * kstep; const char* b2 = last ? nB : cB + (size_t)(t + 2) * kstep;
            const char* a3 = a2 + kstep; const char* b3 = b2 + kstep;
            if (last && has_next) S.a_ready(nxt);
            if constexpr (SP2) {
            PG8_LDB(B0, 0, 0); PG8_LDB(B1, 0, 1); PG8_SCHED; PG8_LDA(At, 0, 0); PG8_STAGE(PG8_SA(1, 1), a1 + hstep, voffA);
            PG8_WAIT_V(8); PG8_WAIT_L(0); PG8_BAR; PG8_MMA(0, 0, At, B0); PG8_MMA(0, 1, At, B1); PG8_BAR; PG8_SCHED;
            PG8_LDA(At, 0, 1); PG8_STAGE(PG8_SB(0, 0), b2, voffB); PG8_STAGE(PG8_SB(0, 1), b2 + hstep, voffB); PG8_STAGE(PG8_SA(0, 0), a2, voffA);
            PG8_WAIT_V(8); PG8_WAIT_L(0); PG8_BAR; PG8_MMA(1, 0, At, B0); PG8_MMA(1, 1, At, B1); PG8_BAR; PG8_SCHED;
            PG8_LDB(B0, 1, 0); PG8_LDB(B1, 1, 1); PG8_SCHED; PG8_LDA(At, 1, 0); PG8_STAGE(PG8_SA(0, 1), a2 + hstep, voffA);
            PG8_WAIT_V(8); PG8_WAIT_L(0); PG8_BAR; PG8_MMA(0, 0, At, B0); PG8_MMA(0, 1, At, B1); PG8_BAR; PG8_SCHED;
            PG8_LDA(At, 1, 1); PG8_STAGE(PG8_SB(1, 0), b3, voffB); PG8_STAGE(PG8_SB(1, 1), b3 + hstep, voffB); PG8_STAGE(PG8_SA(1, 0), a3, voffA);
            PG8_WAIT_V(8); PG8_WAIT_L(0); PG8_BAR; PG8_MMA(1, 0, At, B0); PG8_MMA(1, 1, At, B1); PG8_BAR; PG8_SCHED;
            } else {
            PG8_LDB(B0, 0, 0); PG8_SCHED; PG8_LDA(At, 0, 0); PG8_STAGE(PG8_SA(1, 1), a1 + hstep, voffA);
            PG8_WAIT_L(8); PG8_BAR; PG8_WAIT_L(0); PG8_MMA(0, 0, At, B0); PG8_BAR; PG8_SCHED;
            PG8_LDB(B1, 0, 1); PG8_STAGE(PG8_SB(0, 0), b2, voffB);
            PG8_BAR; PG8_WAIT_L(0); PG8_MMA(0, 1, At, B1); PG8_BAR;
            PG8_LDA(At, 0, 1); PG8_STAGE(PG8_SA(0, 0), a2, voffA);
            PG8_BAR; PG8_WAIT_L(0); PG8_MMA(1, 0, At, B0); PG8_BAR; PG8_SCHED;
            PG8_STAGE(PG8_SB(0, 1), b2 + hstep, voffB);
            PG8_WAIT_V(6); PG8_BAR; PG8_MMA(1, 1, At, B1); PG8_BAR;
            PG8_LDB(B0, 1, 0); PG8_SCHED; PG8_LDA(At, 1, 0); PG8_STAGE(PG8_SA(0, 1), a2 + hstep, voffA);
            PG8_WAIT_L(8); PG8_BAR; PG8_WAIT_L(0); PG8_MMA(0, 0, At, B0); PG8_BAR; PG8_SCHED;
            PG8_LDB(B1, 1, 1); PG8_STAGE(PG8_SB(1, 0), b3, voffB);
            PG8_BAR; PG8_WAIT_L(0); PG8_MMA(0, 1, At, B1); PG8_BAR;
            PG8_LDA(At, 1, 1); PG8_STAGE(PG8_SA(1, 0), a3, voffA);
            PG8_BAR; PG8_WAIT_L(0); PG8_MMA(1, 0, At, B0); PG8_BAR; PG8_SCHED;
            PG8_STAGE(PG8_SB(1, 1), b3 + hstep, voffB);
            PG8_WAIT_V(6); PG8_BAR; PG8_MMA(1, 1, At, B1); PG8_BAR;
            }
        }
        if constexpr (ALIGN_EPI) { if (wr == 0) PG8_BAR; }
        if constexpr (!Epi::AFTER_DRAIN) { E(acc, cur, wr, wc, fr, fq); S.done(cur); }
        if (!has_next) break;
#pragma unroll
        for (int a = 0; a < 2; ++a)
#pragma unroll
            for (int b = 0; b < 2; ++b)
#pragma unroll
                for (int m = 0; m < 4; ++m)
#pragma unroll
                    for (int n = 0; n < 2; ++n) acc[a][b][m][n] = (f32x4){0.f, 0.f, 0.f, 0.f};
        cur = nxt; cA = nA; cB = nB; ++ui;
        if constexpr (ALIGN_EPI) { if (wr == 1) PG8_BAR; }
    }
    PG8_WAIT_V(0);
    if constexpr (!ALIGN_EPI) { if (wr == 0) PG8_BAR; }
    PG8_BAR;
    if constexpr (Epi::AFTER_DRAIN) { E.fused(acc, cur, wr, wc, fr, fq, lds, wid, lane); S.done(cur); }
#undef PG8_SA
#undef PG8_SB
#undef PG8_STAGE
#undef PG8_LDA
#undef PG8_LDB
#undef PG8_MMA
#undef PG8_WAIT_V
#undef PG8_WAIT_L
#undef PG8_BAR
#undef PG8_SCHED
}
}

#ifndef PG8_SP2
#define PG8_SP2 true
#endif
#ifndef PG8_ALIGN
#define PG8_ALIGN true
#endif
#include <cmath>

constexpr int NWAVES = 8;
constexpr int NPH = 11;
#ifndef MK_N_LAUNCHES
#define MK_N_LAUNCHES 1
#endif
constexpr int N_LAUNCHES = MK_N_LAUNCHES;
static_assert(N_LAUNCHES == 1 || N_LAUNCHES == NPH, "MK_N_LAUNCHES is 1 or NPH");

constexpr int BATCH = 2, SEQ = 4096, DM = 2048, M = BATCH * SEQ;
constexpr int AH = 16, HD = 64, AW = AH * HD;
constexpr int SG = 64, SC = 16, SW = SG * SC, SP = 64;
constexpr int INC = 3 * AW + SW;
constexpr int MOBA_BLK = 256, NBLK = SEQ / MOBA_BLK, TOPK = 3;
constexpr int DFF = 5632, DFF2 = 2 * DFF;
constexpr float RMS_EPS = 1e-6f;
constexpr float LOG2E = 1.4426950408889634f;
constexpr float C2 = 0.125f * LOG2E;

constexpr size_t MiB = 1u << 20;
constexpr size_t WS_CTL = 0, CTL_ZERO_BYTES = 1 * MiB;
constexpr size_t WS_WDOWN = 1 * MiB;
constexpr size_t WS_WIN = 23 * MiB;
constexpr size_t WS_WGLU = 39 * MiB;
constexpr size_t WS_WOUT = 41 * MiB;
constexpr size_t WS_WUP = 49 * MiB;
constexpr size_t WS_XN = 93 * MiB;
constexpr size_t WS_Q = 125 * MiB, WS_K = 141 * MiB, WS_V = 157 * MiB, WS_U = 173 * MiB;
constexpr size_t WS_Y = 189 * MiB, WS_Z = 205 * MiB;
constexpr size_t WS_UP = 125 * MiB;
constexpr size_t WS_X1G = 301 * MiB;
constexpr size_t WS_ACT = 23 * MiB;
constexpr size_t WS_SSQ = 333 * MiB;
constexpr size_t WS_KMEAN = 334 * MiB;
constexpr size_t WS_T5B = 335 * MiB;
constexpr size_t WS_END = 336 * MiB;
static_assert(WS_ACT + (size_t)M * DFF * 2 <= WS_Q && WS_UP + (size_t)M * DFF2 * 2 <= WS_X1G && WS_WUP + (size_t)DFF2 * DM * 2 <= WS_XN, "d_ws map");
constexpr int CW_TMO = 0, CW_CODE = 1;
constexpr int CW_BAR = 4096;

constexpr int RING_OFF = 0, RING_BYTES = 131072;
constexpr int LDSCTL_OFF = RING_BYTES, MISC_OFF = LDSCTL_OFF + 320;
constexpr int LDS_BYTES = 147456;
static_assert(MISC_OFF + 128 <= LDS_BYTES, "LDS map");

#define GAS __attribute__((address_space(1)))
#define LAS __attribute__((address_space(3)))
typedef unsigned short bf16;
typedef unsigned v4u __attribute__((ext_vector_type(4)));
typedef float f32x4 __attribute__((ext_vector_type(4)));
typedef short bf16x8 __attribute__((ext_vector_type(8)));
typedef GAS unsigned gu32;
typedef GAS unsigned long long gu64;
#define RLX_AGENT __ATOMIC_RELAXED, __HIP_MEMORY_SCOPE_AGENT
#define LDS_WAIT() asm volatile("s_waitcnt lgkmcnt(0)" ::: "memory")
#define VM_WAIT() asm volatile("s_waitcnt vmcnt(0)" ::: "memory")
__device__ __forceinline__ unsigned long long rt() { return __builtin_amdgcn_s_memrealtime(); }
__device__ __forceinline__ unsigned f2bf(float f) { unsigned u = __builtin_bit_cast(unsigned, f); return (u + 0x7fffu + ((u >> 16) & 1u)) >> 16; }
__device__ __forceinline__ unsigned pk2(float lo, float hi) { return f2bf(lo) | (f2bf(hi) << 16); }

#define XB_TMO      128
#define XB_XCNT(j)  (256  + 64 * (j))
#define XB_XSUB(j)  (1280 + 64 * (j))
#define XB_XGEN(j)  (2304 + 64 * (j))
#define XB_TOP      3328
#define XB_TOPGEN   3392
#define XCD_BAR_WORDS 3456
#define XB_SPIN_CAP (1u << 18)

__device__ __forceinline__ unsigned xb_ld(unsigned* p)              { return __hip_atomic_load(p, __ATOMIC_RELAXED, __HIP_MEMORY_SCOPE_AGENT); }
__device__ __forceinline__ unsigned xb_add(unsigned* p, unsigned v) { return __hip_atomic_fetch_add(p, v, __ATOMIC_RELAXED, __HIP_MEMORY_SCOPE_AGENT); }
__device__ __forceinline__ unsigned xb_xcc_id() { return (unsigned)__builtin_amdgcn_s_getreg((3 << 11) | 20) & 0xFu; }
#define XB_SPIN(cond, bar) do { unsigned _sp = 0; while (cond) { __builtin_amdgcn_s_sleep(1); \
    if ((++_sp & 255u) == 0u) { if (xb_ld(&(bar)[XB_TMO])) break; if (_sp > XB_SPIN_CAP) { atomicAdd(&(bar)[XB_TMO], 1u); break; } } } } while (0)

struct XcdBarrier {
    unsigned* bar; unsigned x;
    volatile LAS unsigned* st;
};

__device__ __forceinline__ XcdBarrier xcd_barrier_post(unsigned* bar, volatile LAS unsigned* st) {
    XcdBarrier b; b.bar = bar; b.x = xb_xcc_id(); b.st = st;
    if (threadIdx.x == 0) (void)xb_add(&bar[XB_XCNT(b.x)], 1u);
    return b;
}
__device__ __forceinline__ void xcd_barrier_complete(unsigned* bar, unsigned x, unsigned& nloc, unsigned& nx) {
    const unsigned G = gridDim.x * gridDim.y * gridDim.z;
    unsigned sum, cnt, mine, sp = 0u;
    for (;;) {
        sum = 0u; cnt = 0u; mine = 0u;
#pragma unroll
        for (unsigned j = 0; j < 16; ++j) { const unsigned c = xb_ld(&bar[XB_XCNT(j)]); sum += c; cnt += (c > 0u) ? 1u : 0u; mine = (j == x) ? c : mine; }
        if (sum == G) break;
        __builtin_amdgcn_s_sleep(1);
        if ((++sp & 255u) == 0u) { if (xb_ld(&bar[XB_TMO])) break; if (sp > XB_SPIN_CAP) { atomicAdd(&bar[XB_TMO], 1u); break; } }
    }
    nloc = mine > 0u ? mine : 1u; nx = cnt > 0u ? cnt : 1u;
}

__device__ __forceinline__ void xcd_barrier(const XcdBarrier& b) {
    asm volatile("s_waitcnt vmcnt(0)" ::: "memory");
    __syncthreads();
    if (threadIdx.x == 0) {
        unsigned* bar = b.bar;
        __builtin_amdgcn_s_waitcnt(0);
        unsigned nloc = b.st[0], nx = b.st[1];
        if (nloc == 0u) { xcd_barrier_complete(bar, b.x, nloc, nx); b.st[0] = nloc; b.st[1] = nx; }
        const unsigned old = xb_add(&bar[XB_XSUB(b.x)], 1u);
        const unsigned gen = old / nloc;
        if (old + 1u == (gen + 1u) * nloc) {
            __builtin_amdgcn_fence(__ATOMIC_RELEASE, "agent");
            asm volatile("s_waitcnt vmcnt(0)" ::: "memory");
            const unsigned og = xb_add(&bar[XB_TOP], 1u);
            const unsigned tg = og / nx;
            if (og + 1u == (tg + 1u) * nx) xb_add(&bar[XB_TOPGEN], 1u);
            else XB_SPIN(xb_ld(&bar[XB_TOPGEN]) == tg, bar);
            __builtin_amdgcn_fence(__ATOMIC_ACQUIRE, "agent");
            xb_add(&bar[XB_XGEN(b.x)], 1u);
            asm volatile("s_waitcnt vmcnt(0)" ::: "memory");
        } else {
            XB_SPIN(xb_ld(&bar[XB_XGEN(b.x)]) == gen, bar);
            __builtin_amdgcn_fence(__ATOMIC_ACQUIRE, "agent");
            asm volatile("s_waitcnt vmcnt(0)" ::: "memory");
        }
    }
    __syncthreads();
}

struct Frame {
    LAS unsigned char* lds;
    volatile LAS unsigned* MISC;
    gu32* ctl;
    int tid, lane, wave;
    int vcu, G;
};
__device__ __forceinline__ float wave_sum(float v) {
#pragma unroll
    for (int o = 1; o < 64; o <<= 1) v += __shfl_xor(v, o);
    return v;
}
__device__ __forceinline__ float wave_max(float v) {
#pragma unroll
    for (int o = 1; o < 64; o <<= 1) v = fmaxf(v, __shfl_xor(v, o));
    return v;
}
__device__ __forceinline__ float bf_lo(unsigned w) { return __uint_as_float(w << 16); }
__device__ __forceinline__ float bf_hi(unsigned w) { return __uint_as_float(w & 0xffff0000u); }
__device__ __forceinline__ float bf2f(bf16 h) { return __uint_as_float((unsigned)h << 16); }

__device__ __forceinline__ void p0_transpose_item(const float* W, int K, int N, bf16* WT, int row_off, LAS float* scr, int item, int lane) {
    const int nblk = N / 32, kb = item / nblk, nb = item % nblk, k0 = 64 * kb, n0 = 32 * nb;
#pragma unroll 8
    for (int i = 0; i < 32; ++i) { const int kk = 2 * i + (lane >> 5); scr[kk * 33 + (lane & 31)] = W[(size_t)(k0 + kk) * N + n0 + (lane & 31)]; }
    LDS_WAIT(); asm volatile("" ::: "memory");
    const int c = lane & 7;
#pragma unroll
    for (int j = 0; j < 4; ++j) { const int n = (lane >> 3) + 8 * j; const LAS float* s = scr + (8 * c) * 33 + n;
        v4u o; o.x = pk2(s[0 * 33], s[1 * 33]); o.y = pk2(s[2 * 33], s[3 * 33]); o.z = pk2(s[4 * 33], s[5 * 33]); o.w = pk2(s[6 * 33], s[7 * 33]);
        *(GAS v4u*)(WT + (size_t)(row_off + n0 + n) * K + k0 + 8 * c) = o; }
    LDS_WAIT(); asm volatile("" ::: "memory");
}
__device__ __forceinline__ void rms_row_to_bf16(int lane, const float* xrow, const float* g, bf16* orow) {
    const GAS f32x4* xr = (const GAS f32x4*)xrow + lane; const GAS f32x4* gr = (const GAS f32x4*)g + lane;
    f32x4 v[8]; float s = 0.f;
#pragma unroll
    for (int j = 0; j < 8; ++j) { v[j] = xr[64 * j]; s += (v[j].x * v[j].x + v[j].y * v[j].y) + (v[j].z * v[j].z + v[j].w * v[j].w); }
    const float rstd = 1.0f / sqrtf(wave_sum(s) * (1.f / DM) + RMS_EPS);
    GAS unsigned long long* o8 = (GAS unsigned long long*)orow + lane;
#pragma unroll
    for (int j = 0; j < 8; ++j) { const f32x4 gg = gr[64 * j]; const f32x4 o = v[j] * rstd * gg;
        o8[64 * j] = (unsigned long long)pk2(o.x, o.y) | ((unsigned long long)pk2(o.z, o.w) << 32); }
}
__device__ __forceinline__ void rms_row1024_bf16(int lane, const bf16* irow, const float* g, bf16* orow) {
    float v[16]; float s = 0.f;
#pragma unroll
    for (int j = 0; j < 2; ++j) { const v4u w = *((const GAS v4u*)irow + lane + 64 * j);
        v[8 * j + 0] = bf_lo(w.x); v[8 * j + 1] = bf_hi(w.x); v[8 * j + 2] = bf_lo(w.y); v[8 * j + 3] = bf_hi(w.y);
        v[8 * j + 4] = bf_lo(w.z); v[8 * j + 5] = bf_hi(w.z); v[8 * j + 6] = bf_lo(w.w); v[8 * j + 7] = bf_hi(w.w); }
#pragma unroll
    for (int k = 0; k < 16; ++k) s += v[k] * v[k];
    const float rstd = 1.0f / sqrtf(wave_sum(s) * (1.f / 1024.f) + RMS_EPS);
#pragma unroll
    for (int j = 0; j < 2; ++j) { const f32x4 g0 = *((const GAS f32x4*)g + 2 * (lane + 64 * j)), g1 = *((const GAS f32x4*)g + 2 * (lane + 64 * j) + 1);
        v4u o; o.x = pk2(v[8 * j + 0] * rstd * g0.x, v[8 * j + 1] * rstd * g0.y); o.y = pk2(v[8 * j + 2] * rstd * g0.z, v[8 * j + 3] * rstd * g0.w);
        o.z = pk2(v[8 * j + 4] * rstd * g1.x, v[8 * j + 5] * rstd * g1.y); o.w = pk2(v[8 * j + 6] * rstd * g1.z, v[8 * j + 7] * rstd * g1.w);
        *((GAS v4u*)orow + lane + 64 * j) = o; }
}
__device__ __forceinline__ int t5_bucket(int dist) {
    if (dist < 16) return dist;
    const float lr = logf((float)dist / 16.0f) / logf(8.0f) * 16.0f;
    int b = 16 + (int)lr; return b < 31 ? b : 31;
}
__device__ __forceinline__ float gelu_tanh(float y) {
    const float u = 0.7978845608028654f * (y + 0.044715f * y * y * y);
    const float e = __builtin_amdgcn_exp2f(2.0f * LOG2E * u);
    const float th = 1.0f - 2.0f * __builtin_amdgcn_rcpf(e + 1.0f);
    return 0.5f * y * (1.0f + th);
}

struct Args { const float* in[23]; float* out; unsigned char* ws; int ph_lo, ph_hi, li, pad; };
__global__ void __launch_bounds__(NWAVES * 64, 2) skel_fwd(Args args) {
    extern __shared__ __attribute__((aligned(16))) unsigned char lds[];
    Frame F;
    F.lds = (LAS unsigned char*)lds;
    F.MISC = (volatile LAS unsigned*)(F.lds + MISC_OFF);
    F.tid = threadIdx.x; F.lane = F.tid & 63; F.wave = __builtin_amdgcn_readfirstlane(F.tid >> 6);
    F.G = gridDim.x; { const int bx = blockIdx.x; F.vcu = (F.G % 8 == 0) ? (bx % 8) * (F.G / 8) + bx / 8 : bx; }
    unsigned char* ws = args.ws;
    F.ctl = (gu32*)(ws + WS_CTL);
    const float* x = args.in[0]; const float* norm_mix = args.in[1]; const float* w_in = args.in[2]; const float* rel_bias = args.in[3];
    const float* lam_re = args.in[4]; const float* lam_im = args.in[5]; const float* log_dt = args.in[6];
    const float* b_re = args.in[7]; const float* b_im = args.in[8]; const float* c_re = args.in[9]; const float* c_im = args.in[10]; const float* d_skip = args.in[11];
    const float* w_glu = args.in[12]; const float* b_glu = args.in[13]; const float* norm_attn = args.in[14]; const float* norm_ssm = args.in[15];
    const float* w_out = args.in[16]; const float* norm_ffn = args.in[17]; const float* w_up = args.in[18]; const float* conv_w = args.in[19]; const float* conv_b = args.in[20];
    const float* w_down = args.in[21]; const float* norm_final = args.in[22];
    float* out = args.out;
    bf16* Wt_in = (bf16*)(ws + WS_WIN); bf16* Wt_glu = (bf16*)(ws + WS_WGLU); bf16* Wt_out = (bf16*)(ws + WS_WOUT); bf16* Wt_up = (bf16*)(ws + WS_WUP); bf16* Wt_down = (bf16*)(ws + WS_WDOWN);
    bf16* XN = (bf16*)(ws + WS_XN); bf16* QB = (bf16*)(ws + WS_Q); bf16* KB = (bf16*)(ws + WS_K); bf16* VB = (bf16*)(ws + WS_V); bf16* UB = (bf16*)(ws + WS_U);
    bf16* YB = (bf16*)(ws + WS_Y); bf16* ZB = (bf16*)(ws + WS_Z); bf16* UPB = (bf16*)(ws + WS_UP); bf16* X1G = (bf16*)(ws + WS_X1G); bf16* ACT = (bf16*)(ws + WS_ACT);
    float* SSQ = (float*)(ws + WS_SSQ); float* KMEAN = (float*)(ws + WS_KMEAN); float* T5B = (float*)(ws + WS_T5B);

    for (int u = F.tid; u < (LDS_BYTES - LDSCTL_OFF) / 4; u += NWAVES * 64) ((LAS unsigned*)(F.lds + LDSCTL_OFF))[u] = 0u;
    __syncthreads();
    XcdBarrier bar; bar.bar = (unsigned*)(F.ctl + CW_BAR); bar.x = 0; bar.st = nullptr;
    if (N_LAUNCHES == 1) bar = xcd_barrier_post((unsigned*)(F.ctl + CW_BAR), F.MISC + 8);
#define GRID_BAR() do { if (N_LAUNCHES == 1) xcd_barrier(bar); } while (0)
    const int lo = args.ph_lo, hi = args.ph_hi;
#define IN(k) (lo <= (k) && (k) < hi)
#define BOTH(k) (IN(k) && IN((k) + 1))
    const int gw = F.vcu * NWAVES + F.wave, NGW = F.G * NWAVES;
    const int gt = gw * 64 + F.lane, NGT = NGW * 64;

    if (IN(0)) {
        LAS float* scr = (LAS float*)(F.lds + RING_OFF + F.wave * 16384);
        constexpr int I_IN = (DM / 64) * (INC / 32), I_GLU = (SW / 64) * (SW / 32), I_OUT = (DM / 64) * (DM / 32), I_UP = (DM / 64) * (DFF2 / 32), I_DN = (DFF / 64) * (DM / 32);
        constexpr int NITEMS = I_IN + I_GLU + I_OUT + I_UP + I_DN;
        for (int it = gw; it < NITEMS; it += NGW) {
            int r = it;
            if (r < I_IN) { p0_transpose_item(w_in, DM, INC, Wt_in, 0, scr, r, F.lane); continue; } r -= I_IN;
            if (r < I_GLU) { p0_transpose_item(w_glu, SW, SW, Wt_glu, 0, scr, r, F.lane); continue; } r -= I_GLU;
            if (r < I_OUT) { p0_transpose_item(w_out, DM, DM, Wt_out, 0, scr, r, F.lane); continue; } r -= I_OUT;
            if (r < I_UP) { p0_transpose_item(w_up, DM, DFF2, Wt_up, 0, scr, r, F.lane); continue; } r -= I_UP;
            p0_transpose_item(w_down, DFF, DM, Wt_down, 0, scr, r, F.lane);
        }
        for (int m = gw; m < M; m += NGW) rms_row_to_bf16(F.lane, x + (size_t)m * DM, norm_mix, XN + (size_t)m * DM);
        for (int i = gt; i < AH * 512; i += NGT) { const int h = i >> 9, d = i & 511; T5B[i] = LOG2E * rel_bias[t5_bucket(d) * AH + h]; }
        if (BOTH(0)) GRID_BAR();
    }

    if (IN(1)) {
        pg8::Gemm g{XN, Wt_in, M, INC, DM}; pg8::StaticOrder S; S.init(M, INC, F.G, (int)blockIdx.x);
        pg8::EpiBf16<0> E{QB, AW, nullptr, AW, (size_t)(WS_K - WS_Q) / 2, C2};
        pg8::gemm_phase<pg8::EpiBf16<0>, pg8::StaticOrder, PG8_ALIGN, PG8_SP2>(F.lds + RING_OFF, g, S, E);
        if (BOTH(1)) GRID_BAR();
    }

    if (IN(2)) {
        for (int it = gw; it < BATCH * AH * NBLK; it += NGW) {
            const int n = it % NBLK, h = (it / NBLK) % AH, b = it / (NBLK * AH);
            const bf16* kp = KB + ((size_t)(b * SEQ + n * MOBA_BLK + (F.lane >> 3))) * AW + h * HD + (F.lane & 7) * 8;
            float a[8];
#pragma unroll
            for (int k = 0; k < 8; ++k) a[k] = 0.f;
            for (int i = 0; i < 32; ++i) { const v4u w = *(const GAS v4u*)(kp + (size_t)i * 8 * AW);
                a[0] += bf_lo(w.x); a[1] += bf_hi(w.x); a[2] += bf_lo(w.y); a[3] += bf_hi(w.y); a[4] += bf_lo(w.z); a[5] += bf_hi(w.z); a[6] += bf_lo(w.w); a[7] += bf_hi(w.w); }
#pragma unroll
            for (int k = 0; k < 8; ++k) { a[k] += __shfl_xor(a[k], 8); a[k] += __shfl_xor(a[k], 16); a[k] += __shfl_xor(a[k], 32); }
            if (F.lane < 8) { float* o = KMEAN + (size_t)it * HD + F.lane * 8;
#pragma unroll
                for (int k = 0; k < 8; ++k) o[k] = a[k] * (1.0f / MOBA_BLK); }
        }
        for (int it = gw; it < BATCH * SG; it += NGW) {
            const int g = it % SG, b = it / SG, p = F.lane;
            const float lr = lam_re[g * SP + p], li = lam_im[g * SP + p], dt = expf(log_dt[g]);
            const float er = expf(lr * dt), lbr = er * cosf(li * dt), lbi = er * sinf(li * dt);
            const float nr = lbr - 1.0f, ni = lbi, den = lr * lr + li * li;
            const float cr_ = (nr * lr + ni * li) / den, ci_ = (ni * lr - nr * li) / den;
            float bbr[16], bbi[16], ccr[16], cci[16];
#pragma unroll
            for (int h = 0; h < 16; ++h) { const float bre = b_re[(size_t)(g * SP + p) * SC + h], bim = b_im[(size_t)(g * SP + p) * SC + h];
                bbr[h] = cr_ * bre - ci_ * bim; bbi[h] = cr_ * bim + ci_ * bre;
                ccr[h] = c_re[(size_t)(g * SC + h) * SP + p]; cci[h] = c_im[(size_t)(g * SC + h) * SP + p]; }
            const float dsk = d_skip[g * SC + (F.lane & 15)];
            float xr = 0.f, xi = 0.f;
            const bf16* up = UB + (size_t)(b * SEQ) * SW + g * SC;
            v4u n0 = *(const GAS v4u*)(up), n1 = *(const GAS v4u*)(up + 8);
            for (int t = 0; t < SEQ; ++t) {
                const v4u c0 = n0, c1 = n1;
                if (t + 1 < SEQ) { n0 = *(const GAS v4u*)(up + (size_t)(t + 1) * SW); n1 = *(const GAS v4u*)(up + (size_t)(t + 1) * SW + 8); }
                float uf[16];
                uf[0] = bf_lo(c0.x); uf[1] = bf_hi(c0.x); uf[2] = bf_lo(c0.y); uf[3] = bf_hi(c0.y); uf[4] = bf_lo(c0.z); uf[5] = bf_hi(c0.z); uf[6] = bf_lo(c0.w); uf[7] = bf_hi(c0.w);
                uf[8] = bf_lo(c1.x); uf[9] = bf_hi(c1.x); uf[10] = bf_lo(c1.y); uf[11] = bf_hi(c1.y); uf[12] = bf_lo(c1.z); uf[13] = bf_hi(c1.z); uf[14] = bf_lo(c1.w); uf[15] = bf_hi(c1.w);
                float bur = 0.f, bui = 0.f;
#pragma unroll
                for (int h = 0; h < 16; ++h) { bur += uf[h] * bbr[h]; bui += uf[h] * bbi[h]; }
                const float nxr = lbr * xr - lbi * xi + bur, nxi = lbr * xi + lbi * xr + bui; xr = nxr; xi = nxi;
                float yv = 0.f;
#pragma unroll
                for (int h = 0; h < 16; ++h) { const float v = wave_sum(xr * ccr[h] - xi * cci[h]); if (F.lane == h) yv = v + dsk * uf[h]; }
                if (F.lane < 16) YB[(size_t)(b * SEQ + t) * SW + g * SC + F.lane] = (bf16)f2bf(gelu_tanh(yv));
            }
        }
        if (BOTH(2)) GRID_BAR();
    }

    if (IN(3)) {
        LAS float* pl = (LAS float*)(F.lds + RING_OFF + F.wave * 4096);
        for (int it = gw; it < BATCH * AH * SEQ; it += NGW) {
            const int qpos = it % SEQ, h = (it / SEQ) % AH, b = it / (SEQ * AH);
            const int own = qpos >> 8;
            const size_t qrow = (size_t)(b * SEQ + qpos) * AW + h * HD;
            float qf[64];
#pragma unroll
            for (int j = 0; j < 8; ++j) { const v4u w = *(const GAS v4u*)(QB + qrow + 8 * j);
                qf[8 * j + 0] = bf_lo(w.x); qf[8 * j + 1] = bf_hi(w.x); qf[8 * j + 2] = bf_lo(w.y); qf[8 * j + 3] = bf_hi(w.y);
                qf[8 * j + 4] = bf_lo(w.z); qf[8 * j + 5] = bf_hi(w.z); qf[8 * j + 6] = bf_lo(w.w); qf[8 * j + 7] = bf_hi(w.w); }
            float gt_ = -INFINITY;
            if (F.lane < own) { const float* km = KMEAN + ((size_t)((b * AH + h) * NBLK + F.lane)) * HD; float a = 0.f;
#pragma unroll
                for (int d = 0; d < 64; ++d) a += qf[d] * km[d];
                gt_ = a; }
            unsigned selmask = 0u; const int ns = own < TOPK ? own : TOPK;
            for (int s = 0; s < ns; ++s) { const float mx = wave_max(gt_); const unsigned long long bal = __ballot(gt_ == mx); const int idx = __ffsll((long long)bal) - 1;
                selmask |= 1u << idx; if (F.lane == idx) gt_ = -INFINITY; }
            int bl[4]; bool va[4]; { unsigned mk = selmask;
#pragma unroll
                for (int s = 0; s < 3; ++s) { va[s] = mk != 0u; bl[s] = va[s] ? (__ffs((int)mk) - 1) : 0; mk &= mk - 1u; } }
            bl[3] = own; va[3] = true;
            float sc[4][4]; float mx = -INFINITY;
#pragma unroll
            for (int s = 0; s < 4; ++s)
#pragma unroll
                for (int j = 0; j < 4; ++j) { const int kpos = bl[s] * MOBA_BLK + j * 64 + F.lane; float v = -INFINITY;
                    if (va[s] && kpos <= qpos) { const bf16* kr = KB + (size_t)(b * SEQ + kpos) * AW + h * HD; float a = 0.f;
#pragma unroll
                        for (int jj = 0; jj < 8; ++jj) { const v4u w = *(const GAS v4u*)(kr + 8 * jj);
                            a += qf[8 * jj + 0] * bf_lo(w.x) + qf[8 * jj + 1] * bf_hi(w.x) + qf[8 * jj + 2] * bf_lo(w.y) + qf[8 * jj + 3] * bf_hi(w.y)
                               + qf[8 * jj + 4] * bf_lo(w.z) + qf[8 * jj + 5] * bf_hi(w.z) + qf[8 * jj + 6] * bf_lo(w.w) + qf[8 * jj + 7] * bf_hi(w.w); }
                        const int dist = qpos - kpos; v = a + T5B[h * 512 + (dist < 511 ? dist : 511)]; }
                    sc[s][j] = v; mx = fmaxf(mx, v); }
            mx = wave_max(mx);
            float l = 0.f;
#pragma unroll
            for (int s = 0; s < 4; ++s)
#pragma unroll
                for (int j = 0; j < 4; ++j) { const float p = __builtin_amdgcn_exp2f(sc[s][j] - mx); l += p; pl[s * 256 + j * 64 + F.lane] = p; }
            l = wave_sum(l);
            LDS_WAIT(); asm volatile("" ::: "memory");
            float o = 0.f;
#pragma unroll
            for (int s = 0; s < 4; ++s) if (va[s]) { const bf16* vp = VB + (size_t)(b * SEQ + bl[s] * MOBA_BLK) * AW + h * HD + F.lane;
                for (int k = 0; k < 256; ++k) o += pl[s * 256 + k] * bf2f(vp[(size_t)k * AW]); }
            LDS_WAIT(); asm volatile("" ::: "memory");
            QB[qrow + F.lane] = (bf16)f2bf(o / l);
        }
        if (BOTH(3)) GRID_BAR();
    }

    if (IN(4)) {
        pg8::Gemm g{YB, Wt_glu, M, SW, SW}; pg8::StaticOrder S; S.init(M, SW, F.G, (int)blockIdx.x);
        pg8::EpiGlu E{YB, ZB, SW, b_glu};
        pg8::gemm_phase<pg8::EpiGlu, pg8::StaticOrder, PG8_ALIGN, PG8_SP2>(F.lds + RING_OFF, g, S, E);
        if (BOTH(4)) GRID_BAR();
    }

    if (IN(5)) {
        for (int m = gw; m < M; m += NGW) {
            rms_row1024_bf16(F.lane, QB + (size_t)m * AW, norm_attn, XN + (size_t)m * DM);
            rms_row1024_bf16(F.lane, ZB + (size_t)m * SW, norm_ssm, XN + (size_t)m * DM + AW);
        }
        if (BOTH(5)) GRID_BAR();
    }

    if (IN(6)) {
        pg8::Gemm g{XN, Wt_out, M, DM, DM}; pg8::StaticOrder S; S.init(M, DM, F.G, (int)blockIdx.x);
        pg8::EpiResid1 E{x, out, X1G, norm_ffn, SSQ, DM};
        pg8::gemm_phase<pg8::EpiResid1, pg8::StaticOrder, PG8_ALIGN, PG8_SP2>(F.lds + RING_OFF, g, S, E);
        if (BOTH(6)) GRID_BAR();
    }

    if (IN(7)) {
        pg8::Gemm g{X1G, Wt_up, M, DFF2, DM}; pg8::StaticOrder S; S.init(M, DFF2, F.G, (int)blockIdx.x);
        pg8::EpiUp E{UPB, DFF2, SSQ, 1.0f / DM, RMS_EPS};
        pg8::gemm_phase<pg8::EpiUp, pg8::StaticOrder, PG8_ALIGN, PG8_SP2>(F.lds + RING_OFF, g, S, E);
        if (BOTH(7)) GRID_BAR();
    }

    if (IN(8)) {
        constexpr int NCC = DFF / 8, RUN = 32, NRUN = M / RUN;
        for (int it = gt; it < NCC * NRUN; it += NGT) {
            const int cc = it % NCC, rr = it / NCC, j0 = cc * 8, r0 = rr * RUN;
            float wg[3][8], wv[3][8], bg[8], bvv[8];
#pragma unroll
            for (int k = 0; k < 3; ++k)
#pragma unroll
                for (int e = 0; e < 8; ++e) { wg[k][e] = conv_w[(size_t)k * DFF2 + j0 + e]; wv[k][e] = conv_w[(size_t)k * DFF2 + DFF + j0 + e]; }
#pragma unroll
            for (int e = 0; e < 8; ++e) { bg[e] = conv_b[j0 + e]; bvv[e] = conv_b[DFF + j0 + e]; }
            float g1[8], g2[8], v1[8], v2[8];
#pragma unroll
            for (int e = 0; e < 8; ++e) { g1[e] = 0.f; g2[e] = 0.f; v1[e] = 0.f; v2[e] = 0.f; }
            if ((r0 % SEQ) != 0) {
                const v4u a1 = *(const GAS v4u*)(UPB + (size_t)(r0 - 1) * DFF2 + j0), a2 = *(const GAS v4u*)(UPB + (size_t)(r0 - 2) * DFF2 + j0);
                const v4u c1 = *(const GAS v4u*)(UPB + (size_t)(r0 - 1) * DFF2 + DFF + j0), c2 = *(const GAS v4u*)(UPB + (size_t)(r0 - 2) * DFF2 + DFF + j0);
                g1[0] = bf_lo(a1.x); g1[1] = bf_hi(a1.x); g1[2] = bf_lo(a1.y); g1[3] = bf_hi(a1.y); g1[4] = bf_lo(a1.z); g1[5] = bf_hi(a1.z); g1[6] = bf_lo(a1.w); g1[7] = bf_hi(a1.w);
                g2[0] = bf_lo(a2.x); g2[1] = bf_hi(a2.x); g2[2] = bf_lo(a2.y); g2[3] = bf_hi(a2.y); g2[4] = bf_lo(a2.z); g2[5] = bf_hi(a2.z); g2[6] = bf_lo(a2.w); g2[7] = bf_hi(a2.w);
                v1[0] = bf_lo(c1.x); v1[1] = bf_hi(c1.x); v1[2] = bf_lo(c1.y); v1[3] = bf_hi(c1.y); v1[4] = bf_lo(c1.z); v1[5] = bf_hi(c1.z); v1[6] = bf_lo(c1.w); v1[7] = bf_hi(c1.w);
                v2[0] = bf_lo(c2.x); v2[1] = bf_hi(c2.x); v2[2] = bf_lo(c2.y); v2[3] = bf_hi(c2.y); v2[4] = bf_lo(c2.z); v2[5] = bf_hi(c2.z); v2[6] = bf_lo(c2.w); v2[7] = bf_hi(c2.w);
            }
            for (int r = r0; r < r0 + RUN; ++r) {
                const v4u a0 = *(const GAS v4u*)(UPB + (size_t)r * DFF2 + j0), c0 = *(const GAS v4u*)(UPB + (size_t)r * DFF2 + DFF + j0);
                float g0[8], v0[8], o[8];
                g0[0] = bf_lo(a0.x); g0[1] = bf_hi(a0.x); g0[2] = bf_lo(a0.y); g0[3] = bf_hi(a0.y); g0[4] = bf_lo(a0.z); g0[5] = bf_hi(a0.z); g0[6] = bf_lo(a0.w); g0[7] = bf_hi(a0.w);
                v0[0] = bf_lo(c0.x); v0[1] = bf_hi(c0.x); v0[2] = bf_lo(c0.y); v0[3] = bf_hi(c0.y); v0[4] = bf_lo(c0.z); v0[5] = bf_hi(c0.z); v0[6] = bf_lo(c0.w); v0[7] = bf_hi(c0.w);
#pragma unroll
                for (int e = 0; e < 8; ++e) {
                    const float cg = g0[e] * wg[2][e] + g1[e] * wg[1][e] + g2[e] * wg[0][e] + bg[e];
                    const float cv = v0[e] * wv[2][e] + v1[e] * wv[1][e] + v2[e] * wv[0][e] + bvv[e];
                    o[e] = cg * __builtin_amdgcn_rcpf(1.0f + __builtin_amdgcn_exp2f(-LOG2E * cg)) * cv;
                    g2[e] = g1[e]; g1[e] = g0[e]; v2[e] = v1[e]; v1[e] = v0[e]; }
                v4u w; w.x = pk2(o[0], o[1]); w.y = pk2(o[2], o[3]); w.z = pk2(o[4], o[5]); w.w = pk2(o[6], o[7]);
                *(GAS v4u*)(ACT + (size_t)r * DFF + j0) = w;
            }
        }
        if (BOTH(8)) GRID_BAR();
    }

    if (IN(9)) {
        pg8::Gemm g{ACT, Wt_down, M, DM, DFF}; pg8::StaticOrder S; S.init(M, DM, F.G, (int)blockIdx.x);
        pg8::EpiResid2 E{out, DM};
        pg8::gemm_phase<pg8::EpiResid2, pg8::StaticOrder, PG8_ALIGN, PG8_SP2>(F.lds + RING_OFF, g, S, E);
        if (BOTH(9)) GRID_BAR();
    }

    if (IN(10)) {
        for (int m = gw; m < M; m += NGW) {
            GAS f32x4* xr = (GAS f32x4*)(out + (size_t)m * DM) + F.lane; const GAS f32x4* gr = (const GAS f32x4*)norm_final + F.lane;
            f32x4 v[8]; float s = 0.f;
#pragma unroll
            for (int j = 0; j < 8; ++j) { v[j] = xr[64 * j]; s += (v[j].x * v[j].x + v[j].y * v[j].y) + (v[j].z * v[j].z + v[j].w * v[j].w); }
            const float rstd = 1.0f / sqrtf(wave_sum(s) * (1.f / DM) + RMS_EPS);
#pragma unroll
            for (int j = 0; j < 8; ++j) xr[64 * j] = v[j] * rstd * gr[64 * j];
        }
    }
#undef IN
#undef BOTH
}

extern "C" void kernel_launch(void* const* d_in, const int* in_sizes, int n_in, void* d_out, int out_size, void* d_ws, size_t ws_size, hipStream_t stream) {
    static int grid = 0;
    if (grid == 0) {
        if (n_in != 23 || in_sizes[0] != M * DM || out_size != M * DM || ws_size < WS_END) { fprintf(stderr, "kernel_launch: unexpected shapes: n_in %d in0 %d out %d ws %zu (need %zu); nothing launched\n", n_in, n_in > 0 ? in_sizes[0] : -1, out_size, ws_size, (size_t)WS_END); grid = -1; return; }
        int dev = 0, cus = 0, per_cu = 0;
        if (hipGetDevice(&dev) != hipSuccess || hipDeviceGetAttribute(&cus, hipDeviceAttributeMultiprocessorCount, dev) != hipSuccess) { fprintf(stderr, "kernel_launch: device query failed\n"); grid = -1; return; }
        if (hipFuncSetAttribute((const void*)skel_fwd, hipFuncAttributeMaxDynamicSharedMemorySize, LDS_BYTES) != hipSuccess) { fprintf(stderr, "kernel_launch: hipFuncSetAttribute failed\n"); grid = -1; return; }
        if (hipOccupancyMaxActiveBlocksPerMultiprocessor(&per_cu, (const void*)skel_fwd, NWAVES * 64, LDS_BYTES) != hipSuccess || per_cu < 1)
            fprintf(stderr, "kernel_launch: note: occupancy query reports %d workgroups per CU\n", per_cu);
        (void)hipGetLastError();
        grid = cus;
    }
    if (grid < 0) return;
    if (hipMemsetAsync((char*)d_ws + WS_CTL, 0, CTL_ZERO_BYTES, stream) != hipSuccess) { fprintf(stderr, "kernel_launch: hipMemsetAsync failed\n"); return; }
    Args a{};
    for (int i = 0; i < 23; ++i) a.in[i] = (const float*)d_in[i];
    a.out = (float*)d_out; a.ws = (unsigned char*)d_ws;
    for (int li = 0; li < N_LAUNCHES; ++li) {
        a.ph_lo = (N_LAUNCHES == 1) ? 0 : li; a.ph_hi = (N_LAUNCHES == 1) ? NPH : li + 1; a.li = li;
        hipLaunchKernelGGL(skel_fwd, dim3(grid), dim3(NWAVES * 64), LDS_BYTES, stream, a);
        const hipError_t le = hipPeekAtLastError();
        if (le != hipSuccess) { fprintf(stderr, "kernel_launch: launch %d failed: %s\n", li, hipGetErrorName(le)); break; }
    }
}
```

```cpp
#include <hip/hip_runtime.h>
#include <cstdio>
#include <cstdint>
namespace pg8 {
#define PG8_LAS __attribute__((address_space(3)))
typedef unsigned short bf16_t;
typedef short bf16x8 __attribute__((ext_vector_type(8)));
typedef float f32x4 __attribute__((ext_vector_type(4)));
typedef unsigned u32x4 __attribute__((ext_vector_type(4)));
constexpr int BM = 256, BK = 64, HALF = 128, HTB = HALF * BK * 2  , STAGE_BYTES = 8 * HTB, NXCD = 8, WGM = 8;

__host__ __device__ __forceinline__ int lds_byte(int r, int c) { const int st = (r >> 4) * 2 + (c >> 5), rr = r & 15, cc = c & 31, ob = rr * 64 + cc * 2; return st * 1024 + (ob ^ (((ob >> 9) & 1) << 5)); }
__host__ __device__ __forceinline__ void stage_rc(int b, int& R, int& C) { const int st = b / 1024, sb = b % 1024, swz = sb ^ (((sb >> 9) & 1) << 5); R = (st >> 1) * 16 + swz / 64; C = (st & 1) * 32 + (swz % 64) / 2; }
__host__ __device__ __forceinline__ int perm32(int rho) { const int n = rho >> 4, i = rho & 15; return 8 * (i >> 2) + 4 * n + (i & 3); }

struct Unit { int pm, pn; };
struct Gemm { const bf16_t* A; const bf16_t* Bt; int M, N, K; };

struct StaticOrder {
    int nM, nN, nwg, G, c;
    __host__ __device__ void init(int M, int N, int G_, int c_) { nM = M / BM; nN = N / BM; nwg = nM * nN; G = G_; c = c_; }
    __host__ __device__ bool next(int i, Unit& u) const {
        const long L = (long)i * G + c; if (L >= nwg) return false;
        int wgid = (int)L; { const int q = nwg / NXCD, r = nwg % NXCD, xcd = wgid % NXCD, off = wgid / NXCD; wgid = (xcd < r ? xcd * (q + 1) : r * (q + 1) + (xcd - r) * q) + off; }
        const int nig = WGM * nN, gid = wgid / nig, fm = gid * WGM, gsz = (nM - fm) < WGM ? (nM - fm) : WGM;
        u.pm = fm + ((wgid % nig) % gsz); u.pn = (wgid % nig) / gsz; return true;
    }
    __device__ __forceinline__ void a_ready(const Unit&) const {}
    __device__ __forceinline__ void done(const Unit&) const {}
};

__device__ __forceinline__ unsigned cvt_pk_bf16(float lo, float hi) { unsigned r; asm volatile("v_cvt_pk_bf16_f32 %0, %1, %2" : "=v"(r) : "v"(lo), "v"(hi)); return r; }
typedef float f32x2 __attribute__((ext_vector_type(2)));
__device__ __forceinline__ f32x2 gelu_pk(f32x2 v) {
    const f32x2 av = __builtin_elementwise_abs(v), d = av * 0.2316418882f + 1.0f;
    f32x2 t; t.x = __builtin_amdgcn_rcpf(d.x); t.y = __builtin_amdgcn_rcpf(d.y);
    f32x2 q = t * 0.5307027145f + (-0.7265760135f); q = q * t + 0.7107068705f; q = q * t + (-0.142248368f); q = q * t + 0.127414796f; q = q * t;
    const f32x2 s = (v * v) * (-0.72134752044f);
    f32x2 e; e.x = __builtin_amdgcn_exp2f(s.x); e.y = __builtin_amdgcn_exp2f(s.y);
    const f32x2 m = v * (q * e), r = v - m;
    f32x2 o; o.x = v.x < 0.f ? m.x : r.x; o.y = v.y < 0.f ? m.y : r.y; return o;
}

template <int ACT  > struct EpiBf16 {
    static constexpr bool PERM = true, AFTER_DRAIN = false; static_assert(ACT == 0 || ACT == 1, "EpiBf16: ACT is 0 (none) or 1 (gelu_pk)");
    bf16_t* O; int ldc; const float* bias; int split_cols; size_t split_stride; float scale0;
    __device__ __forceinline__ void operator()(const f32x4 (&acc)[2][2][4][2], const Unit& u, int wr, int wc, int fr, int fq) const {
        const int row0 = u.pm * BM + wr * 64 + fr; int colt = u.pn * BM; bf16_t* base = O;
        float sc = 1.f; if (split_cols) { const int t = colt / split_cols; base += (size_t)t * split_stride; colt -= t * split_cols; if (t == 0) sc = scale0; }
        const int col0 = colt + wc * 32 + 8 * fq, bcol0 = u.pn * BM + wc * 32 + 8 * fq;
        f32x4 bv[2][2];
#pragma unroll
        for (int bj = 0; bj < 2; ++bj)
#pragma unroll
            for (int n = 0; n < 2; ++n) bv[bj][n] = bias ? *(const f32x4*)(bias + bcol0 + bj * HALF + 4 * n) : (f32x4){0.f, 0.f, 0.f, 0.f};
#pragma unroll
        for (int ai = 0; ai < 2; ++ai)
#pragma unroll
            for (int m = 0; m < 4; ++m) { bf16_t* rowp = base + (size_t)(row0 + ai * HALF + m * 16) * ldc + col0;
#pragma unroll
                for (int bj = 0; bj < 2; ++bj) { f32x4 v0 = acc[ai][bj][m][0] + bv[bj][0], v1 = acc[ai][bj][m][1] + bv[bj][1];
                    if (ACT == 1) { f32x2 a = gelu_pk((f32x2){v0[0], v0[1]}), b = gelu_pk((f32x2){v0[2], v0[3]}), c = gelu_pk((f32x2){v1[0], v1[1]}), d = gelu_pk((f32x2){v1[2], v1[3]});
                        v0 = (f32x4){a.x, a.y, b.x, b.y}; v1 = (f32x4){c.x, c.y, d.x, d.y}; }
                    v0 = v0 * sc; v1 = v1 * sc; u32x4 w; w.x = cvt_pk_bf16(v0[0], v0[1]); w.y = cvt_pk_bf16(v0[2], v0[3]); w.z = cvt_pk_bf16(v1[0], v1[1]); w.w = cvt_pk_bf16(v1[2], v1[3]);
                    *(u32x4*)(rowp + bj * HALF) = w; } }
    }
};

__device__ __forceinline__ float bf_lo(unsigned w) { return __uint_as_float(w << 16); }
__device__ __forceinline__ float bf_hi(unsigned w) { return __uint_as_float(w & 0xffff0000u); }
__device__ __forceinline__ float sigmoid_f(float v) { return __builtin_amdgcn_rcpf(1.0f + __builtin_amdgcn_exp2f(-1.4426950408889634f * v)); }
struct EpiGlu {
    static constexpr bool PERM = true, AFTER_DRAIN = false;
    const bf16_t* Y; bf16_t* Z; int ldc; const float* bias;
    __device__ __forceinline__ void operator()(const f32x4 (&acc)[2][2][4][2], const Unit& u, int wr, int wc, int fr, int fq) const {
        const int row0 = u.pm * BM + wr * 64 + fr, col0 = u.pn * BM + wc * 32 + 8 * fq;
        f32x4 bv[2][2];
#pragma unroll
        for (int bj = 0; bj < 2; ++bj)
#pragma unroll
            for (int n = 0; n < 2; ++n) bv[bj][n] = *(const f32x4*)(bias + col0 + bj * HALF + 4 * n);
#pragma unroll
        for (int ai = 0; ai < 2; ++ai)
#pragma unroll
            for (int m = 0; m < 4; ++m) { const size_t off = (size_t)(row0 + ai * HALF + m * 16) * ldc + col0;
#pragma unroll
                for (int bj = 0; bj < 2; ++bj) { const u32x4 yv = *(const u32x4*)(Y + off + bj * HALF);
                    const f32x4 v0 = acc[ai][bj][m][0] + bv[bj][0], v1 = acc[ai][bj][m][1] + bv[bj][1];
                    u32x4 w;
                    w.x = cvt_pk_bf16(bf_lo(yv.x) * sigmoid_f(v0[0]), bf_hi(yv.x) * sigmoid_f(v0[1]));
                    w.y = cvt_pk_bf16(bf_lo(yv.y) * sigmoid_f(v0[2]), bf_hi(yv.y) * sigmoid_f(v0[3]));
                    w.z = cvt_pk_bf16(bf_lo(yv.z) * sigmoid_f(v1[0]), bf_hi(yv.z) * sigmoid_f(v1[1]));
                    w.w = cvt_pk_bf16(bf_lo(yv.w) * sigmoid_f(v1[2]), bf_hi(yv.w) * sigmoid_f(v1[3]));
                    *(u32x4*)(Z + off + bj * HALF) = w; } }
    }
};
struct EpiResid1 {
    static constexpr bool PERM = true, AFTER_DRAIN = false;
    const float* X; float* X1; bf16_t* X1G; const float* gw; float* ssq; int ldc;
    __device__ __forceinline__ void operator()(const f32x4 (&acc)[2][2][4][2], const Unit& u, int wr, int wc, int fr, int fq) const {
        const int row0 = u.pm * BM + wr * 64 + fr, col0 = u.pn * BM + wc * 32 + 8 * fq;
        f32x4 gv[2][2];
#pragma unroll
        for (int bj = 0; bj < 2; ++bj)
#pragma unroll
            for (int n = 0; n < 2; ++n) gv[bj][n] = *(const f32x4*)(gw + col0 + bj * HALF + 4 * n);
#pragma unroll
        for (int ai = 0; ai < 2; ++ai)
#pragma unroll
            for (int m = 0; m < 4; ++m) { const int row = row0 + ai * HALF + m * 16; const size_t off = (size_t)row * ldc + col0; float s = 0.f;
#pragma unroll
                for (int bj = 0; bj < 2; ++bj) {
                    const f32x4 v0 = *(const f32x4*)(X + off + bj * HALF) + acc[ai][bj][m][0], v1 = *(const f32x4*)(X + off + bj * HALF + 4) + acc[ai][bj][m][1];
                    *(f32x4*)(X1 + off + bj * HALF) = v0; *(f32x4*)(X1 + off + bj * HALF + 4) = v1;
                    s += (v0[0] * v0[0] + v0[1] * v0[1]) + (v0[2] * v0[2] + v0[3] * v0[3]) + (v1[0] * v1[0] + v1[1] * v1[1]) + (v1[2] * v1[2] + v1[3] * v1[3]);
                    const f32x4 g0 = v0 * gv[bj][0], g1 = v1 * gv[bj][1]; u32x4 w;
                    w.x = cvt_pk_bf16(g0[0], g0[1]); w.y = cvt_pk_bf16(g0[2], g0[3]); w.z = cvt_pk_bf16(g1[0], g1[1]); w.w = cvt_pk_bf16(g1[2], g1[3]);
                    *(u32x4*)(X1G + off + bj * HALF) = w; }
                s += __shfl_xor(s, 16); s += __shfl_xor(s, 32);
                if (fq == 0) ssq[(size_t)row * 32 + u.pn * 4 + wc] = s; }
    }
};
struct EpiUp {
    static constexpr bool PERM = true, AFTER_DRAIN = false;
    bf16_t* O; int ldc; const float* ssq; float inv_n, eps;
    __device__ __forceinline__ void operator()(const f32x4 (&acc)[2][2][4][2], const Unit& u, int wr, int wc, int fr, int fq) const {
        const int row0 = u.pm * BM + wr * 64 + fr, col0 = u.pn * BM + wc * 32 + 8 * fq;
#pragma unroll
        for (int ai = 0; ai < 2; ++ai)
#pragma unroll
            for (int m = 0; m < 4; ++m) { const int row = row0 + ai * HALF + m * 16; const f32x4* sp = (const f32x4*)(ssq + (size_t)row * 32);
                f32x4 t = sp[0];
#pragma unroll
                for (int k = 1; k < 8; ++k) t += sp[k];
                const float rstd = __builtin_amdgcn_rsqf(((t[0] + t[1]) + (t[2] + t[3])) * inv_n + eps);
                bf16_t* rowp = O + (size_t)row * ldc + col0;
#pragma unroll
                for (int bj = 0; bj < 2; ++bj) { const f32x4 v0 = acc[ai][bj][m][0] * rstd, v1 = acc[ai][bj][m][1] * rstd; u32x4 w;
                    w.x = cvt_pk_bf16(v0[0], v0[1]); w.y = cvt_pk_bf16(v0[2], v0[3]); w.z = cvt_pk_bf16(v1[0], v1[1]); w.w = cvt_pk_bf16(v1[2], v1[3]);
                    *(u32x4*)(rowp + bj * HALF) = w; } }
    }
};
struct EpiResid2 {
    static constexpr bool PERM = true, AFTER_DRAIN = false;
    float* OUT; int ldc;
    __device__ __forceinline__ void operator()(const f32x4 (&acc)[2][2][4][2], const Unit& u, int wr, int wc, int fr, int fq) const {
        const int row0 = u.pm * BM + wr * 64 + fr, col0 = u.pn * BM + wc * 32 + 8 * fq;
#pragma unroll
        for (int ai = 0; ai < 2; ++ai)
#pragma unroll
            for (int m = 0; m < 4; ++m) { float* rowp = OUT + (size_t)(row0 + ai * HALF + m * 16) * ldc + col0;
#pragma unroll
                for (int bj = 0; bj < 2; ++bj) { f32x4* p = (f32x4*)(rowp + bj * HALF); const f32x4 a = p[0], b = p[1]; p[0] = a + acc[ai][bj][m][0]; p[1] = b + acc[ai][bj][m][1]; } }
    }
};
template <class Epi, class Sched, bool ALIGN_EPI = false, bool SP2 = false>
__device__ __forceinline__ void gemm_phase(PG8_LAS unsigned char* lds, const Gemm g, const Sched& S, const Epi& E) {
    const int tid = threadIdx.x, wid = __builtin_amdgcn_readfirstlane(tid >> 6), lane = tid & 63, wr = wid >> 2, wc = wid & 3, fr = lane & 15, fq = lane >> 4;
    const int K = g.K, nt = K / BK;
    unsigned voffA[2], voffB[2];
#pragma unroll
    for (int i = 0; i < 2; ++i) { int R, C; stage_rc(tid * 16 + i * 8192, R, C); const int Rb = Epi::PERM ? ((R & ~31) + perm32(R & 31)) : R;
        voffA[i] = (unsigned)(R * K + C) * 2u; voffB[i] = (unsigned)(Rb * K + C) * 2u; }
    const size_t kstep = (size_t)(BK * 2);
    const size_t hstep = (size_t)HALF * K * 2;
    const size_t tstep = 2 * hstep;
    const unsigned ldsw = (unsigned)wid * 1024u;
    const int aoff = lds_byte(wr * 64 + fr, fq * 8), boff = lds_byte(wc * 32 + fr, fq * 8);
#define PG8_SA(b, h) (((b) * 2 + (h)) * HTB)
#define PG8_SB(b, h) ((4 + (b) * 2 + (h)) * HTB)
#define PG8_STAGE(bufoff, gbase, voff) do { _Pragma("unroll") for (int _i = 0; _i < 2; ++_i) \
        __builtin_amdgcn_global_load_lds((const unsigned*)((const char*)(gbase) + (voff)[_i]), (PG8_LAS unsigned*)(lds + (bufoff) + ldsw + _i * 8192), 16, 0, 0); } while (0)
#define PG8_LDA(dst, b, h) do { _Pragma("unroll") for (int m = 0; m < 4; ++m) _Pragma("unroll") for (int k = 0; k < 2; ++k) dst[m][k] = *(const PG8_LAS bf16x8*)(lds + PG8_SA(b, h) + aoff + m * 2048 + k * 1024); } while (0)
#define PG8_LDB(dst, b, h) do { _Pragma("unroll") for (int n = 0; n < 2; ++n) _Pragma("unroll") for (int k = 0; k < 2; ++k) dst[n][k] = *(const PG8_LAS bf16x8*)(lds + PG8_SB(b, h) + boff + n * 2048 + k * 1024); } while (0)
#define PG8_MMA(ai, bj, At, Bt) do { __builtin_amdgcn_s_setprio(1); _Pragma("unroll") for (int m = 0; m < 4; ++m) _Pragma("unroll") for (int n = 0; n < 2; ++n) _Pragma("unroll") for (int k = 0; k < 2; ++k) \
        acc[ai][bj][m][n] = __builtin_amdgcn_mfma_f32_16x16x32_bf16(Bt[n][k], At[m][k], acc[ai][bj][m][n], 0, 0, 0); __builtin_amdgcn_s_setprio(0); } while (0)
#define PG8_WAIT_V(n) asm volatile("s_waitcnt vmcnt(" #n ")" ::: "memory")
#define PG8_WAIT_L(n) asm volatile("s_waitcnt lgkmcnt(" #n ")" ::: "memory")
#define PG8_BAR __builtin_amdgcn_s_barrier()
#define PG8_SCHED __builtin_amdgcn_sched_barrier(0)
    Unit cur, nxt; int ui = 0;
    if (!S.next(0, cur)) return;
    f32x4 acc[2][2][4][2];
#pragma unroll
    for (int a = 0; a < 2; ++a)
#pragma unroll
        for (int b = 0; b < 2; ++b)
#pragma unroll
            for (int m = 0; m < 4; ++m)
#pragma unroll
                for (int n = 0; n < 2; ++n) acc[a][b][m][n] = (f32x4){0.f, 0.f, 0.f, 0.f};
    bf16x8 At[4][2], B0[2][2], B1[2][2];
    const char* cA = (const char*)g.A + (size_t)cur.pm * tstep; const char* cB = (const char*)g.Bt + (size_t)cur.pn * tstep;
    S.a_ready(cur);
    if constexpr (SP2) {
        PG8_STAGE(PG8_SB(0, 0), cB, voffB); PG8_STAGE(PG8_SB(0, 1), cB + hstep, voffB); PG8_STAGE(PG8_SA(0, 0), cA, voffA); PG8_STAGE(PG8_SA(0, 1), cA + hstep, voffA);
        if (wr == 1) PG8_BAR;
        PG8_WAIT_V(2); PG8_BAR;
        PG8_STAGE(PG8_SB(1, 0), cB + kstep, voffB); PG8_STAGE(PG8_SA(1, 0), cA + kstep, voffA); PG8_STAGE(PG8_SB(1, 1), cB + hstep + kstep, voffB);
        PG8_WAIT_V(6); PG8_BAR;
    } else {
        PG8_STAGE(PG8_SB(0, 0), cB, voffB); PG8_STAGE(PG8_SA(0, 0), cA, voffA); PG8_STAGE(PG8_SB(0, 1), cB + hstep, voffB); PG8_STAGE(PG8_SA(0, 1), cA + hstep, voffA);
        if (wr == 1) PG8_BAR;
        PG8_WAIT_V(4); PG8_BAR;
        PG8_STAGE(PG8_SB(1, 0), cB + kstep, voffB); PG8_STAGE(PG8_SA(1, 0), cA + kstep, voffA); PG8_STAGE(PG8_SB(1, 1), cB + hstep + kstep, voffB);
        PG8_WAIT_V(6); PG8_BAR;
    }
    for (;;) {
        const bool has_next = S.next(ui + 1, nxt);
        const char* nA = has_next ? (const char*)g.A + (size_t)nxt.pm * tstep : cA; const char* nB = has_next ? (const char*)g.Bt + (size_t)nxt.pn * tstep : cB;
        for (int t = 0; t < nt; t += 2) {
            const bool last = (t == nt - 2);
            const char* a1 = cA + (size_t)(t + 1) * kstep;
            const char* a2 = last ? nA : cA + (size_t)(t + 2) * kstep; const char* b2 = last ? nB : cB + (size_t)(t + 2) * kstep;
            const char* a3 = a2 + kstep; const char* b3 = b2 + kstep;
            if (last && has_next) S.a_ready(nxt);
            if constexpr (SP2) {
            PG8_LDB(B0, 0, 0); PG8_LDB(B1, 0, 1); PG8_SCHED; PG8_LDA(At, 0, 0); PG8_STAGE(PG8_SA(1, 1), a1 + hstep, voffA);
            PG8_WAIT_V(8); PG8_WAIT_L(0); PG8_BAR; PG8_MMA(0, 0, At, B0); PG8_MMA(0, 1, At, B1); PG8_BAR; PG8_SCHED;
            PG8_LDA(At, 0, 1); PG8_STAGE(PG8_SB(0, 0), b2, voffB); PG8_STAGE(PG8_SB(0, 1), b2 + hstep, voffB); PG8_STAGE(PG8_SA(0, 0), a2, voffA);
            PG8_WAIT_V(8); PG8_WAIT_L(0); PG8_BAR; PG8_MMA(1, 0, At, B0); PG8_MMA(1, 1, At, B1); PG8_BAR; PG8_SCHED;
            PG8_LDB(B0, 1, 0); PG8_LDB(B1, 1, 1); PG8_SCHED; PG8_LDA(At, 1, 0); PG8_STAGE(PG8_SA(0, 1), a2 + hstep, voffA);
            PG8_WAIT_V(8); PG8_WAIT_L(0); PG8_BAR; PG8_MMA(0, 0, At, B0); PG8_MMA(0, 1, At, B1); PG8_BAR; PG8_SCHED;
            PG8_LDA(At, 1, 1); PG8_STAGE(PG8_SB(1, 0), b3, voffB); PG8_STAGE(PG8_SB(1, 1), b3 + hstep, voffB); PG8_STAGE(PG8_SA(1, 0), a3, voffA);
            PG8_WAIT_V(8); PG8_WAIT_L(0); PG8_BAR; PG8_MMA(1, 0, At, B0); PG8_MMA(1, 1, At, B1); PG8_BAR; PG8_SCHED;
            } else {
            PG8_LDB(B0, 0, 0); PG8_SCHED; PG8_LDA(At, 0, 0); PG8_STAGE(PG8_SA(1, 1), a1 + hstep, voffA);
            PG8_WAIT_L(8); PG8_BAR; PG8_WAIT_L(0); PG8_MMA(0, 0, At, B0); PG8_BAR; PG8_SCHED;
            PG8_LDB(B1, 0, 1); PG8_STAGE(PG8_SB(0, 0), b2, voffB);
            PG8_BAR; PG8_WAIT_L(0); PG8_MMA(0, 1, At, B1); PG8_BAR;
            PG8_LDA(At, 0, 1); PG8_STAGE(PG8_SA(0, 0), a2, voffA);
            PG8_BAR; PG8_WAIT_L(0); PG8_MMA(1, 0, At, B0); PG8_BAR; PG8_SCHED;
            PG8_STAGE(PG8_SB(0, 1), b2 + hstep, voffB);
            PG8_WAIT_V(6); PG8_BAR; PG8_MMA(1, 1, At, B1); PG8_BAR;
            PG8_LDB(B0, 1, 0); PG8_SCHED; PG8_LDA(At, 1, 0); PG8_STAGE(PG8_SA(0, 1), a2 + hstep, voffA);
            PG8_WAIT_L(8); PG8_BAR; PG8_WAIT_L(0); PG8_MMA(0, 0, At, B0); PG8_BAR; PG8_SCHED;
            PG8_LDB(B1, 1, 1); PG8_STAGE(PG8_SB(1, 0), b3, voffB);
            PG8_BAR; PG8_WAIT_L(0); PG8_MMA(0, 1, At, B1); PG8_BAR;
            PG8_LDA(At, 1, 1); PG8_STAGE(PG8_SA(1, 0), a3, voffA);
            PG8_BAR; PG8_WAIT_L(0); PG8_MMA(1, 0, At, B0); PG8_BAR; PG8_SCHED;
            PG8_STAGE(PG8_SB(1, 1), b3 + hstep, voffB);
            PG8_WAIT_V(6); PG8_BAR; PG8_MMA(1, 1, At, B1); PG8_BAR;
            }
        }
        if constexpr (ALIGN_EPI) { if (wr == 0) PG8_BAR; }
        if constexpr (!Epi::AFTER_DRAIN) { E(acc, cur, wr, wc, fr, fq); S.done(cur); }
        if (!has_next) break;
#pragma unroll
        for (int a = 0; a < 2; ++a)
#pragma unroll
            for (int b = 0; b < 2; ++b)
#pragma unroll
                for (int m = 0; m < 4; ++m)
#pragma unroll
                    for (int n = 0; n < 2; ++n) acc[a][b][m][n] = (f32x4){0.f, 0.f, 0.f, 0.f};
        cur = nxt; cA = nA; cB = nB; ++ui;
        if constexpr (ALIGN_EPI) { if (wr == 1) PG8_BAR; }
    }
    PG8_WAIT_V(0);
    if constexpr (!ALIGN_EPI) { if (wr == 0) PG8_BAR; }
    PG8_BAR;
    if constexpr (Epi::AFTER_DRAIN) { E.fused(acc, cur, wr, wc, fr, fq, lds, wid, lane); S.done(cur); }
#undef PG8_SA
#undef PG8_SB
#undef PG8_STAGE
#undef PG8_LDA
#undef PG8_LDB
#undef PG8_MMA
#undef PG8_WAIT_V
#undef PG8_WAIT_L
#undef PG8_BAR
#undef PG8_SCHED
}
}

#ifndef PG8_SP2
#define PG8_SP2 true
#endif
#ifndef PG8_ALIGN
#define PG8_ALIGN true
#endif
#include <cmath>

constexpr int NWAVES = 8;
constexpr int NPH = 11;
#ifndef MK_N_LAUNCHES
#define MK_N_LAUNCHES 1
#endif
constexpr int N_LAUNCHES = MK_N_LAUNCHES;
static_assert(N_LAUNCHES == 1 || N_LAUNCHES == NPH, "MK_N_LAUNCHES is 1 or NPH");

constexpr int BATCH = 2, SEQ = 4096, DM = 2048, M = BATCH * SEQ;
constexpr int AH = 16, HD = 64, AW = AH * HD;
constexpr int SG = 64, SC = 16, SW = SG * SC, SP = 64;
constexpr int INC = 3 * AW + SW;
constexpr int MOBA_BLK = 256, NBLK = SEQ / MOBA_BLK, TOPK = 3;
constexpr int DFF = 5632, DFF2 = 2 * DFF;
constexpr float RMS_EPS = 1e-6f;
constexpr float LOG2E = 1.4426950408889634f;
constexpr float C2 = 0.125f * LOG2E;

constexpr size_t MiB = 1u << 20;
constexpr size_t WS_CTL = 0, CTL_ZERO_BYTES = 1 * MiB;
constexpr size_t WS_WDOWN = 1 * MiB;
constexpr size_t WS_WIN = 23 * MiB;
constexpr size_t WS_WGLU = 39 * MiB;
constexpr size_t WS_WOUT = 41 * MiB;
constexpr size_t WS_WUP = 49 * MiB;
constexpr size_t WS_XN = 93 * MiB;
constexpr size_t WS_Q = 125 * MiB, WS_K = 141 * MiB, WS_V = 157 * MiB, WS_U = 173 * MiB;
constexpr size_t WS_Y = 189 * MiB, WS_Z = 205 * MiB;
constexpr size_t WS_UP = 125 * MiB;
constexpr size_t WS_X1G = 301 * MiB;
constexpr size_t WS_ACT = 23 * MiB;
constexpr size_t WS_SSQ = 333 * MiB;
constexpr size_t WS_KMEAN = 334 * MiB;
constexpr size_t WS_T5B = 335 * MiB;
constexpr size_t WS_END = 336 * MiB;
static_assert(WS_ACT + (size_t)M * DFF * 2 <= WS_Q && WS_UP + (size_t)M * DFF2 * 2 <= WS_X1G && WS_WUP + (size_t)DFF2 * DM * 2 <= WS_XN, "d_ws map");
constexpr int CW_TMO = 0, CW_CODE = 1;
constexpr int CW_BAR = 4096;

constexpr int RING_OFF = 0, RING_BYTES = 131072;
constexpr int LDSCTL_OFF = RING_BYTES, MISC_OFF = LDSCTL_OFF + 320;
constexpr int LDS_BYTES = 147456;
static_assert(MISC_OFF + 128 <= LDS_BYTES, "LDS map");

#define GAS __attribute__((address_space(1)))
#define LAS __attribute__((address_space(3)))
typedef unsigned short bf16;
typedef unsigned v4u __attribute__((ext_vector_type(4)));
typedef float f32x4 __attribute__((ext_vector_type(4)));
typedef short bf16x8 __attribute__((ext_vector_type(8)));
typedef GAS unsigned gu32;
typedef GAS unsigned long long gu64;
#define RLX_AGENT __ATOMIC_RELAXED, __HIP_MEMORY_SCOPE_AGENT
#define LDS_WAIT() asm volatile("s_waitcnt lgkmcnt(0)" ::: "memory")
#define VM_WAIT() asm volatile("s_waitcnt vmcnt(0)" ::: "memory")
__device__ __forceinline__ unsigned long long rt() { return __builtin_amdgcn_s_memrealtime(); }
__device__ __forceinline__ unsigned f2bf(float f) { unsigned u = __builtin_bit_cast(unsigned, f); return (u + 0x7fffu + ((u >> 16) & 1u)) >> 16; }
__device__ __forceinline__ unsigned pk2(float lo, float hi) { return f2bf(lo) | (f2bf(hi) << 16); }

#define XB_TMO      128
#define XB_XCNT(j)  (256  + 64 * (j))
#define XB_XSUB(j)  (1280 + 64 * (j))
#define XB_XGEN(j)  (2304 + 64 * (j))
#define XB_TOP      3328
#define XB_TOPGEN   3392
#define XCD_BAR_WORDS 3456
#define XB_SPIN_CAP (1u << 18)

__device__ __forceinline__ unsigned xb_ld(unsigned* p)              { return __hip_atomic_load(p, __ATOMIC_RELAXED, __HIP_MEMORY_SCOPE_AGENT); }
__device__ __forceinline__ unsigned xb_add(unsigned* p, unsigned v) { return __hip_atomic_fetch_add(p, v, __ATOMIC_RELAXED, __HIP_MEMORY_SCOPE_AGENT); }
__device__ __forceinline__ unsigned xb_xcc_id() { return (unsigned)__builtin_amdgcn_s_getreg((3 << 11) | 20) & 0xFu; }
#define XB_SPIN(cond, bar) do { unsigned _sp = 0; while (cond) { __builtin_amdgcn_s_sleep(1); \
    if ((++_sp & 255u) == 0u) { if (xb_ld(&(bar)[XB_TMO])) break; if (_sp > XB_SPIN_CAP) { atomicAdd(&(bar)[XB_TMO], 1u); break; } } } } while (0)

struct XcdBarrier {
    unsigned* bar; unsigned x;
    volatile LAS unsigned* st;
};

__device__ __forceinline__ XcdBarrier xcd_barrier_post(unsigned* bar, volatile LAS unsigned* st) {
    XcdBarrier b; b.bar = bar; b.x = xb_xcc_id(); b.st = st;
    if (threadIdx.x == 0) (void)xb_add(&bar[XB_XCNT(b.x)], 1u);
    return b;
}
__device__ __forceinline__ void xcd_barrier_complete(unsigned* bar, unsigned x, unsigned& nloc, unsigned& nx) {
    const unsigned G = gridDim.x * gridDim.y * gridDim.z;
    unsigned sum, cnt, mine, sp = 0u;
    for (;;) {
        sum = 0u; cnt = 0u; mine = 0u;
#pragma unroll
        for (unsigned j = 0; j < 16; ++j) { const unsigned c = xb_ld(&bar[XB_XCNT(j)]); sum += c; cnt += (c > 0u) ? 1u : 0u; mine = (j == x) ? c : mine; }
        if (sum == G) break;
        __builtin_amdgcn_s_sleep(1);
        if ((++sp & 255u) == 0u) { if (xb_ld(&bar[XB_TMO])) break; if (sp > XB_SPIN_CAP) { atomicAdd(&bar[XB_TMO], 1u); break; } }
    }
    nloc = mine > 0u ? mine : 1u; nx = cnt > 0u ? cnt : 1u;
}

__device__ __forceinline__ void xcd_barrier(const XcdBarrier& b) {
    asm volatile("s_waitcnt vmcnt(0)" ::: "memory");
    __syncthreads();
    if (threadIdx.x == 0) {
        unsigned* bar = b.bar;
        __builtin_amdgcn_s_waitcnt(0);
        unsigned nloc = b.st[0], nx = b.st[1];
        if (nloc == 0u) { xcd_barrier_complete(bar, b.x, nloc, nx); b.st[0] = nloc; b.st[1] = nx; }
        const unsigned old = xb_add(&bar[XB_XSUB(b.x)], 1u);
        const unsigned gen = old / nloc;
        if (old + 1u == (gen + 1u) * nloc) {
            __builtin_amdgcn_fence(__ATOMIC_RELEASE, "agent");
            asm volatile("s_waitcnt vmcnt(0)" ::: "memory");
            const unsigned og = xb_add(&bar[XB_TOP], 1u);
            const unsigned tg = og / nx;
            if (og + 1u == (tg + 1u) * nx) xb_add(&bar[XB_TOPGEN], 1u);
            else XB_SPIN(xb_ld(&bar[XB_TOPGEN]) == tg, bar);
            __builtin_amdgcn_fence(__ATOMIC_ACQUIRE, "agent");
            xb_add(&bar[XB_XGEN(b.x)], 1u);
            asm volatile("s_waitcnt vmcnt(0)" ::: "memory");
        } else {
            XB_SPIN(xb_ld(&bar[XB_XGEN(b.x)]) == gen, bar);
            __builtin_amdgcn_fence(__ATOMIC_ACQUIRE, "agent");
            asm volatile("s_waitcnt vmcnt(0)" ::: "memory");
        }
    }
    __syncthreads();
}

struct Frame {
    LAS unsigned char* lds;
    volatile LAS unsigned* MISC;
    gu32* ctl;
    int tid, lane, wave;
    int vcu, G;
};
__device__ __forceinline__ float wave_sum(float v) {
#pragma unroll
    for (int o = 1; o < 64; o <<= 1) v += __shfl_xor(v, o);
    return v;
}
__device__ __forceinline__ float wave_max(float v) {
#pragma unroll
    for (int o = 1; o < 64; o <<= 1) v = fmaxf(v, __shfl_xor(v, o));
    return v;
}
__device__ __forceinline__ float bf_lo(unsigned w) { return __uint_as_float(w << 16); }
__device__ __forceinline__ float bf_hi(unsigned w) { return __uint_as_float(w & 0xffff0000u); }
__device__ __forceinline__ float bf2f(bf16 h) { return __uint_as_float((unsigned)h << 16); }

__device__ __forceinline__ void p0_transpose_item(const float* W, int K, int N, bf16* WT, int row_off, LAS float* scr, int item, int lane) {
    const int nblk = N / 32, kb = item / nblk, nb = item % nblk, k0 = 64 * kb, n0 = 32 * nb;
#pragma unroll 8
    for (int i = 0; i < 32; ++i) { const int kk = 2 * i + (lane >> 5); scr[kk * 33 + (lane & 31)] = W[(size_t)(k0 + kk) * N + n0 + (lane & 31)]; }
    LDS_WAIT(); asm volatile("" ::: "memory");
    const int c = lane & 7;
#pragma unroll
    for (int j = 0; j < 4; ++j) { const int n = (lane >> 3) + 8 * j; const LAS float* s = scr + (8 * c) * 33 + n;
        v4u o; o.x = pk2(s[0 * 33], s[1 * 33]); o.y = pk2(s[2 * 33], s[3 * 33]); o.z = pk2(s[4 * 33], s[5 * 33]); o.w = pk2(s[6 * 33], s[7 * 33]);
        *(GAS v4u*)(WT + (size_t)(row_off + n0 + n) * K + k0 + 8 * c) = o; }
    LDS_WAIT(); asm volatile("" ::: "memory");
}
__device__ __forceinline__ void rms_row_to_bf16(int lane, const float* xrow, const float* g, bf16* orow) {
    const GAS f32x4* xr = (const GAS f32x4*)xrow + lane; const GAS f32x4* gr = (const GAS f32x4*)g + lane;
    f32x4 v[8]; float s = 0.f;
#pragma unroll
    for (int j = 0; j < 8; ++j) { v[j] = xr[64 * j]; s += (v[j].x * v[j].x + v[j].y * v[j].y) + (v[j].z * v[j].z + v[j].w * v[j].w); }
    const float rstd = 1.0f / sqrtf(wave_sum(s) * (1.f / DM) + RMS_EPS);
    GAS unsigned long long* o8 = (GAS unsigned long long*)orow + lane;
#pragma unroll
    for (int j = 0; j < 8; ++j) { const f32x4 gg = gr[64 * j]; const f32x4 o = v[j] * rstd * gg;
        o8[64 * j] = (unsigned long long)pk2(o.x, o.y) | ((unsigned long long)pk2(o.z, o.w) << 32); }
}
__device__ __forceinline__ void rms_row1024_bf16(int lane, const bf16* irow, const float* g, bf16* orow) {
    float v[16]; float s = 0.f;
#pragma unroll
    for (int j = 0; j < 2; ++j) { const v4u w = *((const GAS v4u*)irow + lane + 64 * j);
        v[8 * j + 0] = bf_lo(w.x); v[8 * j + 1] = bf_hi(w.x); v[8 * j + 2] = bf_lo(w.y); v[8 * j + 3] = bf_hi(w.y);
        v[8 * j + 4] = bf_lo(w.z); v[8 * j + 5] = bf_hi(w.z); v[8 * j + 6] = bf_lo(w.w); v[8 * j + 7] = bf_hi(w.w); }
#pragma unroll
    for (int k = 0; k < 16; ++k) s += v[k] * v[k];
    const float rstd = 1.0f / sqrtf(wave_sum(s) * (1.f / 1024.f) + RMS_EPS);
#pragma unroll
    for (int j = 0; j < 2; ++j) { const f32x4 g0 = *((const GAS f32x4*)g + 2 * (lane + 64 * j)), g1 = *((const GAS f32x4*)g + 2 * (lane + 64 * j) + 1);
        v4u o; o.x = pk2(v[8 * j + 0] * rstd * g0.x, v[8 * j + 1] * rstd * g0.y); o.y = pk2(v[8 * j + 2] * rstd * g0.z, v[8 * j + 3] * rstd * g0.w);
        o.z = pk2(v[8 * j + 4] * rstd * g1.x, v[8 * j + 5] * rstd * g1.y); o.w = pk2(v[8 * j + 6] * rstd * g1.z, v[8 * j + 7] * rstd * g1.w);
        *((GAS v4u*)orow + lane + 64 * j) = o; }
}
__device__ __forceinline__ int t5_bucket(int dist) {
    if (dist < 16) return dist;
    const float lr = logf((float)dist / 16.0f) / logf(8.0f) * 16.0f;
    int b = 16 + (int)lr; return b < 31 ? b : 31;
}
__device__ __forceinline__ float gelu_tanh(float y) {
    const float u = 0.7978845608028654f * (y + 0.044715f * y * y * y);
    const float e = __builtin_amdgcn_exp2f(2.0f * LOG2E * u);
    const float th = 1.0f - 2.0f * __builtin_amdgcn_rcpf(e + 1.0f);
    return 0.5f * y * (1.0f + th);
}

struct Args { const float* in[23]; float* out; unsigned char* ws; int ph_lo, ph_hi, li, pad; };
__global__ void __launch_bounds__(NWAVES * 64, 2) skel_fwd(Args args) {
    extern __shared__ __attribute__((aligned(16))) unsigned char lds[];
    Frame F;
    F.lds = (LAS unsigned char*)lds;
    F.MISC = (volatile LAS unsigned*)(F.lds + MISC_OFF);
    F.tid = threadIdx.x; F.lane = F.tid & 63; F.wave = __builtin_amdgcn_readfirstlane(F.tid >> 6);
    F.G = gridDim.x; { const int bx = blockIdx.x; F.vcu = (F.G % 8 == 0) ? (bx % 8) * (F.G / 8) + bx / 8 : bx; }
    unsigned char* ws = args.ws;
    F.ctl = (gu32*)(ws + WS_CTL);
    const float* x = args.in[0]; const float* norm_mix = args.in[1]; const float* w_in = args.in[2]; const float* rel_bias = args.in[3];
    const float* lam_re = args.in[4]; const float* lam_im = args.in[5]; const float* log_dt = args.in[6];
    const float* b_re = args.in[7]; const float* b_im = args.in[8]; const float* c_re = args.in[9]; const float* c_im = args.in[10]; const float* d_skip = args.in[11];
    const float* w_glu = args.in[12]; const float* b_glu = args.in[13]; const float* norm_attn = args.in[14]; const float* norm_ssm = args.in[15];
    const float* w_out = args.in[16]; const float* norm_ffn = args.in[17]; const float* w_up = args.in[18]; const float* conv_w = args.in[19]; const float* conv_b = args.in[20];
    const float* w_down = args.in[21]; const float* norm_final = args.in[22];
    float* out = args.out;
    bf16* Wt_in = (bf16*)(ws + WS_WIN); bf16* Wt_glu = (bf16*)(ws + WS_WGLU); bf16* Wt_out = (bf16*)(ws + WS_WOUT); bf16* Wt_up = (bf16*)(ws + WS_WUP); bf16* Wt_down = (bf16*)(ws + WS_WDOWN);
    bf16* XN = (bf16*)(ws + WS_XN); bf16* QB = (bf16*)(ws + WS_Q); bf16* KB = (bf16*)(ws + WS_K); bf16* VB = (bf16*)(ws + WS_V); bf16* UB = (bf16*)(ws + WS_U);
    bf16* YB = (bf16*)(ws + WS_Y); bf16* ZB = (bf16*)(ws + WS_Z); bf16* UPB = (bf16*)(ws + WS_UP); bf16* X1G = (bf16*)(ws + WS_X1G); bf16* ACT = (bf16*)(ws + WS_ACT);
    float* SSQ = (float*)(ws + WS_SSQ); float* KMEAN = (float*)(ws + WS_KMEAN); float* T5B = (float*)(ws + WS_T5B);

    for (int u = F.tid; u < (LDS_BYTES - LDSCTL_OFF) / 4; u += NWAVES * 64) ((LAS unsigned*)(F.lds + LDSCTL_OFF))[u] = 0u;
    __syncthreads();
    XcdBarrier bar; bar.bar = (unsigned*)(F.ctl + CW_BAR); bar.x = 0; bar.st = nullptr;
    if (N_LAUNCHES == 1) bar = xcd_barrier_post((unsigned*)(F.ctl + CW_BAR), F.MISC + 8);
#define GRID_BAR() do { if (N_LAUNCHES == 1) xcd_barrier(bar); } while (0)
    const int lo = args.ph_lo, hi = args.ph_hi;
#define IN(k) (lo <= (k) && (k) < hi)
#define BOTH(k) (IN(k) && IN((k) + 1))
    const int gw = F.vcu * NWAVES + F.wave, NGW = F.G * NWAVES;
    const int gt = gw * 64 + F.lane, NGT = NGW * 64;

    if (IN(0)) {
        LAS float* scr = (LAS float*)(F.lds + RING_OFF + F.wave * 16384);
        constexpr int I_IN = (DM / 64) * (INC / 32), I_GLU = (SW / 64) * (SW / 32), I_OUT = (DM / 64) * (DM / 32), I_UP = (DM / 64) * (DFF2 / 32), I_DN = (DFF / 64) * (DM / 32);
        constexpr int NITEMS = I_IN + I_GLU + I_OUT + I_UP + I_DN;
        for (int it = gw; it < NITEMS; it += NGW) {
            int r = it;
            if (r < I_IN) { p0_transpose_item(w_in, DM, INC, Wt_in, 0, scr, r, F.lane); continue; } r -= I_IN;
            if (r < I_GLU) { p0_transpose_item(w_glu, SW, SW, Wt_glu, 0, scr, r, F.lane); continue; } r -= I_GLU;
            if (r < I_OUT) { p0_transpose_item(w_out, DM, DM, Wt_out, 0, scr, r, F.lane); continue; } r -= I_OUT;
            if (r < I_UP) { p0_transpose_item(w_up, DM, DFF2, Wt_up, 0, scr, r, F.lane); continue; } r -= I_UP;
            p0_transpose_item(w_down, DFF, DM, Wt_down, 0, scr, r, F.lane);
        }
        for (int m = gw; m < M; m += NGW) rms_row_to_bf16(F.lane, x + (size_t)m * DM, norm_mix, XN + (size_t)m * DM);
        for (int i = gt; i < AH * 512; i += NGT) { const int h = i >> 9, d = i & 511; T5B[i] = LOG2E * rel_bias[t5_bucket(d) * AH + h]; }
        if (BOTH(0)) GRID_BAR();
    }

    if (IN(1)) {
        pg8::Gemm g{XN, Wt_in, M, INC, DM}; pg8::StaticOrder S; S.init(M, INC, F.G, (int)blockIdx.x);
        pg8::EpiBf16<0> E{QB, AW, nullptr, AW, (size_t)(WS_K - WS_Q) / 2, C2};
        pg8::gemm_phase<pg8::EpiBf16<0>, pg8::StaticOrder, PG8_ALIGN, PG8_SP2>(F.lds + RING_OFF, g, S, E);
        if (BOTH(1)) GRID_BAR();
    }

    if (IN(2)) {
        for (int it = gw; it < BATCH * AH * NBLK; it += NGW) {
            const int n = it % NBLK, h = (it / NBLK) % AH, b = it / (NBLK * AH);
            const bf16* kp = KB + ((size_t)(b * SEQ + n * MOBA_BLK + (F.lane >> 3))) * AW + h * HD + (F.lane & 7) * 8;
            float a[8];
#pragma unroll
            for (int k = 0; k < 8; ++k) a[k] = 0.f;
            for (int i = 0; i < 32; ++i) { const v4u w = *(const GAS v4u*)(kp + (size_t)i * 8 * AW);
                a[0] += bf_lo(w.x); a[1] += bf_hi(w.x); a[2] += bf_lo(w.y); a[3] += bf_hi(w.y); a[4] += bf_lo(w.z); a[5] += bf_hi(w.z); a[6] += bf_lo(w.w); a[7] += bf_hi(w.w); }
#pragma unroll
            for (int k = 0; k < 8; ++k) { a[k] += __shfl_xor(a[k], 8); a[k] += __shfl_xor(a[k], 16); a[k] += __shfl_xor(a[k], 32); }
            if (F.lane < 8) { float* o = KMEAN + (size_t)it * HD + F.lane * 8;
#pragma unroll
                for (int k = 0; k < 8; ++k) o[k] = a[k] * (1.0f / MOBA_BLK); }
        }
        for (int it = gw; it < BATCH * SG; it += NGW) {
            const int g = it % SG, b = it / SG, p = F.lane;
            const float lr = lam_re[g * SP + p], li = lam_im[g * SP + p], dt = expf(log_dt[g]);
            const float er = expf(lr * dt), lbr = er * cosf(li * dt), lbi = er * sinf(li * dt);
            const float nr = lbr - 1.0f, ni = lbi, den = lr * lr + li * li;
            const float cr_ = (nr * lr + ni * li) / den, ci_ = (ni * lr - nr * li) / den;
            float bbr[16], bbi[16], ccr[16], cci[16];
#pragma unroll
            for (int h = 0; h < 16; ++h) { const float bre = b_re[(size_t)(g * SP + p) * SC + h], bim = b_im[(size_t)(g * SP + p) * SC + h];
                bbr[h] = cr_ * bre - ci_ * bim; bbi[h] = cr_ * bim + ci_ * bre;
                ccr[h] = c_re[(size_t)(g * SC + h) * SP + p]; cci[h] = c_im[(size_t)(g * SC + h) * SP + p]; }
            const float dsk = d_skip[g * SC + (F.lane & 15)];
            float xr = 0.f, xi = 0.f;
            const bf16* up = UB + (size_t)(b * SEQ) * SW + g * SC;
            v4u n0 = *(const GAS v4u*)(up), n1 = *(const GAS v4u*)(up + 8);
            for (int t = 0; t < SEQ; ++t) {
                const v4u c0 = n0, c1 = n1;
                if (t + 1 < SEQ) { n0 = *(const GAS v4u*)(up + (size_t)(t + 1) * SW); n1 = *(const GAS v4u*)(up + (size_t)(t + 1) * SW + 8); }
                float uf[16];
                uf[0] = bf_lo(c0.x); uf[1] = bf_hi(c0.x); uf[2] = bf_lo(c0.y); uf[3] = bf_hi(c0.y); uf[4] = bf_lo(c0.z); uf[5] = bf_hi(c0.z); uf[6] = bf_lo(c0.w); uf[7] = bf_hi(c0.w);
                uf[8] = bf_lo(c1.x); uf[9] = bf_hi(c1.x); uf[10] = bf_lo(c1.y); uf[11] = bf_hi(c1.y); uf[12] = bf_lo(c1.z); uf[13] = bf_hi(c1.z); uf[14] = bf_lo(c1.w); uf[15] = bf_hi(c1.w);
                float bur = 0.f, bui = 0.f;
#pragma unroll
                for (int h = 0; h < 16; ++h) { bur += uf[h] * bbr[h]; bui += uf[h] * bbi[h]; }
                const float nxr = lbr * xr - lbi * xi + bur, nxi = lbr * xi + lbi * xr + bui; xr = nxr; xi = nxi;
                float yv = 0.f;
#pragma unroll
                for (int h = 0; h < 16; ++h) { const float v = wave_sum(xr * ccr[h] - xi * cci[h]); if (F.lane == h) yv = v + dsk * uf[h]; }
                if (F.lane < 16) YB[(size_t)(b * SEQ + t) * SW + g * SC + F.lane] = (bf16)f2bf(gelu_tanh(yv));
            }
        }
        if (BOTH(2)) GRID_BAR();
    }

    if (IN(3)) {
        LAS float* pl = (LAS float*)(F.lds + RING_OFF + F.wave * 4096);
        for (int it = gw; it < BATCH * AH * SEQ; it += NGW) {
            const int qpos = it % SEQ, h = (it / SEQ) % AH, b = it / (SEQ * AH);
            const int own = qpos >> 8;
            const size_t qrow = (size_t)(b * SEQ + qpos) * AW + h * HD;
            float qf[64];
#pragma unroll
            for (int j = 0; j < 8; ++j) { const v4u w = *(const GAS v4u*)(QB + qrow + 8 * j);
                qf[8 * j + 0] = bf_lo(w.x); qf[8 * j + 1] = bf_hi(w.x); qf[8 * j + 2] = bf_lo(w.y); qf[8 * j + 3] = bf_hi(w.y);
                qf[8 * j + 4] = bf_lo(w.z); qf[8 * j + 5] = bf_hi(w.z); qf[8 * j + 6] = bf_lo(w.w); qf[8 * j + 7] = bf_hi(w.w); }
            float gt_ = -INFINITY;
            if (F.lane < own) { const float* km = KMEAN + ((size_t)((b * AH + h) * NBLK + F.lane)) * HD; float a = 0.f;
#pragma unroll
                for (int d = 0; d < 64; ++d) a += qf[d] * km[d];
                gt_ = a; }
            unsigned selmask = 0u; const int ns = own < TOPK ? own : TOPK;
            for (int s = 0; s < ns; ++s) { const float mx = wave_max(gt_); const unsigned long long bal = __ballot(gt_ == mx); const int idx = __ffsll((long long)bal) - 1;
                selmask |= 1u << idx; if (F.lane == idx) gt_ = -INFINITY; }
            int bl[4]; bool va[4]; { unsigned mk = selmask;
#pragma unroll
                for (int s = 0; s < 3; ++s) { va[s] = mk != 0u; bl[s] = va[s] ? (__ffs((int)mk) - 1) : 0; mk &= mk - 1u; } }
            bl[3] = own; va[3] = true;
            float sc[4][4]; float mx = -INFINITY;
#pragma unroll
            for (int s = 0; s < 4; ++s)
#pragma unroll
                for (int j = 0; j < 4; ++j) { const int kpos = bl[s] * MOBA_BLK + j * 64 + F.lane; float v = -INFINITY;
                    if (va[s] && kpos <= qpos) { const bf16* kr = KB + (size_t)(b * SEQ + kpos) * AW + h * HD; float a = 0.f;
#pragma unroll
                        for (int jj = 0; jj < 8; ++jj) { const v4u w = *(const GAS v4u*)(kr + 8 * jj);
                            a += qf[8 * jj + 0] * bf_lo(w.x) + qf[8 * jj + 1] * bf_hi(w.x) + qf[8 * jj + 2] * bf_lo(w.y) + qf[8 * jj + 3] * bf_hi(w.y)
                               + qf[8 * jj + 4] * bf_lo(w.z) + qf[8 * jj + 5] * bf_hi(w.z) + qf[8 * jj + 6] * bf_lo(w.w) + qf[8 * jj + 7] * bf_hi(w.w); }
                        const int dist = qpos - kpos; v = a + T5B[h * 512 + (dist < 511 ? dist : 511)]; }
                    sc[s][j] = v; mx = fmaxf(mx, v); }
            mx = wave_max(mx);
            float l = 0.f;
#pragma unroll
            for (int s = 0; s < 4; ++s)
#pragma unroll
                for (int j = 0; j < 4; ++j) { const float p = __builtin_amdgcn_exp2f(sc[s][j] - mx); l += p; pl[s * 256 + j * 64 + F.lane] = p; }
            l = wave_sum(l);
            LDS_WAIT(); asm volatile("" ::: "memory");
            float o = 0.f;
#pragma unroll
            for (int s = 0; s < 4; ++s) if (va[s]) { const bf16* vp = VB + (size_t)(b * SEQ + bl[s] * MOBA_BLK) * AW + h * HD + F.lane;
                for (int k = 0; k < 256; ++k) o += pl[s * 256 + k] * bf2f(vp[(size_t)k * AW]); }
            LDS_WAIT(); asm volatile("" ::: "memory");
            QB[qrow + F.lane] = (bf16)f2bf(o / l);
        }
        if (BOTH(3)) GRID_BAR();
    }

    if (IN(4)) {
        pg8::Gemm g{YB, Wt_glu, M, SW, SW}; pg8::StaticOrder S; S.init(M, SW, F.G, (int)blockIdx.x);
        pg8::EpiGlu E{YB, ZB, SW, b_glu};
        pg8::gemm_phase<pg8::EpiGlu, pg8::StaticOrder, PG8_ALIGN, PG8_SP2>(F.lds + RING_OFF, g, S, E);
        if (BOTH(4)) GRID_BAR();
    }

    if (IN(5)) {
        for (int m = gw; m < M; m += NGW) {
            rms_row1024_bf16(F.lane, QB + (size_t)m * AW, norm_attn, XN + (size_t)m * DM);
            rms_row1024_bf16(F.lane, ZB + (size_t)m * SW, norm_ssm, XN + (size_t)m * DM + AW);
        }
        if (BOTH(5)) GRID_BAR();
    }

    if (IN(6)) {
        pg8::Gemm g{XN, Wt_out, M, DM, DM}; pg8::StaticOrder S; S.init(M, DM, F.G, (int)blockIdx.x);
        pg8::EpiResid1 E{x, out, X1G, norm_ffn, SSQ, DM};
        pg8::gemm_phase<pg8::EpiResid1, pg8::StaticOrder, PG8_ALIGN, PG8_SP2>(F.lds + RING_OFF, g, S, E);
        if (BOTH(6)) GRID_BAR();
    }

    if (IN(7)) {
        pg8::Gemm g{X1G, Wt_up, M, DFF2, DM}; pg8::StaticOrder S; S.init(M, DFF2, F.G, (int)blockIdx.x);
        pg8::EpiUp E{UPB, DFF2, SSQ, 1.0f / DM, RMS_EPS};
        pg8::gemm_phase<pg8::EpiUp, pg8::StaticOrder, PG8_ALIGN, PG8_SP2>(F.lds + RING_OFF, g, S, E);
        if (BOTH(7)) GRID_BAR();
    }

    if (IN(8)) {
        constexpr int NCC = DFF / 8, RUN = 32, NRUN = M / RUN;
        for (int it = gt; it < NCC * NRUN; it += NGT) {
            const int cc = it % NCC, rr = it / NCC, j0 = cc * 8, r0 = rr * RUN;
            float wg[3][8], wv[3][8], bg[8], bvv[8];
#pragma unroll
            for (int k = 0; k < 3; ++k)
#pragma unroll
                for (int e = 0; e < 8; ++e) { wg[k][e] = conv_w[(size_t)k * DFF2 + j0 + e]; wv[k][e] = conv_w[(size_t)k * DFF2 + DFF + j0 + e]; }
#pragma unroll
            for (int e = 0; e < 8; ++e) { bg[e] = conv_b[j0 + e]; bvv[e] = conv_b[DFF + j0 + e]; }
            float g1[8], g2[8], v1[8], v2[8];
#pragma unroll
            for (int e = 0; e < 8; ++e) { g1[e] = 0.f; g2[e] = 0.f; v1[e] = 0.f; v2[e] = 0.f; }
            if ((r0 % SEQ) != 0) {
                const v4u a1 = *(const GAS v4u*)(UPB + (size_t)(r0 - 1) * DFF2 + j0), a2 = *(const GAS v4u*)(UPB + (size_t)(r0 - 2) * DFF2 + j0);
                const v4u c1 = *(const GAS v4u*)(UPB + (size_t)(r0 - 1) * DFF2 + DFF + j0), c2 = *(const GAS v4u*)(UPB + (size_t)(r0 - 2) * DFF2 + DFF + j0);
                g1[0] = bf_lo(a1.x); g1[1] = bf_hi(a1.x); g1[2] = bf_lo(a1.y); g1[3] = bf_hi(a1.y); g1[4] = bf_lo(a1.z); g1[5] = bf_hi(a1.z); g1[6] = bf_lo(a1.w); g1[7] = bf_hi(a1.w);
                g2[0] = bf_lo(a2.x); g2[1] = bf_hi(a2.x); g2[2] = bf_lo(a2.y); g2[3] = bf_hi(a2.y); g2[4] = bf_lo(a2.z); g2[5] = bf_hi(a2.z); g2[6] = bf_lo(a2.w); g2[7] = bf_hi(a2.w);
                v1[0] = bf_lo(c1.x); v1[1] = bf_hi(c1.x); v1[2] = bf_lo(c1.y); v1[3] = bf_hi(c1.y); v1[4] = bf_lo(c1.z); v1[5] = bf_hi(c1.z); v1[6] = bf_lo(c1.w); v1[7] = bf_hi(c1.w);
                v2[0] = bf_lo(c2.x); v2[1] = bf_hi(c2.x); v2[2] = bf_lo(c2.y); v2[3] = bf_hi(c2.y); v2[4] = bf_lo(c2.z); v2[5] = bf_hi(c2.z); v2[6] = bf_lo(c2.w); v2[7] = bf_hi(c2.w);
            }
            for (int r = r0; r < r0 + RUN; ++r) {
                const v4u a0 = *(const GAS v4u*)(UPB + (size_t)r * DFF2 + j0), c0 = *(const GAS v4u*)(UPB + (size_t)r * DFF2 + DFF + j0);
                float g0[8], v0[8], o[8];
                g0[0] = bf_lo(a0.x); g0[1] = bf_hi(a0.x); g0[2] = bf_lo(a0.y); g0[3] = bf_hi(a0.y); g0[4] = bf_lo(a0.z); g0[5] = bf_hi(a0.z); g0[6] = bf_lo(a0.w); g0[7] = bf_hi(a0.w);
                v0[0] = bf_lo(c0.x); v0[1] = bf_hi(c0.x); v0[2] = bf_lo(c0.y); v0[3] = bf_hi(c0.y); v0[4] = bf_lo(c0.z); v0[5] = bf_hi(c0.z); v0[6] = bf_lo(c0.w); v0[7] = bf_hi(c0.w);
#pragma unroll
                for (int e = 0; e < 8; ++e) {
                    const float cg = g0[e] * wg[2][e] + g1[e] * wg[1][e] + g2[e] * wg[0][e] + bg[e];
                    const float cv = v0[e] * wv[2][e] + v1[e] * wv[1][e] + v2[e] * wv[0][e] + bvv[e];
                    o[e] = cg * __builtin_amdgcn_rcpf(1.0f + __builtin_amdgcn_exp2f(-LOG2E * cg)) * cv;
                    g2[e] = g1[e]; g1[e] = g0[e]; v2[e] = v1[e]; v1[e] = v0[e]; }
                v4u w; w.x = pk2(o[0], o[1]); w.y = pk2(o[2], o[3]); w.z = pk2(o[4], o[5]); w.w = pk2(o[6], o[7]);
                *(GAS v4u*)(ACT + (size_t)r * DFF + j0) = w;
            }
        }
        if (BOTH(8)) GRID_BAR();
    }

    if (IN(9)) {
        pg8::Gemm g{ACT, Wt_down, M, DM, DFF}; pg8::StaticOrder S; S.init(M, DM, F.G, (int)blockIdx.x);
        pg8::EpiResid2 E{out, DM};
        pg8::gemm_phase<pg8::EpiResid2, pg8::StaticOrder, PG8_ALIGN, PG8_SP2>(F.lds + RING_OFF, g, S, E);
        if (BOTH(9)) GRID_BAR();
    }

    if (IN(10)) {
        for (int m = gw; m < M; m += NGW) {
            GAS f32x4* xr = (GAS f32x4*)(out + (size_t)m * DM) + F.lane; const GAS f32x4* gr = (const GAS f32x4*)norm_final + F.lane;
            f32x4 v[8]; float s = 0.f;
#pragma unroll
            for (int j = 0; j < 8; ++j) { v[j] = xr[64 * j]; s += (v[j].x * v[j].x + v[j].y * v[j].y) + (v[j].z * v[j].z + v[j].w * v[j].w); }
            const float rstd = 1.0f / sqrtf(wave_sum(s) * (1.f / DM) + RMS_EPS);
#pragma unroll
            for (int j = 0; j < 8; ++j) xr[64 * j] = v[j] * rstd * gr[64 * j];
        }
    }
#undef IN
#undef BOTH
}

extern "C" void kernel_launch(void* const* d_in, const int* in_sizes, int n_in, void* d_out, int out_size, void* d_ws, size_t ws_size, hipStream_t stream) {
    static int grid = 0;
    if (grid == 0) {
        if (n_in != 23 || in_sizes[0] != M * DM || out_size != M * DM || ws_size < WS_END) { fprintf(stderr, "kernel_launch: unexpected shapes: n_in %d in0 %d out %d ws %zu (need %zu); nothing launched\n", n_in, n_in > 0 ? in_sizes[0] : -1, out_size, ws_size, (size_t)WS_END); grid = -1; return; }
        int dev = 0, cus = 0, per_cu = 0;
        if (hipGetDevice(&dev) != hipSuccess || hipDeviceGetAttribute(&cus, hipDeviceAttributeMultiprocessorCount, dev) != hipSuccess) { fprintf(stderr, "kernel_launch: device query failed\n"); grid = -1; return; }
        if (hipFuncSetAttribute((const void*)skel_fwd, hipFuncAttributeMaxDynamicSharedMemorySize, LDS_BYTES) != hipSuccess) { fprintf(stderr, "kernel_launch: hipFuncSetAttribute failed\n"); grid = -1; return; }
        if (hipOccupancyMaxActiveBlocksPerMultiprocessor(&per_cu, (const void*)skel_fwd, NWAVES * 64, LDS_BYTES) != hipSuccess || per_cu < 1)
            fprintf(stderr, "kernel_launch: note: occupancy query reports %d workgroups per CU\n", per_cu);
        (void)hipGetLastError();
        grid = cus;
    }
    if (grid < 0) return;
    if (hipMemsetAsync((char*)d_ws + WS_CTL, 0, CTL_ZERO_BYTES, stream) != hipSuccess) { fprintf(stderr, "kernel_launch: hipMemsetAsync failed\n"); return; }
    Args a{};
    for (int i = 0; i < 23; ++i) a.in[i] = (const float*)d_in[i];
    a.out = (float*)d_out; a.ws = (unsigned char*)d_ws;
    for (int li = 0; li < N_LAUNCHES; ++li) {
        a.ph_lo = (N_LAUNCHES == 1) ? 0 : li; a.ph_hi = (N_LAUNCHES == 1) ? NPH : li + 1; a.li = li;
        hipLaunchKernelGGL(skel_fwd, dim3(grid), dim3(NWAVES * 64), LDS_BYTES, stream, a);
        const hipError_t le = hipPeekAtLastError();
        if (le != hipSuccess) { fprintf(stderr, "kernel_launch: launch %d failed: %s\n", li, hipGetErrorName(le)); break; }
    }
}
```

```cpp
#ifndef SSM_FAST
#define SSM_FAST 1
#endif
#include <hip/hip_runtime.h>
#include <cstdio>
#include <cstdint>
namespace pg8 {
#define PG8_LAS __attribute__((address_space(3)))
typedef unsigned short bf16_t;
typedef short bf16x8 __attribute__((ext_vector_type(8)));
typedef float f32x4 __attribute__((ext_vector_type(4)));
typedef unsigned u32x4 __attribute__((ext_vector_type(4)));
constexpr int BM = 256, BK = 64, HALF = 128, HTB = HALF * BK * 2  , STAGE_BYTES = 8 * HTB, NXCD = 8, WGM = 8;

__host__ __device__ __forceinline__ int lds_byte(int r, int c) { const int st = (r >> 4) * 2 + (c >> 5), rr = r & 15, cc = c & 31, ob = rr * 64 + cc * 2; return st * 1024 + (ob ^ (((ob >> 9) & 1) << 5)); }
__host__ __device__ __forceinline__ void stage_rc(int b, int& R, int& C) { const int st = b / 1024, sb = b % 1024, swz = sb ^ (((sb >> 9) & 1) << 5); R = (st >> 1) * 16 + swz / 64; C = (st & 1) * 32 + (swz % 64) / 2; }
__host__ __device__ __forceinline__ int perm32(int rho) { const int n = rho >> 4, i = rho & 15; return 8 * (i >> 2) + 4 * n + (i & 3); }

struct Unit { int pm, pn; };
struct Gemm { const bf16_t* A; const bf16_t* Bt; int M, N, K; int lda, ldb; };

struct StaticOrder {
    int nM, nN, nwg, G, c;
    __host__ __device__ void init(int M, int N, int G_, int c_) { nM = M / BM; nN = N / BM; nwg = nM * nN; G = G_; c = c_; }
    __host__ __device__ bool next(int i, Unit& u) const {
        const long L = (long)i * G + c; if (L >= nwg) return false;
        int wgid = (int)L; { const int q = nwg / NXCD, r = nwg % NXCD, xcd = wgid % NXCD, off = wgid / NXCD; wgid = (xcd < r ? xcd * (q + 1) : r * (q + 1) + (xcd - r) * q) + off; }
        const int nig = WGM * nN, gid = wgid / nig, fm = gid * WGM, gsz = (nM - fm) < WGM ? (nM - fm) : WGM;
        u.pm = fm + ((wgid % nig) % gsz); u.pn = (wgid % nig) / gsz; return true;
    }
    __device__ __forceinline__ void a_ready(const Unit&) const {}
    __device__ __forceinline__ void done(const Unit&) const {}
};

__device__ __forceinline__ unsigned cvt_pk_bf16(float lo, float hi) { unsigned r; asm volatile("v_cvt_pk_bf16_f32 %0, %1, %2" : "=v"(r) : "v"(lo), "v"(hi)); return r; }
typedef float f32x2 __attribute__((ext_vector_type(2)));
__device__ __forceinline__ f32x2 gelu_pk(f32x2 v) {
    const f32x2 av = __builtin_elementwise_abs(v), d = av * 0.2316418882f + 1.0f;
    f32x2 t; t.x = __builtin_amdgcn_rcpf(d.x); t.y = __builtin_amdgcn_rcpf(d.y);
    f32x2 q = t * 0.5307027145f + (-0.7265760135f); q = q * t + 0.7107068705f; q = q * t + (-0.142248368f); q = q * t + 0.127414796f; q = q * t;
    const f32x2 s = (v * v) * (-0.72134752044f);
    f32x2 e; e.x = __builtin_amdgcn_exp2f(s.x); e.y = __builtin_amdgcn_exp2f(s.y);
    const f32x2 m = v * (q * e), r = v - m;
    f32x2 o; o.x = v.x < 0.f ? m.x : r.x; o.y = v.y < 0.f ? m.y : r.y; return o;
}

template <int ACT  > struct EpiBf16 {
    static constexpr bool PERM = true, AFTER_DRAIN = false; static_assert(ACT == 0 || ACT == 1, "EpiBf16: ACT is 0 (none) or 1 (gelu_pk)");
    bf16_t* O; int ldc; const float* bias; int split_cols; size_t split_stride; float scale0;
    __device__ __forceinline__ void operator()(const f32x4 (&acc)[2][2][4][2], const Unit& u, int wr, int wc, int fr, int fq) const {
        const int row0 = u.pm * BM + wr * 64 + fr; int colt = u.pn * BM; bf16_t* base = O;
        float sc = 1.f; if (split_cols) { const int t = colt / split_cols; base += (size_t)t * split_stride; colt -= t * split_cols; if (t == 0) sc = scale0; }
        const int col0 = colt + wc * 32 + 8 * fq, bcol0 = u.pn * BM + wc * 32 + 8 * fq;
        f32x4 bv[2][2];
#pragma unroll
        for (int bj = 0; bj < 2; ++bj)
#pragma unroll
            for (int n = 0; n < 2; ++n) bv[bj][n] = bias ? *(const f32x4*)(bias + bcol0 + bj * HALF + 4 * n) : (f32x4){0.f, 0.f, 0.f, 0.f};
#pragma unroll
        for (int ai = 0; ai < 2; ++ai)
#pragma unroll
            for (int m = 0; m < 4; ++m) { bf16_t* rowp = base + (size_t)(row0 + ai * HALF + m * 16) * ldc + col0;
#pragma unroll
                for (int bj = 0; bj < 2; ++bj) { f32x4 v0 = acc[ai][bj][m][0] + bv[bj][0], v1 = acc[ai][bj][m][1] + bv[bj][1];
                    if (ACT == 1) { f32x2 a = gelu_pk((f32x2){v0[0], v0[1]}), b = gelu_pk((f32x2){v0[2], v0[3]}), c = gelu_pk((f32x2){v1[0], v1[1]}), d = gelu_pk((f32x2){v1[2], v1[3]});
                        v0 = (f32x4){a.x, a.y, b.x, b.y}; v1 = (f32x4){c.x, c.y, d.x, d.y}; }
                    v0 = v0 * sc; v1 = v1 * sc; u32x4 w; w.x = cvt_pk_bf16(v0[0], v0[1]); w.y = cvt_pk_bf16(v0[2], v0[3]); w.z = cvt_pk_bf16(v1[0], v1[1]); w.w = cvt_pk_bf16(v1[2], v1[3]);
                    *(u32x4*)(rowp + bj * HALF) = w; } }
    }
};

__device__ __forceinline__ float bf_lo(unsigned w) { return __uint_as_float(w << 16); }
__device__ __forceinline__ float bf_hi(unsigned w) { return __uint_as_float(w & 0xffff0000u); }
__device__ __forceinline__ float sigmoid_f(float v) { return __builtin_amdgcn_rcpf(1.0f + __builtin_amdgcn_exp2f(-1.4426950408889634f * v)); }
struct EpiGlu {
    static constexpr bool PERM = true, AFTER_DRAIN = false;
    const bf16_t* Y; bf16_t* Z; int ldc; const float* bias;
    __device__ __forceinline__ void operator()(const f32x4 (&acc)[2][2][4][2], const Unit& u, int wr, int wc, int fr, int fq) const {
        const int row0 = u.pm * BM + wr * 64 + fr, col0 = u.pn * BM + wc * 32 + 8 * fq;
        f32x4 bv[2][2];
#pragma unroll
        for (int bj = 0; bj < 2; ++bj)
#pragma unroll
            for (int n = 0; n < 2; ++n) bv[bj][n] = *(const f32x4*)(bias + col0 + bj * HALF + 4 * n);
#pragma unroll
        for (int ai = 0; ai < 2; ++ai)
#pragma unroll
            for (int m = 0; m < 4; ++m) { const size_t off = (size_t)(row0 + ai * HALF + m * 16) * ldc + col0;
#pragma unroll
                for (int bj = 0; bj < 2; ++bj) { const u32x4 yv = *(const u32x4*)(Y + off + bj * HALF);
                    const f32x4 v0 = acc[ai][bj][m][0] + bv[bj][0], v1 = acc[ai][bj][m][1] + bv[bj][1];
                    u32x4 w;
                    w.x = cvt_pk_bf16(bf_lo(yv.x) * sigmoid_f(v0[0]), bf_hi(yv.x) * sigmoid_f(v0[1]));
                    w.y = cvt_pk_bf16(bf_lo(yv.y) * sigmoid_f(v0[2]), bf_hi(yv.y) * sigmoid_f(v0[3]));
                    w.z = cvt_pk_bf16(bf_lo(yv.z) * sigmoid_f(v1[0]), bf_hi(yv.z) * sigmoid_f(v1[1]));
                    w.w = cvt_pk_bf16(bf_lo(yv.w) * sigmoid_f(v1[2]), bf_hi(yv.w) * sigmoid_f(v1[3]));
                    *(u32x4*)(Z + off + bj * HALF) = w; } }
    }
};
struct EpiResid1 {
    static constexpr bool PERM = true, AFTER_DRAIN = false;
    const float* X; float* X1; bf16_t* X1G; const float* gw; float* ssq; int ldc;
    __device__ __forceinline__ void operator()(const f32x4 (&acc)[2][2][4][2], const Unit& u, int wr, int wc, int fr, int fq) const {
        const int row0 = u.pm * BM + wr * 64 + fr, col0 = u.pn * BM + wc * 32 + 8 * fq;
        f32x4 gv[2][2];
#pragma unroll
        for (int bj = 0; bj < 2; ++bj)
#pragma unroll
            for (int n = 0; n < 2; ++n) gv[bj][n] = *(const f32x4*)(gw + col0 + bj * HALF + 4 * n);
#pragma unroll
        for (int ai = 0; ai < 2; ++ai)
#pragma unroll
            for (int m = 0; m < 4; ++m) { const int row = row0 + ai * HALF + m * 16; const size_t off = (size_t)row * ldc + col0; float s = 0.f;
#pragma unroll
                for (int bj = 0; bj < 2; ++bj) {
                    const f32x4 v0 = *(const f32x4*)(X + off + bj * HALF) + acc[ai][bj][m][0], v1 = *(const f32x4*)(X + off + bj * HALF + 4) + acc[ai][bj][m][1];
                    *(f32x4*)(X1 + off + bj * HALF) = v0; *(f32x4*)(X1 + off + bj * HALF + 4) = v1;
                    s += (v0[0] * v0[0] + v0[1] * v0[1]) + (v0[2] * v0[2] + v0[3] * v0[3]) + (v1[0] * v1[0] + v1[1] * v1[1]) + (v1[2] * v1[2] + v1[3] * v1[3]);
                    const f32x4 g0 = v0 * gv[bj][0], g1 = v1 * gv[bj][1]; u32x4 w;
                    w.x = cvt_pk_bf16(g0[0], g0[1]); w.y = cvt_pk_bf16(g0[2], g0[3]); w.z = cvt_pk_bf16(g1[0], g1[1]); w.w = cvt_pk_bf16(g1[2], g1[3]);
                    *(u32x4*)(X1G + off + bj * HALF) = w; }
                s += __shfl_xor(s, 16); s += __shfl_xor(s, 32);
                if (fq == 0) ssq[(size_t)row * 32 + u.pn * 4 + wc] = s; }
    }
};
struct EpiUp {
    static constexpr bool PERM = true, AFTER_DRAIN = false;
    bf16_t* O; int ldc; const float* ssq; float inv_n, eps;
    __device__ __forceinline__ void operator()(const f32x4 (&acc)[2][2][4][2], const Unit& u, int wr, int wc, int fr, int fq) const {
        const int row0 = u.pm * BM + wr * 64 + fr, col0 = u.pn * BM + wc * 32 + 8 * fq;
#pragma unroll
        for (int ai = 0; ai < 2; ++ai)
#pragma unroll
            for (int m = 0; m < 4; ++m) { const int row = row0 + ai * HALF + m * 16; const f32x4* sp = (const f32x4*)(ssq + (size_t)row * 32);
                f32x4 t = sp[0];
#pragma unroll
                for (int k = 1; k < 8; ++k) t += sp[k];
                const float rstd = __builtin_amdgcn_rsqf(((t[0] + t[1]) + (t[2] + t[3])) * inv_n + eps);
                bf16_t* rowp = O + (size_t)row * ldc + col0;
#pragma unroll
                for (int bj = 0; bj < 2; ++bj) { const f32x4 v0 = acc[ai][bj][m][0] * rstd, v1 = acc[ai][bj][m][1] * rstd; u32x4 w;
                    w.x = cvt_pk_bf16(v0[0], v0[1]); w.y = cvt_pk_bf16(v0[2], v0[3]); w.z = cvt_pk_bf16(v1[0], v1[1]); w.w = cvt_pk_bf16(v1[2], v1[3]);
                    *(u32x4*)(rowp + bj * HALF) = w; } }
    }
};
struct EpiResid2 {
    static constexpr bool PERM = true, AFTER_DRAIN = false;
    float* OUT; int ldc;
    __device__ __forceinline__ void operator()(const f32x4 (&acc)[2][2][4][2], const Unit& u, int wr, int wc, int fr, int fq) const {
        const int row0 = u.pm * BM + wr * 64 + fr, col0 = u.pn * BM + wc * 32 + 8 * fq;
#pragma unroll
        for (int ai = 0; ai < 2; ++ai)
#pragma unroll
            for (int m = 0; m < 4; ++m) { float* rowp = OUT + (size_t)(row0 + ai * HALF + m * 16) * ldc + col0;
#pragma unroll
                for (int bj = 0; bj < 2; ++bj) { f32x4* p = (f32x4*)(rowp + bj * HALF); const f32x4 a = p[0], b = p[1]; p[0] = a + acc[ai][bj][m][0]; p[1] = b + acc[ai][bj][m][1]; } }
    }
};
__device__ __forceinline__ float gelu_tanh_f(float y) {
    const float u = 0.7978845608028654f * (y + 0.044715f * y * y * y);
    const float e = __builtin_amdgcn_exp2f(2.0f * 1.4426950408889634f * u);
    return 0.5f * y * (2.0f - 2.0f * __builtin_amdgcn_rcpf(e + 1.0f));
}
struct EpiQKVU {
    static constexpr bool PERM = true, AFTER_DRAIN = false;
    bf16_t* Q; size_t split_stride; bf16_t* A2; float scale0;
    __device__ __forceinline__ void operator()(const f32x4 (&acc)[2][2][4][2], const Unit& u, int wr, int wc, int fr, int fq) const {
        const int row0 = u.pm * BM + wr * 64 + fr; const int colt = u.pn * BM, t = colt >> 10, col0 = (colt & 1023) + wc * 32 + 8 * fq;
        const float sc = (t == 0) ? scale0 : 1.f;
#pragma unroll
        for (int ai = 0; ai < 2; ++ai)
#pragma unroll
            for (int m = 0; m < 4; ++m) { const int row = row0 + ai * HALF + m * 16;
#pragma unroll
                for (int bj = 0; bj < 2; ++bj) { const int c = col0 + bj * HALF; const f32x4 v0 = acc[ai][bj][m][0] * sc, v1 = acc[ai][bj][m][1] * sc; u32x4 w;
                    w.x = cvt_pk_bf16(v0[0], v0[1]); w.y = cvt_pk_bf16(v0[2], v0[3]); w.z = cvt_pk_bf16(v1[0], v1[1]); w.w = cvt_pk_bf16(v1[2], v1[3]);
                    if (t < 3) *(u32x4*)(Q + (size_t)t * split_stride + (size_t)row * 1024 + c) = w;
                    else { const int b = row >> 12, tok = row & 4095; *(u32x4*)(A2 + ((size_t)((c >> 4) * 256 + b * 128 + (tok >> 5)) * 640 + (tok & 31) * 16 + (c & 15))) = w; } } }
    }
};
struct EpiS {
    static constexpr bool PERM = false, AFTER_DRAIN = false;
    float* S;
    __device__ __forceinline__ void operator()(const f32x4 (&acc)[2][2][4][2], const Unit& u, int wr, int wc, int fr, int fq) const {
        const int row0 = wr * 64 + fr, col0 = wc * 32 + 4 * fq;
#pragma unroll
        for (int ai = 0; ai < 2; ++ai)
#pragma unroll
            for (int m = 0; m < 4; ++m) { float* rowp = S + ((size_t)u.pm * 256 + row0 + ai * HALF + m * 16) * 128 + col0;
#pragma unroll
                for (int n = 0; n < 2; ++n) *(f32x4*)(rowp + n * 16) = acc[ai][0][m][n]; }
    }
};
struct EpiY {
    static constexpr bool PERM = true, AFTER_DRAIN = false;
    bf16_t* Y;
    __device__ __forceinline__ void operator()(const f32x4 (&acc)[2][2][4][2], const Unit& u, int wr, int wc, int fr, int fq) const {
        const int row0 = wr * 64 + fr, col0 = (u.pn & 1) * BM + wc * 32 + 8 * fq, g = u.pm;
#pragma unroll
        for (int ai = 0; ai < 2; ++ai)
#pragma unroll
            for (int m = 0; m < 4; ++m) { const int R = row0 + ai * HALF + m * 16, b = R >> 7, c = R & 127;
#pragma unroll
                for (int bj = 0; bj < 2; ++bj) { const int cl = col0 + bj * HALF, t = cl >> 4, h0 = cl & 15; const f32x4 v0 = acc[ai][bj][m][0], v1 = acc[ai][bj][m][1]; u32x4 w;
                    w.x = cvt_pk_bf16(gelu_tanh_f(v0[0]), gelu_tanh_f(v0[1])); w.y = cvt_pk_bf16(gelu_tanh_f(v0[2]), gelu_tanh_f(v0[3]));
                    w.z = cvt_pk_bf16(gelu_tanh_f(v1[0]), gelu_tanh_f(v1[1])); w.w = cvt_pk_bf16(gelu_tanh_f(v1[2]), gelu_tanh_f(v1[3]));
                    *(u32x4*)(Y + (size_t)(b * 4096 + c * 32 + t) * 1024 + g * 16 + h0) = w; } }
    }
};
struct GroupOrder {
    int g, nu, pn0;
    __device__ __forceinline__ bool next(int i, Unit& u) const { if (i >= nu) return false; u.pm = g; u.pn = pn0 + i; return true; }
    __device__ __forceinline__ void a_ready(const Unit&) const {}
    __device__ __forceinline__ void done(const Unit&) const {}
};
template <class Epi, class Sched, bool ALIGN_EPI = false, bool SP2 = false>
__device__ __forceinline__ void gemm_phase(PG8_LAS unsigned char* lds, const Gemm g, const Sched& S, const Epi& E) {
    const int tid = threadIdx.x, wid = __builtin_amdgcn_readfirstlane(tid >> 6), lane = tid & 63, wr = wid >> 2, wc = wid & 3, fr = lane & 15, fq = lane >> 4;
    const int K = g.K, nt = K / BK, lda = g.lda ? g.lda : K, ldb = g.ldb ? g.ldb : K;
    unsigned voffA[2], voffB[2];
#pragma unroll
    for (int i = 0; i < 2; ++i) { int R, C; stage_rc(tid * 16 + i * 8192, R, C); const int Rb = Epi::PERM ? ((R & ~31) + perm32(R & 31)) : R;
        voffA[i] = (unsigned)(R * lda + C) * 2u; voffB[i] = (unsigned)(Rb * ldb + C) * 2u; }
    const size_t kstep = (size_t)(BK * 2);
    const size_t hstepA = (size_t)HALF * lda * 2, hstepB = (size_t)HALF * ldb * 2;
    const size_t tstepA = 2 * hstepA, tstepB = 2 * hstepB;
    const unsigned ldsw = (unsigned)wid * 1024u;
    const int aoff = lds_byte(wr * 64 + fr, fq * 8), boff = lds_byte(wc * 32 + fr, fq * 8);
#define PG8_SA(b, h) (((b) * 2 + (h)) * HTB)
#define PG8_SB(b, h) ((4 + (b) * 2 + (h)) * HTB)
#define PG8_STAGE(bufoff, gbase, voff) do { _Pragma("unroll") for (int _i = 0; _i < 2; ++_i) \
        __builtin_amdgcn_global_load_lds((const unsigned*)((const char*)(gbase) + (voff)[_i]), (PG8_LAS unsigned*)(lds + (bufoff) + ldsw + _i * 8192), 16, 0, 0); } while (0)
#define PG8_LDA(dst, b, h) do { _Pragma("unroll") for (int m = 0; m < 4; ++m) _Pragma("unroll") for (int k = 0; k < 2; ++k) dst[m][k] = *(const PG8_LAS bf16x8*)(lds + PG8_SA(b, h) + aoff + m * 2048 + k * 1024); } while (0)
#define PG8_LDB(dst, b, h) do { _Pragma("unroll") for (int n = 0; n < 2; ++n) _Pragma("unroll") for (int k = 0; k < 2; ++k) dst[n][k] = *(const PG8_LAS bf16x8*)(lds + PG8_SB(b, h) + boff + n * 2048 + k * 1024); } while (0)
#define PG8_MMA(ai, bj, At, Bt) do { __builtin_amdgcn_s_setprio(1); _Pragma("unroll") for (int m = 0; m < 4; ++m) _Pragma("unroll") for (int n = 0; n < 2; ++n) _Pragma("unroll") for (int k = 0; k < 2; ++k) \
        acc[ai][bj][m][n] = __builtin_amdgcn_mfma_f32_16x16x32_bf16(Bt[n][k], At[m][k], acc[ai][bj][m][n], 0, 0, 0); __builtin_amdgcn_s_setprio(0); } while (0)
#define PG8_WAIT_V(n) asm volatile("s_waitcnt vmcnt(" #n ")" ::: "memory")
#define PG8_WAIT_L(n) asm volatile("s_waitcnt lgkmcnt(" #n ")" ::: "memory")
#define PG8_BAR __builtin_amdgcn_s_barrier()
#define PG8_SCHED __builtin_amdgcn_sched_barrier(0)
    Unit cur, nxt; int ui = 0;
    if (!S.next(0, cur)) return;
    f32x4 acc[2][2][4][2];
#pragma unroll
    for (int a = 0; a < 2; ++a)
#pragma unroll
        for (int b = 0; b < 2; ++b)
#pragma unroll
            for (int m = 0; m < 4; ++m)
#pragma unroll
                for (int n = 0; n < 2; ++n) acc[a][b][m][n] = (f32x4){0.f, 0.f, 0.f, 0.f};
    bf16x8 At[4][2], B0[2][2], B1[2][2];
    const char* cA = (const char*)g.A + (size_t)cur.pm * tstepA; const char* cB = (const char*)g.Bt + (size_t)cur.pn * tstepB;
    S.a_ready(cur);
    if constexpr (SP2) {
        PG8_STAGE(PG8_SB(0, 0), cB, voffB); PG8_STAGE(PG8_SB(0, 1), cB + hstepB, voffB); PG8_STAGE(PG8_SA(0, 0), cA, voffA); PG8_STAGE(PG8_SA(0, 1), cA + hstepA, voffA);
        if (wr == 1) PG8_BAR;
        PG8_WAIT_V(2); PG8_BAR;
        PG8_STAGE(PG8_SB(1, 0), cB + kstep, voffB); PG8_STAGE(PG8_SA(1, 0), cA + kstep, voffA); PG8_STAGE(PG8_SB(1, 1), cB + hstepB + kstep, voffB);
        PG8_WAIT_V(6); PG8_BAR;
    } else {
        PG8_STAGE(PG8_SB(0, 0), cB, voffB); PG8_STAGE(PG8_SA(0, 0), cA, voffA); PG8_STAGE(PG8_SB(0, 1), cB + hstepB, voffB); PG8_STAGE(PG8_SA(0, 1), cA + hstepA, voffA);
        if (wr == 1) PG8_BAR;
        PG8_WAIT_V(4); PG8_BAR;
        PG8_STAGE(PG8_SB(1, 0), cB + kstep, voffB); PG8_STAGE(PG8_SA(1, 0), cA + kstep, voffA); PG8_STAGE(PG8_SB(1, 1), cB + hstepB + kstep, voffB);
        PG8_WAIT_V(6); PG8_BAR;
    }
    for (;;) {
        const bool has_next = S.next(ui + 1, nxt);
        const char* nA = has_next ? (const char*)g.A + (size_t)nxt.pm * tstepA : cA; const char* nB = has_next ? (const char*)g.Bt + (size_t)nxt.pn * tstepB : cB;
        for (int t = 0; t < nt; t += 2) {
            const bool last = (t == nt - 2);
            const char* a1 = cA + (size_t)(t + 1) * kstep;
            const char* a2 = last ? nA : cA + (size_t)(t + 2) * kstep; const char* b2 = last ? nB : cB + (size_t)(t + 2) * kstep;
            const char* a3 = a2 + kstep; const char* b3 = b2 + kstep;
            if (last && has_next) S.a_ready(nxt);
            if constexpr (SP2) {
            PG8_LDB(B0, 0, 0); PG8_LDB(B1, 0, 1); PG8_SCHED; PG8_LDA(At, 0, 0); PG8_STAGE(PG8_SA(1, 1), a1 + hstepA, voffA);
            PG8_WAIT_V(8); PG8_WAIT_L(0); PG8_BAR; PG8_MMA(0, 0, At, B0); PG8_MMA(0, 1, At, B1); PG8_BAR; PG8_SCHED;
            PG8_LDA(At, 0, 1); PG8_STAGE(PG8_SB(0, 0), b2, voffB); PG8_STAGE(PG8_SB(0, 1), b2 + hstepB, voffB); PG8_STAGE(PG8_SA(0, 0), a2, voffA);
            PG8_WAIT_V(8); PG8_WAIT_L(0); PG8_BAR; PG8_MMA(1, 0, At, B0); PG8_MMA(1, 1, At, B1); PG8_BAR; PG8_SCHED;
            PG8_LDB(B0, 1, 0); PG8_LDB(B1, 1, 1); PG8_SCHED; PG8_LDA(At, 1, 0); PG8_STAGE(PG8_SA(0, 1), a2 + hstepA, voffA);
            PG8_WAIT_V(8); PG8_WAIT_L(0); PG8_BAR; PG8_MMA(0, 0, At, B0); PG8_MMA(0, 1, At, B1); PG8_BAR; PG8_SCHED;
            PG8_LDA(At, 1, 1); PG8_STAGE(PG8_SB(1, 0), b3, voffB); PG8_STAGE(PG8_SB(1, 1), b3 + hstepB, voffB); PG8_STAGE(PG8_SA(1, 0), a3, voffA);
            PG8_WAIT_V(8); PG8_WAIT_L(0); PG8_BAR; PG8_MMA(1, 0, At, B0); PG8_MMA(1, 1, At, B1); PG8_BAR; PG8_SCHED;
            } else {
            PG8_LDB(B0, 0, 0); PG8_SCHED; PG8_LDA(At, 0, 0); PG8_STAGE(PG8_SA(1, 1), a1 + hstepA, voffA);
            PG8_WAIT_L(8); PG8_BAR; PG8_WAIT_L(0); PG8_MMA(0, 0, At, B0); PG8_BAR; PG8_SCHED;
            PG8_LDB(B1, 0, 1); PG8_STAGE(PG8_SB(0, 0), b2, voffB);
            PG8_BAR; PG8_WAIT_L(0); PG8_MMA(0, 1, At, B1); PG8_BAR;
            PG8_LDA(At, 0, 1); PG8_STAGE(PG8_SA(0, 0), a2, voffA);
            PG8_BAR; PG8_WAIT_L(0); PG8_MMA(1, 0, At, B0); PG8_BAR; PG8_SCHED;
            PG8_STAGE(PG8_SB(0, 1), b2 + hstepB, voffB);
            PG8_WAIT_V(6); PG8_BAR; PG8_MMA(1, 1, At, B1); PG8_BAR;
            PG8_LDB(B0, 1, 0); PG8_SCHED; PG8_LDA(At, 1, 0); PG8_STAGE(PG8_SA(0, 1), a2 + hstepA, voffA);
            PG8_WAIT_L(8); PG8_BAR; PG8_WAIT_L(0); PG8_MMA(0, 0, At, B0); PG8_BAR; PG8_SCHED;
            PG8_LDB(B1, 1, 1); PG8_STAGE(PG8_SB(1, 0), b3, voffB);
            PG8_BAR; PG8_WAIT_L(0); PG8_MMA(0, 1, At, B1); PG8_BAR;
            PG8_LDA(At, 1, 1); PG8_STAGE(PG8_SA(1, 0), a3, voffA);
            PG8_BAR; PG8_WAIT_L(0); PG8_MMA(1, 0, At, B0); PG8_BAR; PG8_SCHED;
            PG8_STAGE(PG8_SB(1, 1), b3 + hstepB, voffB);
            PG8_WAIT_V(6); PG8_BAR; PG8_MMA(1, 1, At, B1); PG8_BAR;
            }
        }
        if constexpr (ALIGN_EPI) { if (wr == 0) PG8_BAR; }
        if constexpr (!Epi::AFTER_DRAIN) { E(acc, cur, wr, wc, fr, fq); S.done(cur); }
        if (!has_next) break;
#pragma unroll
        for (int a = 0; a < 2; ++a)
#pragma unroll
            for (int b = 0; b < 2; ++b)
#pragma unroll
                for (int m = 0; m < 4; ++m)
#pragma unroll
                    for (int n = 0; n < 2; ++n) acc[a][b][m][n] = (f32x4){0.f, 0.f, 0.f, 0.f};
        cur = nxt; cA = nA; cB = nB; ++ui;
        if constexpr (ALIGN_EPI) { if (wr == 1) PG8_BAR; }
    }
    PG8_WAIT_V(0);
    if constexpr (!ALIGN_EPI) { if (wr == 0) PG8_BAR; }
    PG8_BAR;
    if constexpr (Epi::AFTER_DRAIN) { E.fused(acc, cur, wr, wc, fr, fq, lds, wid, lane); S.done(cur); }
#undef PG8_SA
#undef PG8_SB
#undef PG8_STAGE
#undef PG8_LDA
#undef PG8_LDB
#undef PG8_MMA
#undef PG8_WAIT_V
#undef PG8_WAIT_L
#undef PG8_BAR
#undef PG8_SCHED
}
}

#ifndef PG8_SP2
#define PG8_SP2 true
#endif
#ifndef PG8_ALIGN
#define PG8_ALIGN true
#endif
#include <cmath>

constexpr int NWAVES = 8;
constexpr int NPH = 11;
#ifndef MK_N_LAUNCHES
#define MK_N_LAUNCHES 1
#endif
constexpr int N_LAUNCHES = MK_N_LAUNCHES;
static_assert(N_LAUNCHES == 1 || N_LAUNCHES == NPH, "MK_N_LAUNCHES is 1 or NPH");

constexpr int BATCH = 2, SEQ = 4096, DM = 2048, M = BATCH * SEQ;
constexpr int AH = 16, HD = 64, AW = AH * HD;
constexpr int SG = 64, SC = 16, SW = SG * SC, SP = 64;
constexpr int INC = 3 * AW + SW;
constexpr int MOBA_BLK = 256, NBLK = SEQ / MOBA_BLK, TOPK = 3;
constexpr int DFF = 5632, DFF2 = 2 * DFF;
constexpr float RMS_EPS = 1e-6f;
constexpr float LOG2E = 1.4426950408889634f;
constexpr float C2 = 0.125f * LOG2E;

constexpr size_t MiB = 1u << 20;
constexpr size_t WS_CTL = 0, CTL_ZERO_BYTES = 1 * MiB;
constexpr size_t WS_WDOWN = 1 * MiB;
constexpr size_t WS_WIN = 23 * MiB;
constexpr size_t WS_WGLU = 39 * MiB;
constexpr size_t WS_WOUT = 41 * MiB;
constexpr size_t WS_WUP = 49 * MiB;
constexpr size_t WS_XN = 93 * MiB;
constexpr size_t WS_Q = 125 * MiB, WS_K = 141 * MiB, WS_V = 157 * MiB, WS_U = 173 * MiB;
constexpr size_t WS_Y = 189 * MiB, WS_Z = 205 * MiB;
constexpr size_t WS_UP = 125 * MiB;
constexpr size_t WS_X1G = 301 * MiB;
constexpr size_t WS_ACT = 23 * MiB;
constexpr size_t WS_SSQ = 333 * MiB;
constexpr size_t WS_KMEAN = 334 * MiB;
constexpr size_t WS_T5B = 335 * MiB;
constexpr size_t WS_A2 = 221 * MiB;
constexpr size_t WS_S = 241 * MiB;
constexpr size_t WS_BTS = 249 * MiB;
constexpr size_t WS_BT2 = 265 * MiB;
constexpr size_t WS_END = 336 * MiB;
static_assert(WS_ACT + (size_t)M * DFF * 2 <= WS_Q && WS_UP + (size_t)M * DFF2 * 2 <= WS_X1G && WS_WUP + (size_t)DFF2 * DM * 2 <= WS_XN, "d_ws map");
constexpr int CW_TMO = 0, CW_CODE = 1;
constexpr int CW_BAR = 4096;

constexpr int RING_OFF = 0, RING_BYTES = 131072;
constexpr int LDSCTL_OFF = RING_BYTES, MISC_OFF = LDSCTL_OFF + 320;
constexpr int LDS_BYTES = 147456;
static_assert(MISC_OFF + 128 <= LDS_BYTES, "LDS map");

#include <hip/hip_bf16.h>
#include <cmath>
namespace attn_body {
using bf16=__hip_bfloat16;
using bf16x8=__attribute__((ext_vector_type(8)))short;
using s16x4=__attribute__((ext_vector_type(4)))short;
using f32x16=__attribute__((ext_vector_type(16)))float;
using u32x4=__attribute__((ext_vector_type(4)))unsigned;
using f32x4_=__attribute__((ext_vector_type(4)))float;
constexpr int BATCH=2,NHEAD=16,SEQ=4096,D=64,DM=NHEAD*D;
constexpr int NW=8,QBLK=32,QB=QBLK*NW,KVBLK=64,NQB=SEQ/QB;
constexpr int ATTN_PITCH=DM, ATTN_UNIT_ROWS=QB;
__device__ __forceinline__ int crow(int r,int hi){return (r&3)+8*(r>>2)+4*hi;}
#define SBAR() __builtin_amdgcn_sched_barrier(0)
__device__ __forceinline__ void cmask(f32x16&p0,f32x16&p1,int jb,int qrel,int hi){
  const float NEG=-INFINITY; int kb=64*jb+4*hi;
  #pragma unroll
  for(int r=0;r<16;++r){int kv=kb+(r&3)+8*(r>>2); if(kv>qrel)p0[r]=NEG; if(kv+32>qrel)p1[r]=NEG;}
}

typedef __attribute__((address_space(3))) const float* lds_cfptr;
__device__ __forceinline__ void abias(f32x16&p0,f32x16&p1,int jb,int qrel,int hi,int wid,lds_cfptr Tp){
  if(32*wid-64*jb-63>=113)return;
  const lds_cfptr tb=Tp+(255-59+qrel-64*jb-4*hi);
  #pragma unroll
  for(int r=0;r<16;++r){ p0[r]+=tb[59-((r&3)+8*(r>>2))]; p1[r]+=tb[27-((r&3)+8*(r>>2))]; }
}
constexpr int NSLOT=3, SLOTB=8192;
constexpr int LDS_K=0, LDS_V=NSLOT*SLOTB, LDS_WS=2*NSLOT*SLOTB, LDS_OST=LDS_WS+NW*64*4, LDS_KM=LDS_OST+NW*4096, LDS_BIAS=LDS_KM+4096, LDS_BYTES=LDS_BIAS+2560;
constexpr float C2=0.125f*1.4426950408889634f;
__device__ __forceinline__ void glds16(const void*gsrc,unsigned lds_dst){unsigned keep;
  asm volatile("s_mov_b32 %0, m0\n\ts_mov_b32 m0, %2\n\ts_nop 0\n\tglobal_load_lds_dwordx4 %1, off\n\ts_mov_b32 m0, %0":"=&s"(keep):"v"(gsrc),"s"(lds_dst):"memory");}
__device__ __forceinline__ float max3f(float a,float b,float c){float r;asm("v_max3_f32 %0, %1, %2, %3":"=v"(r):"v"(a),"v"(b),"v"(c));return r;}
__device__ __forceinline__ float max2f(float a,float b){float r;asm("v_max_f32_e32 %0, %1, %2":"=v"(r):"v"(a),"v"(b));return r;}
__device__ __forceinline__ float fadd_s(float a,float b){float r;asm("v_add_f32_e32 %0, %1, %2":"=v"(r):"v"(a),"v"(b));return r;}
__device__ __forceinline__ float fsub_s(float a,float b){float r;asm("v_sub_f32_e32 %0, %1, %2":"=v"(r):"v"(a),"v"(b));return r;}
typedef float f32x2_t __attribute__((ext_vector_type(2))); typedef __bf16 bf16x2_t __attribute__((ext_vector_type(2)));
__device__ __forceinline__ unsigned cvtpk_s(float lo,float hi){f32x2_t v={lo,hi};bf16x2_t b=__builtin_convertvector(v,bf16x2_t);return __builtin_bit_cast(unsigned,b);}
#define WAIT_BAR(N) asm volatile("s_waitcnt vmcnt(" #N ") lgkmcnt(0)\n\ts_barrier":::"memory")

__device__ __forceinline__ void qkt(f32x16&p0,f32x16&p1,const char*Kslot,const bf16x8*qr,const f32x16&negm,int r32,int hi){
  const char*kb=Kslot+hi*1024+r32*16;
  #pragma unroll
  for(int d0=0;d0<4;++d0){
    const bf16x8 b0=*reinterpret_cast<const bf16x8*>(kb+d0*2048);
    const bf16x8 b1=*reinterpret_cast<const bf16x8*>(kb+d0*2048+512);
    if(d0==0){p0=__builtin_amdgcn_mfma_f32_32x32x16_bf16(b0,qr[0],negm,0,0,0);p1=__builtin_amdgcn_mfma_f32_32x32x16_bf16(b1,qr[0],negm,0,0,0);}
    else{p0=__builtin_amdgcn_mfma_f32_32x32x16_bf16(b0,qr[d0],p0,0,0,0);p1=__builtin_amdgcn_mfma_f32_32x32x16_bf16(b1,qr[d0],p1,0,0,0);}}
}
typedef __attribute__((address_space(3))) const char* lds_cptr;
typedef short v4i16_t __attribute__((ext_vector_type(4)));
__device__ __forceinline__ void kload8(bf16x8*kf,lds_cptr kp){
  kf[0]=*(const __attribute__((address_space(3))) bf16x8*)(kp);      kf[1]=*(const __attribute__((address_space(3))) bf16x8*)(kp+512);
  kf[2]=*(const __attribute__((address_space(3))) bf16x8*)(kp+2048); kf[3]=*(const __attribute__((address_space(3))) bf16x8*)(kp+2560);
  kf[4]=*(const __attribute__((address_space(3))) bf16x8*)(kp+4096); kf[5]=*(const __attribute__((address_space(3))) bf16x8*)(kp+4608);
  kf[6]=*(const __attribute__((address_space(3))) bf16x8*)(kp+6144); kf[7]=*(const __attribute__((address_space(3))) bf16x8*)(kp+6656);
}
__device__ __forceinline__ void kload2(bf16x8*kf,lds_cptr kp,int j){ kf[2*j]=*(const __attribute__((address_space(3))) bf16x8*)(kp+j*2048); kf[2*j+1]=*(const __attribute__((address_space(3))) bf16x8*)(kp+j*2048+512); }
__device__ __forceinline__ s16x4 vtr(lds_cptr p){ return __builtin_bit_cast(s16x4,__builtin_amdgcn_ds_read_tr16_b64_v4i16((__attribute__((address_space(3))) v4i16_t*)p)); }
__device__ __forceinline__ float rowmax(const f32x16&p0,const f32x16&p1){
  float a=max3f(p0[0],p0[1],p1[0]),b=max3f(p0[2],p0[3],p1[1]);a=max3f(a,p1[2],p1[3]);
  #pragma unroll
  for(int r=4;r<16;r+=4){a=max3f(a,p0[r],p0[r+1]);b=max3f(b,p0[r+2],p0[r+3]);a=max3f(a,p1[r],p1[r+1]);b=max3f(b,p1[r+2],p1[r+3]);}
  const float m=max2f(a,b);
  auto rr=__builtin_amdgcn_permlane32_swap(__float_as_uint(m),__float_as_uint(m),false,false);
  return max2f(__uint_as_float(rr[0]),__uint_as_float(rr[1]));
}
__device__ __forceinline__ void pv(f32x16*o,int vb,bf16x8 pa0,bf16x8 pa1,bf16x8 pa2,bf16x8 pa3){
  #pragma unroll
  for(int d0=0;d0<2;++d0){s16x4 lo[4],hi[4];
    #pragma unroll
    for(int ks=0;ks<4;++ks){
      asm volatile("ds_read_b64_tr_b16 %0,%1 offset:%c2":"=&v"(lo[ks]):"v"(vb),"i"(d0*4096+ks*1024):"memory");
      asm volatile("ds_read_b64_tr_b16 %0,%1 offset:%c2":"=&v"(hi[ks]):"v"(vb),"i"(d0*4096+ks*1024+512):"memory");}
    asm volatile("s_waitcnt lgkmcnt(0)":::"memory");SBAR();
    #define PK(k) (bf16x8){lo[k][0],lo[k][1],lo[k][2],lo[k][3],hi[k][0],hi[k][1],hi[k][2],hi[k][3]}
    o[d0]=__builtin_amdgcn_mfma_f32_32x32x16_bf16(pa0,PK(0),o[d0],0,0,0);
    o[d0]=__builtin_amdgcn_mfma_f32_32x32x16_bf16(pa1,PK(1),o[d0],0,0,0);
    o[d0]=__builtin_amdgcn_mfma_f32_32x32x16_bf16(pa2,PK(2),o[d0],0,0,0);
    o[d0]=__builtin_amdgcn_mfma_f32_32x32x16_bf16(pa3,PK(3),o[d0],0,0,0);
    #undef PK
  }
}

#ifndef ATTN_STORE16
#define ATTN_STORE16(p,v) (*(u32x4*)(p)=(v))
#endif
template<int THRL> __device__ __forceinline__ void attn_unit(int b,int h,int qb,const bf16*Q,const bf16*__restrict__ K,const bf16*__restrict__ V,bf16*O,const float*KM,const float*TB,char*shm){
  int tid_=threadIdx.x; asm volatile("":"+v"(tid_));
  const int tid=tid_,lane=tid&63,r32=lane&31,hi=lane>>5; const int wid=__builtin_amdgcn_readfirstlane(tid>>6);
  const long rowbase=(long)b*SEQ; const int q0=qb*QB;
  const bf16*Qw=Q+(rowbase+q0+wid*QBLK)*DM+h*D;
  const bf16*Kh=K+rowbase*DM+h*D,*Vh=V+rowbase*DM+h*D;
  const unsigned lds0=(unsigned)(uintptr_t)shm;
  float*wsf=(float*)(shm+LDS_WS)+wid*64;
  const bf16*ksrc=Kh+(long)lane*DM+wid*8;
  const bf16*vsrc=Vh+(long)(16*(wid&3)+(lane>>2))*DM+(wid>>2)*32+(lane&3)*8;
  const unsigned kdst=lds0+LDS_K+wid*1024, vdst=lds0+LDS_V+wid*1024;
  #define DMA_K(t,slot) glds16(ksrc+(long)(t)*KVBLK*DM,(unsigned)__builtin_amdgcn_readfirstlane(kdst+(slot)))
  #define DMA_V(t,slot) glds16(vsrc+(long)(t)*KVBLK*DM,(unsigned)__builtin_amdgcn_readfirstlane(vdst+(slot)))
  const int vb0=(int)(lds0+LDS_V)+((lane>>4)&1)*32+(lane&3)*8+(4*hi+((lane&15)>>2))*64;
  const char*Kbase=shm+LDS_K; bf16x8 kf[8];
  const lds_cptr shm3=(lds_cptr)shm; const lds_cptr kp0=shm3+LDS_K+hi*1024+r32*16; const lds_cptr vp0=shm3+LDS_V+((lane>>4)&1)*32+(lane&3)*8+(4*hi+((lane&15)>>2))*64;
  const int NT=(q0+QB)/KVBLK;
  DMA_K(0,0);DMA_V(0,0);DMA_K(1,SLOTB);
  bf16x8 qr[4];
  #pragma unroll
  for(int d0=0;d0<4;++d0)qr[d0]=*reinterpret_cast<const bf16x8*>(&Qw[(long)r32*DM+d0*16+hi*8]);
  { typedef float f32x2_ __attribute__((ext_vector_type(2))); int tid2=tid; asm volatile("":"+v"(tid2));
    *(__attribute__((address_space(3))) f32x2_*)((__attribute__((address_space(3))) char*)shm3+LDS_KM+tid2*8)=*(const f32x2_*)(KM+tid2*2);
    for(int i_=tid2;i_<640;i_+=512){ const int d_=i_-255; *(__attribute__((address_space(3))) float*)((__attribute__((address_space(3))) char*)shm3+LDS_BIAS+i_*4)=(d_>=0&&d_<128)?TB[d_]-TB[511]:0.f; } }
  const lds_cfptr Tb=(lds_cfptr)(shm3+LDS_BIAS);
  float mhat=0.f,l_reg=0.f;f32x16 o[2];o[0]=f32x16{};o[1]=f32x16{};f32x16 negm=f32x16{};asm volatile("":"+v"(negm));
  unsigned selm=1u<<qb;
  #define NEGM_SET(tn) do{ const float cv_=((selm>>((tn)>>2))&1u)?-mhat:-INFINITY; _Pragma("unroll") for(int r=0;r<16;++r)negm[r]=cv_; asm volatile("":"+v"(negm)); }while(0)
  const int qrel=wid*QBLK+r32;
  #define CMASK(P0,P1,t) do{int jb_=(t)-(NT-4); if(jb_>=-2){int q2_=qrel,h2_=hi; asm volatile("":"+v"(q2_),"+v"(h2_)); abias(P0,P1,jb_,q2_,h2_,wid,Tb);} if(jb_>=0)cmask(P0,P1,jb_,qrel,hi);}while(0)
  bool resc=false;
  #define START(P0,P1) do{ const float rm=rowmax(P0,P1); resc=false; \
    { const float dl=(rm>-1e30f)?rm:0.f; mhat=fadd_s(mhat,dl); \
      _Pragma("unroll") for(int r=0;r<16;++r){P0[r]=fsub_s(P0[r],dl);P1[r]=fsub_s(P1[r],dl);} \
      NEGM_SET(1); } \
    _Pragma("unroll") for(int r=0;r<16;++r)P0[r]=__builtin_amdgcn_exp2f(P0[r]); }while(0)
  #define RESC() do{ if(resc){ asm volatile("s_waitcnt lgkmcnt(0)":::"memory"); \
      _Pragma("unroll") for(int d_=0;d_<2;++d_) _Pragma("unroll") for(int r=0;r<16;++r)o[d_][r]*=wsf[crow(r,hi)]; } }while(0)
  f32x16 pA0,pA1,pB0,pB1;
  int sl_prev=0,sl_cur=0,sl_next=SLOTB;
  #define ROT() do{sl_prev=sl_cur;sl_cur=sl_next;sl_next=(sl_next==(NSLOT-1)*SLOTB)?0:sl_next+SLOTB;}while(0)
  DMA_K(2,2*SLOTB);
  WAIT_BAR(3);
  { float qf[32]; int hi2=hi; asm volatile("":"+v"(hi2));
    #pragma unroll
    for(int d0=0;d0<4;++d0)
      #pragma unroll
      for(int j=0;j<8;++j)qf[d0*8+j]=__uint_as_float(((unsigned)(unsigned short)qr[d0][j])<<16);
    float v1=-INFINITY,v2=-INFINITY,v3=-INFINITY; int i1=-1,i2=-1,i3=-1;
    const __attribute__((address_space(3))) float* kml=(const __attribute__((address_space(3))) float*)(shm3+LDS_KM)+8*hi2;
    for(int n=0;n<qb;++n){ float a=0.f;
      #pragma unroll
      for(int d0=0;d0<4;++d0){ const f32x4_ k0=*(const __attribute__((address_space(3))) f32x4_*)(kml+n*64+16*d0), k1=*(const __attribute__((address_space(3))) f32x4_*)(kml+n*64+16*d0+4);
        a+=qf[d0*8+0]*k0[0]+qf[d0*8+1]*k0[1]+qf[d0*8+2]*k0[2]+qf[d0*8+3]*k0[3]+qf[d0*8+4]*k1[0]+qf[d0*8+5]*k1[1]+qf[d0*8+6]*k1[2]+qf[d0*8+7]*k1[3]; }
      { auto rr=__builtin_amdgcn_permlane32_swap(__float_as_uint(a),__float_as_uint(a),false,false); a=__uint_as_float(rr[0])+__uint_as_float(rr[1]); }
      if(a>v1){v3=v2;i3=i2;v2=v1;i2=i1;v1=a;i1=n;} else if(a>v2){v3=v2;i3=i2;v2=a;i2=n;} else if(a>v3){v3=a;i3=n;} }
    if(i1>=0)selm|=1u<<i1; if(i2>=0)selm|=1u<<i2; if(i3>=0)selm|=1u<<i3; }
  NEGM_SET(0);
  qkt(pA0,pA1,Kbase,qr,negm,r32,hi);asm volatile("s_nop 15\n\ts_nop 7":"+v"(pA0),"+v"(pA1));CMASK(pA0,pA1,0);
  START(pA0,pA1);
  _Pragma("unroll") for(int r=0;r<16;++r)pA1[r]=__builtin_amdgcn_exp2f(pA1[r]);
  WAIT_BAR(0);
  DMA_K(3,0);DMA_V(1,SLOTB);
  ROT();
  kload8(kf,kp0+sl_cur);
  WAIT_BAR(2);
  s16x4 vlo[8],vhi[8]; u32x4 pw0,pw1,pw2,pw3;
  #define PKW(P,B) cvtpk_s(P[B],P[B+1])
  #define PAF(k) __builtin_bit_cast(bf16x8,pw##k)
  #define VFR(i) (bf16x8){vlo[i][0],vlo[i][1],vlo[i][2],vlo[i][3],vhi[i][0],vhi[i][1],vhi[i][2],vhi[i][3]}
  #define PIN(x) asm volatile("":"+v"(x))
  #define MX3(a,b,c) __builtin_fmaxf(__builtin_fmaxf((a),(b)),(c))
  #define GAPA(MF,A0,A1,A2,A3,W0,W1,PW) do{ MF; sacc+=A0; sacc+=A1; sacc+=A2; sacc+=A3; PIN(sacc); W0; W1; PIN(PW); SBAR(); }while(0)
  #define EX(v) __builtin_amdgcn_exp2f(v)
  #define GAPB(MF,X,B) do{ MF; X[B]=EX(X[B]); X[B+1]=EX(X[B+1]); X[B+2]=EX(X[B+2]); X[B+3]=EX(X[B+3]); PIN(X); SBAR(); }while(0)
  #define VRD(i) do{ vlo[i]=vtr(vp_+(((i)>>2)*4096+((i)&3)*1024)); vhi[i]=vtr(vp_+(((i)>>2)*4096+((i)&3)*1024+512)); }while(0)
  #define KRD(G,j) do{ if(G){ kload2(kf,kp0+sl_next,j); SBAR(); } }while(0)
  #define STEP(C0,C1,P0,P1,t,GK,GV,GL) do{ SBAR(); \
    const lds_cptr vp_=vp0+sl_prev; \
    VRD(0); SBAR(); float sacc=(P0[0]+P0[1]); \
    GAPA(C0=__builtin_amdgcn_mfma_f32_32x32x16_bf16(kf[0],qr[0],negm,0,0,0), P0[2],P0[3],P0[4],P0[5],     pw0[0]=PKW(P0,0), pw0[1]=PKW(P0,2), pw0); \
    VRD(4); SBAR(); GAPA(C1=__builtin_amdgcn_mfma_f32_32x32x16_bf16(kf[1],qr[0],negm,0,0,0), P0[6],P0[7],P0[8],P0[9],     pw0[2]=PKW(P0,4), pw0[3]=PKW(P0,6), pw0); \
    VRD(1); SBAR(); GAPA(C0=__builtin_amdgcn_mfma_f32_32x32x16_bf16(kf[2],qr[1],C0,0,0,0),   P0[10],P0[11],P0[12],P0[13], pw1[0]=PKW(P0,8), pw1[1]=PKW(P0,10), pw1); \
    VRD(5); SBAR(); GAPA(C1=__builtin_amdgcn_mfma_f32_32x32x16_bf16(kf[3],qr[1],C1,0,0,0),   P0[14],P0[15],P1[0],P1[1],   pw1[2]=PKW(P0,12),pw1[3]=PKW(P0,14), pw1); \
    VRD(2); SBAR(); GAPA(C0=__builtin_amdgcn_mfma_f32_32x32x16_bf16(kf[4],qr[2],C0,0,0,0),   P1[2],P1[3],P1[4],P1[5],     pw2[0]=PKW(P1,0), pw2[1]=PKW(P1,2), pw2); \
    VRD(6); SBAR(); GAPA(C1=__builtin_amdgcn_mfma_f32_32x32x16_bf16(kf[5],qr[2],C1,0,0,0),   P1[6],P1[7],P1[8],P1[9],     pw2[2]=PKW(P1,4), pw2[3]=PKW(P1,6), pw2); \
    VRD(3); SBAR(); GAPA(C0=__builtin_amdgcn_mfma_f32_32x32x16_bf16(kf[6],qr[3],C0,0,0,0),   P1[10],P1[11],P1[12],P1[13], pw3[0]=PKW(P1,8), pw3[1]=PKW(P1,10), pw3); \
    VRD(7); SBAR(); GAPA(C1=__builtin_amdgcn_mfma_f32_32x32x16_bf16(kf[7],qr[3],C1,0,0,0),   P1[14],P1[15],0.f,0.f,       pw3[2]=PKW(P1,12),pw3[3]=PKW(P1,14), pw3); \
    l_reg+=sacc; \
    if(GK){DMA_K((t)+3,sl_cur);} if(GV){DMA_V((t)+1,sl_next);} \
    CMASK(C0,C1,t); \
    { float a=MX3(C0[0],C0[1],C1[0]),b=MX3(C0[2],C0[3],C1[1]); a=MX3(a,C1[2],C1[3]); \
      _Pragma("unroll") for(int r=4;r<16;r+=4){a=MX3(a,C0[r],C0[r+1]);b=MX3(b,C0[r+2],C0[r+3]);a=MX3(a,C1[r],C1[r+1]);b=MX3(b,C1[r+2],C1[r+3]);} \
      float rm=__builtin_fmaxf(a,b); { auto rr=__builtin_amdgcn_permlane32_swap(__float_as_uint(rm),__float_as_uint(rm),false,false); rm=__builtin_fmaxf(__uint_as_float(rr[0]),__uint_as_float(rr[1])); } \
      resc=false; \
      if(__builtin_expect(__any(rm>(float)THRL),0)){ const float dl=__builtin_fmaxf(rm,0.f); mhat+=dl; \
        _Pragma("unroll") for(int r=0;r<16;++r){C0[r]-=dl;C1[r]-=dl;} \
        const float f=__builtin_amdgcn_exp2f(-dl); l_reg*=f; if(hi==0)wsf[r32]=f; resc=true; } \
      if(resc||((((t)+1)&3)==0)){ NEGM_SET((t)+1); } } \
    SBAR(); \
    GAPB(o[0]=__builtin_amdgcn_mfma_f32_32x32x16_bf16(PAF(0),VFR(0),o[0],0,0,0), C0,0); \
    GAPB(o[1]=__builtin_amdgcn_mfma_f32_32x32x16_bf16(PAF(0),VFR(4),o[1],0,0,0), C0,4); \
    KRD(GL,0); GAPB(o[0]=__builtin_amdgcn_mfma_f32_32x32x16_bf16(PAF(1),VFR(1),o[0],0,0,0), C0,8); \
    KRD(GL,1); GAPB(o[1]=__builtin_amdgcn_mfma_f32_32x32x16_bf16(PAF(1),VFR(5),o[1],0,0,0), C0,12); \
    KRD(GL,2); GAPB(o[0]=__builtin_amdgcn_mfma_f32_32x32x16_bf16(PAF(2),VFR(2),o[0],0,0,0), C1,0); \
    KRD(GL,3); GAPB(o[1]=__builtin_amdgcn_mfma_f32_32x32x16_bf16(PAF(2),VFR(6),o[1],0,0,0), C1,4); \
    GAPB(o[0]=__builtin_amdgcn_mfma_f32_32x32x16_bf16(PAF(3),VFR(3),o[0],0,0,0), C1,8); \
    GAPB(o[1]=__builtin_amdgcn_mfma_f32_32x32x16_bf16(PAF(3),VFR(7),o[1],0,0,0), C1,12); \
    }while(0)
  int t=1;
  #undef CMASK
  #define CMASK(P0,P1,t) do{}while(0)
  for(;t+7<NT;t+=2){
    STEP(pB0,pB1,pA0,pA1,t,true,true,true);     WAIT_BAR(2); RESC(); ROT();
    STEP(pA0,pA1,pB0,pB1,t+1,true,true,true);   WAIT_BAR(2); RESC(); ROT();
  }
  #undef CMASK
  #define CMASK(P0,P1,t) do{int jb_=(t)-(NT-4); if(jb_>=-2){int q2_=qrel,h2_=hi; asm volatile("":"+v"(q2_),"+v"(h2_)); abias(P0,P1,jb_,q2_,h2_,wid,Tb);} if(jb_>=0)cmask(P0,P1,jb_,qrel,hi);}while(0)
  #define ENDW(tt) do{ if((tt)+3<NT){WAIT_BAR(2);} else if((tt)+2<NT){WAIT_BAR(1);} else {WAIT_BAR(0);} }while(0)
  for(;t+1<NT;t+=2){
    STEP(pB0,pB1,pA0,pA1,t,(t+3<NT),(t+1<NT),(t+1<NT));       ENDW(t);   RESC(); ROT();
    STEP(pA0,pA1,pB0,pB1,t+1,(t+4<NT),(t+2<NT),(t+2<NT));     ENDW(t+1); RESC(); ROT();
  }
  STEP(pB0,pB1,pA0,pA1,NT-1,false,false,false); RESC();
  { float sacc=pB0[0]+pB0[1]; _Pragma("unroll") for(int r=2;r<16;++r)sacc+=pB0[r]; _Pragma("unroll") for(int r=0;r<16;++r)sacc+=pB1[r]; l_reg+=sacc;
    pw0=(u32x4){PKW(pB0,0),PKW(pB0,2),PKW(pB0,4),PKW(pB0,6)};pw1=(u32x4){PKW(pB0,8),PKW(pB0,10),PKW(pB0,12),PKW(pB0,14)};pw2=(u32x4){PKW(pB1,0),PKW(pB1,2),PKW(pB1,4),PKW(pB1,6)};pw3=(u32x4){PKW(pB1,8),PKW(pB1,10),PKW(pB1,12),PKW(pB1,14)};
    SBAR(); pv(o,vb0+sl_cur,PAF(0),PAF(1),PAF(2),PAF(3)); }
  #undef PKW
  #undef PAF
  #undef VFR
  #undef PIN
  #undef MX3
  #undef GAPA
  #undef GAPB
  #undef EX
  #undef VRD
  #undef KRD
  #undef STEP
  #undef ENDW
  {auto rr=__builtin_amdgcn_permlane32_swap(__float_as_uint(l_reg),__float_as_uint(l_reg),false,false);l_reg=__uint_as_float(rr[0])+__uint_as_float(rr[1]);}
  if(hi==0)wsf[32+r32]=l_reg;asm volatile("s_waitcnt lgkmcnt(0)":::"memory");
  float rli[16];
  #pragma unroll
  for(int r=0;r<16;++r)rli[r]=__builtin_amdgcn_rcpf(wsf[32+crow(r,hi)]);
  bf16*Ow=O+(rowbase+q0+wid*QBLK)*DM+h*D;
  { bf16*stg=(bf16*)(shm+LDS_OST)+wid*2048;
    #pragma unroll
    for(int r=0;r<16;++r){const int orow=crow(r,hi);
      #pragma unroll
      for(int d0=0;d0<2;++d0)stg[orow*64+d0*32+r32]=__float2bfloat16(o[d0][r]*rli[r]);}
    asm volatile("s_waitcnt lgkmcnt(0)":::"memory");
    #pragma unroll
    for(int i=0;i<4;++i){const int row=i*8+(lane>>3),ch=lane&7; const u32x4 v=*(const u32x4*)(stg+row*64+ch*8); ATTN_STORE16(Ow+(long)row*DM+ch*8,v);} }
  asm volatile("s_waitcnt lgkmcnt(0)\n\ts_barrier":::"memory");
  #undef DMA_K
  #undef DMA_V
  #undef CMASK
  #undef START
  #undef RESC
  #undef ROT
  #undef NEGM_SET
}
constexpr int ATTN_LDS_BYTES=LDS_BYTES;
struct AttnTensors { const bf16* Q; const bf16* K; const bf16* V; bf16* O; const float* KM; const float* TB; };
struct AttnUnit { int bh; int qb; };
struct StaticOrder {
  int vcu,G;
  __device__ __forceinline__ explicit StaticOrder(int grid,int block):vcu((grid%8==0)?(block%8)*(grid/8)+block/8:block),G(grid){}
  __device__ __forceinline__ bool next(int i,AttnUnit&u)const{ const int p=vcu+(i>>1)*G; if(p>=BATCH*NHEAD*8)return false; const int s=p&7; u.bh=p>>3; u.qb=(i&1)?15-s:s; return true; }
  __device__ __forceinline__ void a_ready(const AttnUnit&)const{}
  __device__ __forceinline__ void done(const AttnUnit&)const{}
};
template<class Sched,int THRL=8> __device__ __forceinline__ void attn_phase(char*lds,const AttnTensors&T,const Sched&S){
  AttnUnit u;
  for(int i=0;S.next(i,u);++i){ S.a_ready(u); attn_unit<THRL>(u.bh/NHEAD,u.bh%NHEAD,u.qb,T.Q,T.K,T.V,T.O,T.KM+(size_t)u.bh*(16*64),T.TB+(u.bh%NHEAD)*512,lds); S.done(u); }
}
#undef SBAR
#undef WAIT_BAR
}
#define GAS __attribute__((address_space(1)))
#define LAS __attribute__((address_space(3)))
typedef unsigned short bf16;
typedef unsigned v4u __attribute__((ext_vector_type(4)));
typedef float f32x4 __attribute__((ext_vector_type(4)));
typedef short bf16x8 __attribute__((ext_vector_type(8)));
typedef GAS unsigned gu32;
typedef GAS unsigned long long gu64;
#define RLX_AGENT __ATOMIC_RELAXED, __HIP_MEMORY_SCOPE_AGENT
#define LDS_WAIT() asm volatile("s_waitcnt lgkmcnt(0)" ::: "memory")
#define VM_WAIT() asm volatile("s_waitcnt vmcnt(0)" ::: "memory")
__device__ __forceinline__ unsigned long long rt() { return __builtin_amdgcn_s_memrealtime(); }
__device__ __forceinline__ unsigned f2bf(float f) { unsigned u = __builtin_bit_cast(unsigned, f); return (u + 0x7fffu + ((u >> 16) & 1u)) >> 16; }
__device__ __forceinline__ unsigned pk2(float lo, float hi) { return f2bf(lo) | (f2bf(hi) << 16); }

#define XB_TMO      128
#define XB_XCNT(j)  (256  + 64 * (j))
#define XB_XSUB(j)  (1280 + 64 * (j))
#define XB_XGEN(j)  (2304 + 64 * (j))
#define XB_TOP      3328
#define XB_TOPGEN   3392
#define XCD_BAR_WORDS 3456
#define XB_SPIN_CAP (1u << 18)

__device__ __forceinline__ unsigned xb_ld(unsigned* p)              { return __hip_atomic_load(p, __ATOMIC_RELAXED, __HIP_MEMORY_SCOPE_AGENT); }
__device__ __forceinline__ unsigned xb_add(unsigned* p, unsigned v) { return __hip_atomic_fetch_add(p, v, __ATOMIC_RELAXED, __HIP_MEMORY_SCOPE_AGENT); }
__device__ __forceinline__ unsigned xb_xcc_id() { return (unsigned)__builtin_amdgcn_s_getreg((3 << 11) | 20) & 0xFu; }
#define XB_SPIN(cond, bar) do { unsigned _sp = 0; while (cond) { __builtin_amdgcn_s_sleep(1); \
    if ((++_sp & 255u) == 0u) { if (xb_ld(&(bar)[XB_TMO])) break; if (_sp > XB_SPIN_CAP) { atomicAdd(&(bar)[XB_TMO], 1u); break; } } } } while (0)

struct XcdBarrier {
    unsigned* bar; unsigned x;
    volatile LAS unsigned* st;
};

__device__ __forceinline__ XcdBarrier xcd_barrier_post(unsigned* bar, volatile LAS unsigned* st) {
    XcdBarrier b; b.bar = bar; b.x = xb_xcc_id(); b.st = st;
    if (threadIdx.x == 0) (void)xb_add(&bar[XB_XCNT(b.x)], 1u);
    return b;
}
__device__ __forceinline__ void xcd_barrier_complete(unsigned* bar, unsigned x, unsigned& nloc, unsigned& nx) {
    const unsigned G = gridDim.x * gridDim.y * gridDim.z;
    unsigned sum, cnt, mine, sp = 0u;
    for (;;) {
        sum = 0u; cnt = 0u; mine = 0u;
#pragma unroll
        for (unsigned j = 0; j < 16; ++j) { const unsigned c = xb_ld(&bar[XB_XCNT(j)]); sum += c; cnt += (c > 0u) ? 1u : 0u; mine = (j == x) ? c : mine; }
        if (sum == G) break;
        __builtin_amdgcn_s_sleep(1);
        if ((++sp & 255u) == 0u) { if (xb_ld(&bar[XB_TMO])) break; if (sp > XB_SPIN_CAP) { atomicAdd(&bar[XB_TMO], 1u); break; } }
    }
    nloc = mine > 0u ? mine : 1u; nx = cnt > 0u ? cnt : 1u;
}

__device__ __forceinline__ void xcd_barrier(const XcdBarrier& b) {
    asm volatile("s_waitcnt vmcnt(0)" ::: "memory");
    __syncthreads();
    if (threadIdx.x == 0) {
        unsigned* bar = b.bar;
        __builtin_amdgcn_s_waitcnt(0);
        unsigned nloc = b.st[0], nx = b.st[1];
        if (nloc == 0u) { xcd_barrier_complete(bar, b.x, nloc, nx); b.st[0] = nloc; b.st[1] = nx; }
        const unsigned old = xb_add(&bar[XB_XSUB(b.x)], 1u);
        const unsigned gen = old / nloc;
        if (old + 1u == (gen + 1u) * nloc) {
            __builtin_amdgcn_fence(__ATOMIC_RELEASE, "agent");
            asm volatile("s_waitcnt vmcnt(0)" ::: "memory");
            const unsigned og = xb_add(&bar[XB_TOP], 1u);
            const unsigned tg = og / nx;
            if (og + 1u == (tg + 1u) * nx) xb_add(&bar[XB_TOPGEN], 1u);
            else XB_SPIN(xb_ld(&bar[XB_TOPGEN]) == tg, bar);
            __builtin_amdgcn_fence(__ATOMIC_ACQUIRE, "agent");
            xb_add(&bar[XB_XGEN(b.x)], 1u);
            asm volatile("s_waitcnt vmcnt(0)" ::: "memory");
        } else {
            XB_SPIN(xb_ld(&bar[XB_XGEN(b.x)]) == gen, bar);
            __builtin_amdgcn_fence(__ATOMIC_ACQUIRE, "agent");
            asm volatile("s_waitcnt vmcnt(0)" ::: "memory");
        }
    }
    __syncthreads();
}

struct Frame {
    LAS unsigned char* lds;
    volatile LAS unsigned* MISC;
    gu32* ctl;
    int tid, lane, wave;
    int vcu, G;
};
__device__ __forceinline__ float wave_sum(float v) {
#pragma unroll
    for (int o = 1; o < 64; o <<= 1) v += __shfl_xor(v, o);
    return v;
}
__device__ __forceinline__ float wave_max(float v) {
#pragma unroll
    for (int o = 1; o < 64; o <<= 1) v = fmaxf(v, __shfl_xor(v, o));
    return v;
}
__device__ __forceinline__ float bf_lo(unsigned w) { return __uint_as_float(w << 16); }
__device__ __forceinline__ float bf_hi(unsigned w) { return __uint_as_float(w & 0xffff0000u); }
__device__ __forceinline__ float bf2f(bf16 h) { return __uint_as_float((unsigned)h << 16); }

__device__ __forceinline__ void p0_transpose_item(const float* W, int K, int N, bf16* WT, int row_off, LAS float* scr, int item, int lane) {
    const int nblk = N / 32, kb = item / nblk, nb = item % nblk, k0 = 64 * kb, n0 = 32 * nb;
#pragma unroll 8
    for (int i = 0; i < 32; ++i) { const int kk = 2 * i + (lane >> 5); scr[kk * 33 + (lane & 31)] = W[(size_t)(k0 + kk) * N + n0 + (lane & 31)]; }
    LDS_WAIT(); asm volatile("" ::: "memory");
    const int c = lane & 7;
#pragma unroll
    for (int j = 0; j < 4; ++j) { const int n = (lane >> 3) + 8 * j; const LAS float* s = scr + (8 * c) * 33 + n;
        v4u o; o.x = pk2(s[0 * 33], s[1 * 33]); o.y = pk2(s[2 * 33], s[3 * 33]); o.z = pk2(s[4 * 33], s[5 * 33]); o.w = pk2(s[6 * 33], s[7 * 33]);
        *(GAS v4u*)(WT + (size_t)(row_off + n0 + n) * K + k0 + 8 * c) = o; }
    LDS_WAIT(); asm volatile("" ::: "memory");
}
__device__ __forceinline__ void rms_row_to_bf16(int lane, const float* xrow, const float* g, bf16* orow) {
    const GAS f32x4* xr = (const GAS f32x4*)xrow + lane; const GAS f32x4* gr = (const GAS f32x4*)g + lane;
    f32x4 v[8]; float s = 0.f;
#pragma unroll
    for (int j = 0; j < 8; ++j) { v[j] = xr[64 * j]; s += (v[j].x * v[j].x + v[j].y * v[j].y) + (v[j].z * v[j].z + v[j].w * v[j].w); }
    const float rstd = 1.0f / sqrtf(wave_sum(s) * (1.f / DM) + RMS_EPS);
    GAS unsigned long long* o8 = (GAS unsigned long long*)orow + lane;
#pragma unroll
    for (int j = 0; j < 8; ++j) { const f32x4 gg = gr[64 * j]; const f32x4 o = v[j] * rstd * gg;
        o8[64 * j] = (unsigned long long)pk2(o.x, o.y) | ((unsigned long long)pk2(o.z, o.w) << 32); }
}
__device__ __forceinline__ void rms_row1024_bf16(int lane, const bf16* irow, const float* g, bf16* orow) {
    float v[16]; float s = 0.f;
#pragma unroll
    for (int j = 0; j < 2; ++j) { const v4u w = *((const GAS v4u*)irow + lane + 64 * j);
        v[8 * j + 0] = bf_lo(w.x); v[8 * j + 1] = bf_hi(w.x); v[8 * j + 2] = bf_lo(w.y); v[8 * j + 3] = bf_hi(w.y);
        v[8 * j + 4] = bf_lo(w.z); v[8 * j + 5] = bf_hi(w.z); v[8 * j + 6] = bf_lo(w.w); v[8 * j + 7] = bf_hi(w.w); }
#pragma unroll
    for (int k = 0; k < 16; ++k) s += v[k] * v[k];
    const float rstd = 1.0f / sqrtf(wave_sum(s) * (1.f / 1024.f) + RMS_EPS);
#pragma unroll
    for (int j = 0; j < 2; ++j) { const f32x4 g0 = *((const GAS f32x4*)g + 2 * (lane + 64 * j)), g1 = *((const GAS f32x4*)g + 2 * (lane + 64 * j) + 1);
        v4u o; o.x = pk2(v[8 * j + 0] * rstd * g0.x, v[8 * j + 1] * rstd * g0.y); o.y = pk2(v[8 * j + 2] * rstd * g0.z, v[8 * j + 3] * rstd * g0.w);
        o.z = pk2(v[8 * j + 4] * rstd * g1.x, v[8 * j + 5] * rstd * g1.y); o.w = pk2(v[8 * j + 6] * rstd * g1.z, v[8 * j + 7] * rstd * g1.w);
        *((GAS v4u*)orow + lane + 64 * j) = o; }
}
__device__ __forceinline__ int t5_bucket(int dist) {
    if (dist < 16) return dist;
    const float lr = logf((float)dist / 16.0f) / logf(8.0f) * 16.0f;
    int b = 16 + (int)lr; return b < 31 ? b : 31;
}
__device__ __forceinline__ float gelu_tanh(float y) {
    const float u = 0.7978845608028654f * (y + 0.044715f * y * y * y);
    const float e = __builtin_amdgcn_exp2f(2.0f * LOG2E * u);
    const float th = 1.0f - 2.0f * __builtin_amdgcn_rcpf(e + 1.0f);
    return 0.5f * y * (1.0f + th);
}

struct Args { const float* in[23]; float* out; unsigned char* ws; int ph_lo, ph_hi, li, pad; };
__global__ void __launch_bounds__(NWAVES * 64, 2) skel_fwd(Args args) {
    extern __shared__ __attribute__((aligned(16))) unsigned char lds[];
    Frame F;
    F.lds = (LAS unsigned char*)lds;
    F.MISC = (volatile LAS unsigned*)(F.lds + MISC_OFF);
    F.tid = threadIdx.x; F.lane = F.tid & 63; F.wave = __builtin_amdgcn_readfirstlane(F.tid >> 6);
    F.G = gridDim.x; { const int bx = blockIdx.x; F.vcu = (F.G % 8 == 0) ? (bx % 8) * (F.G / 8) + bx / 8 : bx; }
    unsigned char* ws = args.ws;
    F.ctl = (gu32*)(ws + WS_CTL);
    const float* x = args.in[0]; const float* norm_mix = args.in[1]; const float* w_in = args.in[2]; const float* rel_bias = args.in[3];
    const float* lam_re = args.in[4]; const float* lam_im = args.in[5]; const float* log_dt = args.in[6];
    const float* b_re = args.in[7]; const float* b_im = args.in[8]; const float* c_re = args.in[9]; const float* c_im = args.in[10]; const float* d_skip = args.in[11];
    const float* w_glu = args.in[12]; const float* b_glu = args.in[13]; const float* norm_attn = args.in[14]; const float* norm_ssm = args.in[15];
    const float* w_out = args.in[16]; const float* norm_ffn = args.in[17]; const float* w_up = args.in[18]; const float* conv_w = args.in[19]; const float* conv_b = args.in[20];
    const float* w_down = args.in[21]; const float* norm_final = args.in[22];
    float* out = args.out;
    bf16* Wt_in = (bf16*)(ws + WS_WIN); bf16* Wt_glu = (bf16*)(ws + WS_WGLU); bf16* Wt_out = (bf16*)(ws + WS_WOUT); bf16* Wt_up = (bf16*)(ws + WS_WUP); bf16* Wt_down = (bf16*)(ws + WS_WDOWN);
    bf16* XN = (bf16*)(ws + WS_XN); bf16* QB = (bf16*)(ws + WS_Q); bf16* KB = (bf16*)(ws + WS_K); bf16* VB = (bf16*)(ws + WS_V); bf16* UB = (bf16*)(ws + WS_U);
    bf16* YB = (bf16*)(ws + WS_Y); bf16* ZB = (bf16*)(ws + WS_Z); bf16* UPB = (bf16*)(ws + WS_UP); bf16* X1G = (bf16*)(ws + WS_X1G); bf16* ACT = (bf16*)(ws + WS_ACT);
    float* SSQ = (float*)(ws + WS_SSQ); float* KMEAN = (float*)(ws + WS_KMEAN); float* T5B = (float*)(ws + WS_T5B);
    bf16* A2 = (bf16*)(ws + WS_A2); float* SBUF = (float*)(ws + WS_S); bf16* BTS = (bf16*)(ws + WS_BTS); bf16* BT2 = (bf16*)(ws + WS_BT2);

    for (int u = F.tid; u < (LDS_BYTES - LDSCTL_OFF) / 4; u += NWAVES * 64) ((LAS unsigned*)(F.lds + LDSCTL_OFF))[u] = 0u;
    __syncthreads();
    XcdBarrier bar; bar.bar = (unsigned*)(F.ctl + CW_BAR); bar.x = 0; bar.st = nullptr;
    if (N_LAUNCHES == 1) bar = xcd_barrier_post((unsigned*)(F.ctl + CW_BAR), F.MISC + 8);
#define GRID_BAR() do { if (N_LAUNCHES == 1) xcd_barrier(bar); } while (0)
    const int lo = args.ph_lo, hi = args.ph_hi;
#define IN(k) (lo <= (k) && (k) < hi)
#define BOTH(k) (IN(k) && IN((k) + 1))
    const int gw = F.vcu * NWAVES + F.wave, NGW = F.G * NWAVES;
    const int gt = gw * 64 + F.lane, NGT = NGW * 64;

    if (IN(0)) {
        {
            LAS float* L = (LAS float*)(F.lds + RING_OFF);
            LAS float* pwr = L; LAS float* pwi = pwr + 33 * 65; LAS float* bbr = pwi + 33 * 65; LAS float* bbi = bbr + 1024;
            LAS float* ccr = bbi + 1024; LAS float* cci = ccr + 16 * 65; LAS float* dsk = cci + 16 * 65; LAS float* Kd = dsk + 16;
            for (int it = blockIdx.x; it < SG * 4; it += F.G) {
                const int g = it >> 2, q = it & 3;
                __syncthreads();
                const float dt = expf(log_dt[g]);
                for (int i = F.tid; i < 33 * 64; i += NWAVES * 64) { const int d = i >> 6, p = i & 63; const float lr = lam_re[g * SP + p], li = lam_im[g * SP + p];
                    const float mag = expf(lr * dt * (float)d), ang = li * dt * (float)d; pwr[d * 65 + p] = mag * cosf(ang); pwi[d * 65 + p] = mag * sinf(ang); }
                for (int i = F.tid; i < 64 * 16; i += NWAVES * 64) { const int p = i >> 4; const float lr = lam_re[g * SP + p], li = lam_im[g * SP + p];
                    const float er = expf(lr * dt), lbr = er * cosf(li * dt), lbi = er * sinf(li * dt);
                    const float nr = lbr - 1.0f, ni = lbi, den = lr * lr + li * li, cr_ = (nr * lr + ni * li) / den, ci_ = (ni * lr - nr * li) / den;
                    const float bre = b_re[(size_t)(g * SP) * SC + i], bim = b_im[(size_t)(g * SP) * SC + i];
                    bbr[i] = cr_ * bre - ci_ * bim; bbi[i] = cr_ * bim + ci_ * bre; }
                for (int i = F.tid; i < 16 * 64; i += NWAVES * 64) { const int h = i >> 6, p = i & 63; ccr[h * 65 + p] = c_re[(size_t)(g * SC) * SP + i]; cci[h * 65 + p] = c_im[(size_t)(g * SC) * SP + i]; }
                if (F.tid < 16) dsk[F.tid] = d_skip[g * SC + F.tid];
                __syncthreads();
                {
                    const int d = F.tid >> 4, h = F.tid & 15; float a16[16];
#pragma unroll
                    for (int e = 0; e < 16; ++e) a16[e] = 0.f;
                    for (int p = 0; p < 64; ++p) { const float cr = ccr[h * 65 + p], ci = cci[h * 65 + p], pr = pwr[d * 65 + p], pi = pwi[d * 65 + p];
                        const float ar = cr * pr - ci * pi, ai_ = cr * pi + ci * pr;
#pragma unroll
                        for (int e = 0; e < 16; ++e) a16[e] += ar * bbr[p * 16 + e] - ai_ * bbi[p * 16 + e]; }
                    const float dd = dsk[h];
#pragma unroll
                    for (int e = 0; e < 16; ++e) Kd[(d * 16 + h) * 16 + e] = a16[e] + ((d == 0 && e == h) ? dd : 0.f);
                }
                __syncthreads();
                for (int i = F.tid; i < 128 * 80; i += NWAVES * 64) {
                    const int rl = i / 80, k8 = i - rl * 80, n = q * 128 + rl, t = n >> 4, h = n & 15; float v[8];
                    if (k8 < 64) { const int s = k8 >> 1, h0 = (k8 & 1) * 8;
                        if (s <= t) { const LAS float* kp = Kd + ((t - s) * 16 + h) * 16 + h0;
#pragma unroll
                            for (int e = 0; e < 8; ++e) v[e] = kp[e]; }
                        else {
#pragma unroll
                            for (int e = 0; e < 8; ++e) v[e] = 0.f; } }
                    else { const int j0 = (k8 - 64) * 8, p0 = j0 & 63; const bool im = j0 >= 64;
#pragma unroll
                        for (int e = 0; e < 8; ++e) { const int p = p0 + e; const float cr = ccr[h * 65 + p], ci = cci[h * 65 + p], pr = pwr[(t + 1) * 65 + p], pi = pwi[(t + 1) * 65 + p];
                            v[e] = im ? -(cr * pi + ci * pr) : (cr * pr - ci * pi); } }
                    v4u o; o.x = pk2(v[0], v[1]); o.y = pk2(v[2], v[3]); o.z = pk2(v[4], v[5]); o.w = pk2(v[6], v[7]);
                    *(GAS v4u*)(BT2 + ((size_t)(g * 512 + n)) * 640 + k8 * 8) = o;
                }
                for (int i = F.tid; i < 64 * 64; i += NWAVES * 64) {
                    const int rl = i >> 6, k8 = i & 63, j = q * 64 + rl; float v[8];
                    if (j < 128) { const int p = j & 63, s = k8 >> 1, h0 = (k8 & 1) * 8; const bool im = j >= 64; const float pr = pwr[(31 - s) * 65 + p], pi = pwi[(31 - s) * 65 + p];
#pragma unroll
                        for (int e = 0; e < 8; ++e) { const float br = bbr[p * 16 + h0 + e], bi = bbi[p * 16 + h0 + e]; v[e] = im ? (pr * bi + pi * br) : (pr * br - pi * bi); } }
                    else {
#pragma unroll
                        for (int e = 0; e < 8; ++e) v[e] = 0.f; }
                    v4u o; o.x = pk2(v[0], v[1]); o.y = pk2(v[2], v[3]); o.z = pk2(v[4], v[5]); o.w = pk2(v[6], v[7]);
                    *(GAS v4u*)(BTS + ((size_t)(g * 256 + j)) * 512 + k8 * 8) = o;
                }
            }
            __syncthreads();
        }
        LAS float* scr = (LAS float*)(F.lds + RING_OFF + F.wave * 16384);
        constexpr int I_IN = (DM / 64) * (INC / 32), I_GLU = (SW / 64) * (SW / 32), I_OUT = (DM / 64) * (DM / 32), I_UP = (DM / 64) * (DFF2 / 32), I_DN = (DFF / 64) * (DM / 32);
        constexpr int NITEMS = I_IN + I_GLU + I_OUT + I_UP + I_DN;
        for (int it = gw; it < NITEMS; it += NGW) {
            int r = it;
            if (r < I_IN) { p0_transpose_item(w_in, DM, INC, Wt_in, 0, scr, r, F.lane); continue; } r -= I_IN;
            if (r < I_GLU) { p0_transpose_item(w_glu, SW, SW, Wt_glu, 0, scr, r, F.lane); continue; } r -= I_GLU;
            if (r < I_OUT) { p0_transpose_item(w_out, DM, DM, Wt_out, 0, scr, r, F.lane); continue; } r -= I_OUT;
            if (r < I_UP) { p0_transpose_item(w_up, DM, DFF2, Wt_up, 0, scr, r, F.lane); continue; } r -= I_UP;
            p0_transpose_item(w_down, DFF, DM, Wt_down, 0, scr, r, F.lane);
        }
        for (int m = gw; m < M; m += NGW) rms_row_to_bf16(F.lane, x + (size_t)m * DM, norm_mix, XN + (size_t)m * DM);
        for (int i = gt; i < AH * 512; i += NGT) { const int h = i >> 9, d = i & 511; T5B[i] = LOG2E * rel_bias[t5_bucket(d) * AH + h]; }
        if (BOTH(0)) GRID_BAR();
    }

    if (IN(1)) {
        pg8::Gemm g{XN, Wt_in, M, INC, DM}; pg8::StaticOrder S; S.init(M, INC, F.G, (int)blockIdx.x);
        pg8::EpiQKVU E{QB, (size_t)(WS_K - WS_Q) / 2, A2, C2};
        pg8::gemm_phase<pg8::EpiQKVU, pg8::StaticOrder, PG8_ALIGN, PG8_SP2>(F.lds + RING_OFF, g, S, E);
        if (BOTH(1)) GRID_BAR();
    }

    if (IN(2)) {
        for (int it = gw; it < BATCH * AH * NBLK; it += NGW) {
            const int n = it % NBLK, h = (it / NBLK) % AH, b = it / (NBLK * AH);
            const bf16* kp = KB + ((size_t)(b * SEQ + n * MOBA_BLK + (F.lane >> 3))) * AW + h * HD + (F.lane & 7) * 8;
            float a[8];
#pragma unroll
            for (int k = 0; k < 8; ++k) a[k] = 0.f;
            for (int i = 0; i < 32; ++i) { const v4u w = *(const GAS v4u*)(kp + (size_t)i * 8 * AW);
                a[0] += bf_lo(w.x); a[1] += bf_hi(w.x); a[2] += bf_lo(w.y); a[3] += bf_hi(w.y); a[4] += bf_lo(w.z); a[5] += bf_hi(w.z); a[6] += bf_lo(w.w); a[7] += bf_hi(w.w); }
#pragma unroll
            for (int k = 0; k < 8; ++k) { a[k] += __shfl_xor(a[k], 8); a[k] += __shfl_xor(a[k], 16); a[k] += __shfl_xor(a[k], 32); }
            if (F.lane < 8) { float* o = KMEAN + (size_t)it * HD + F.lane * 8;
#pragma unroll
                for (int k = 0; k < 8; ++k) o[k] = a[k] * (1.0f / MOBA_BLK); }
        }
#if SSM_FAST
        if ((int)blockIdx.x < SG) { const int g = blockIdx.x;
            { pg8::Gemm g1{A2, BTS, 0, 0, 512, 640, 512}; pg8::GroupOrder S1{g, 1, g}; pg8::EpiS E1{SBUF};
              pg8::gemm_phase<pg8::EpiS, pg8::GroupOrder, false, PG8_SP2>(F.lds + RING_OFF, g1, S1, E1); }
            VM_WAIT(); __syncthreads();
            if (F.tid < 128) { const int b = F.tid >> 6, p = F.tid & 63;
                const float lr = lam_re[g * SP + p], li = lam_im[g * SP + p], dt = expf(log_dt[g]);
                const float mag = expf(lr * dt * 32.0f), ang = li * dt * 32.0f, l32r = mag * cosf(ang), l32i = mag * sinf(ang);
                float xr = 0.f, xi = 0.f;
                const unsigned* sp = (const unsigned*)(SBUF + ((size_t)g * 256 + b * 128) * 128 + p);
                bf16* xp = A2 + ((size_t)(g * 256 + b * 128)) * 640 + 512 + p;
                for (int c0 = 0; c0 < 128; c0 += 8) { float sr[8], si[8];
#pragma unroll
                    for (int k = 0; k < 8; ++k) { sr[k] = __uint_as_float(__hip_atomic_load(sp + (size_t)(c0 + k) * 128, __ATOMIC_RELAXED, __HIP_MEMORY_SCOPE_AGENT));
                                                  si[k] = __uint_as_float(__hip_atomic_load(sp + (size_t)(c0 + k) * 128 + 64, __ATOMIC_RELAXED, __HIP_MEMORY_SCOPE_AGENT)); }
#pragma unroll
                    for (int k = 0; k < 8; ++k) { xp[(size_t)(c0 + k) * 640] = (bf16)f2bf(xr); xp[(size_t)(c0 + k) * 640 + 64] = (bf16)f2bf(xi);
                        const float nxr = l32r * xr - l32i * xi + sr[k], nxi = l32r * xi + l32i * xr + si[k]; xr = nxr; xi = nxi; } }
            }
            VM_WAIT(); __syncthreads();
            { pg8::Gemm g2{A2, BT2, 0, 0, 640, 640, 640}; pg8::GroupOrder S2{g, 2, 2 * g}; pg8::EpiY E2{YB};
              pg8::gemm_phase<pg8::EpiY, pg8::GroupOrder, PG8_ALIGN, PG8_SP2>(F.lds + RING_OFF, g2, S2, E2); }
        }
#else
        for (int it = gw; it < BATCH * SG; it += NGW) {
            const int g = it % SG, b = it / SG, p = F.lane;
            const float lr = lam_re[g * SP + p], li = lam_im[g * SP + p], dt = expf(log_dt[g]);
            const float er = expf(lr * dt), lbr = er * cosf(li * dt), lbi = er * sinf(li * dt);
            const float nr = lbr - 1.0f, ni = lbi, den = lr * lr + li * li;
            const float cr_ = (nr * lr + ni * li) / den, ci_ = (ni * lr - nr * li) / den;
            float bbr[16], bbi[16], ccr[16], cci[16];
#pragma unroll
            for (int h = 0; h < 16; ++h) { const float bre = b_re[(size_t)(g * SP + p) * SC + h], bim = b_im[(size_t)(g * SP + p) * SC + h];
                bbr[h] = cr_ * bre - ci_ * bim; bbi[h] = cr_ * bim + ci_ * bre;
                ccr[h] = c_re[(size_t)(g * SC + h) * SP + p]; cci[h] = c_im[(size_t)(g * SC + h) * SP + p]; }
            const float dsk = d_skip[g * SC + (F.lane & 15)];
            float xr = 0.f, xi = 0.f;
            const bf16* up = A2 + (size_t)(g * 256 + b * 128) * 640;
            v4u n0 = *(const GAS v4u*)(up), n1 = *(const GAS v4u*)(up + 8);
            for (int t = 0; t < SEQ; ++t) {
                const v4u c0 = n0, c1 = n1;
                if (t + 1 < SEQ) { const bf16* un = up + (size_t)((t + 1) >> 5) * 640 + ((t + 1) & 31) * 16; n0 = *(const GAS v4u*)(un); n1 = *(const GAS v4u*)(un + 8); }
                float uf[16];
                uf[0] = bf_lo(c0.x); uf[1] = bf_hi(c0.x); uf[2] = bf_lo(c0.y); uf[3] = bf_hi(c0.y); uf[4] = bf_lo(c0.z); uf[5] = bf_hi(c0.z); uf[6] = bf_lo(c0.w); uf[7] = bf_hi(c0.w);
                uf[8] = bf_lo(c1.x); uf[9] = bf_hi(c1.x); uf[10] = bf_lo(c1.y); uf[11] = bf_hi(c1.y); uf[12] = bf_lo(c1.z); uf[13] = bf_hi(c1.z); uf[14] = bf_lo(c1.w); uf[15] = bf_hi(c1.w);
                float bur = 0.f, bui = 0.f;
#pragma unroll
                for (int h = 0; h < 16; ++h) { bur += uf[h] * bbr[h]; bui += uf[h] * bbi[h]; }
                const float nxr = lbr * xr - lbi * xi + bur, nxi = lbr * xi + lbi * xr + bui; xr = nxr; xi = nxi;
                float yv = 0.f;
#pragma unroll
                for (int h = 0; h < 16; ++h) { const float v = wave_sum(xr * ccr[h] - xi * cci[h]); if (F.lane == h) yv = v + dsk * uf[h]; }
                if (F.lane < 16) YB[(size_t)(b * SEQ + t) * SW + g * SC + F.lane] = (bf16)f2bf(gelu_tanh(yv));
            }
        }
#endif
        if (BOTH(2)) GRID_BAR();
    }

    if (IN(3)) {
        static_assert(attn_body::ATTN_LDS_BYTES <= RING_BYTES && attn_body::ATTN_PITCH == AW, "attention body geometry vs frame");
        const attn_body::AttnTensors AT{(const attn_body::bf16*)QB, (const attn_body::bf16*)KB, (const attn_body::bf16*)VB, (attn_body::bf16*)QB, KMEAN, T5B};
        const attn_body::StaticOrder S((int)F.G, (int)blockIdx.x);
        attn_body::attn_phase<attn_body::StaticOrder>((char*)lds + RING_OFF, AT, S);
        if (BOTH(3)) GRID_BAR();
    }

    if (IN(4)) {
        pg8::Gemm g{YB, Wt_glu, M, SW, SW}; pg8::StaticOrder S; S.init(M, SW, F.G, (int)blockIdx.x);
        pg8::EpiGlu E{YB, ZB, SW, b_glu};
        pg8::gemm_phase<pg8::EpiGlu, pg8::StaticOrder, PG8_ALIGN, PG8_SP2>(F.lds + RING_OFF, g, S, E);
        if (BOTH(4)) GRID_BAR();
    }

    if (IN(5)) {
        for (int m = gw; m < M; m += NGW) {
            rms_row1024_bf16(F.lane, QB + (size_t)m * AW, norm_attn, XN + (size_t)m * DM);
            rms_row1024_bf16(F.lane, ZB + (size_t)m * SW, norm_ssm, XN + (size_t)m * DM + AW);
        }
        if (BOTH(5)) GRID_BAR();
    }

    if (IN(6)) {
        pg8::Gemm g{XN, Wt_out, M, DM, DM}; pg8::StaticOrder S; S.init(M, DM, F.G, (int)blockIdx.x);
        pg8::EpiResid1 E{x, out, X1G, norm_ffn, SSQ, DM};
        pg8::gemm_phase<pg8::EpiResid1, pg8::StaticOrder, PG8_ALIGN, PG8_SP2>(F.lds + RING_OFF, g, S, E);
        if (BOTH(6)) GRID_BAR();
    }

    if (IN(7)) {
        pg8::Gemm g{X1G, Wt_up, M, DFF2, DM}; pg8::StaticOrder S; S.init(M, DFF2, F.G, (int)blockIdx.x);
        pg8::EpiUp E{UPB, DFF2, SSQ, 1.0f / DM, RMS_EPS};
        pg8::gemm_phase<pg8::EpiUp, pg8::StaticOrder, PG8_ALIGN, PG8_SP2>(F.lds + RING_OFF, g, S, E);
        if (BOTH(7)) GRID_BAR();
    }

    if (IN(8)) {
        constexpr int NCC = DFF / 8, RUN = 32, NRUN = M / RUN;
        for (int it = gt; it < NCC * NRUN; it += NGT) {
            const int cc = it % NCC, rr = it / NCC, j0 = cc * 8, r0 = rr * RUN;
            float wg[3][8], wv[3][8], bg[8], bvv[8];
#pragma unroll
            for (int k = 0; k < 3; ++k)
#pragma unroll
                for (int e = 0; e < 8; ++e) { wg[k][e] = conv_w[(size_t)k * DFF2 + j0 + e]; wv[k][e] = conv_w[(size_t)k * DFF2 + DFF + j0 + e]; }
#pragma unroll
            for (int e = 0; e < 8; ++e) { bg[e] = conv_b[j0 + e]; bvv[e] = conv_b[DFF + j0 + e]; }
            float g1[8], g2[8], v1[8], v2[8];
#pragma unroll
            for (int e = 0; e < 8; ++e) { g1[e] = 0.f; g2[e] = 0.f; v1[e] = 0.f; v2[e] = 0.f; }
            if ((r0 % SEQ) != 0) {
                const v4u a1 = *(const GAS v4u*)(UPB + (size_t)(r0 - 1) * DFF2 + j0), a2 = *(const GAS v4u*)(UPB + (size_t)(r0 - 2) * DFF2 + j0);
                const v4u c1 = *(const GAS v4u*)(UPB + (size_t)(r0 - 1) * DFF2 + DFF + j0), c2 = *(const GAS v4u*)(UPB + (size_t)(r0 - 2) * DFF2 + DFF + j0);
                g1[0] = bf_lo(a1.x); g1[1] = bf_hi(a1.x); g1[2] = bf_lo(a1.y); g1[3] = bf_hi(a1.y); g1[4] = bf_lo(a1.z); g1[5] = bf_hi(a1.z); g1[6] = bf_lo(a1.w); g1[7] = bf_hi(a1.w);
                g2[0] = bf_lo(a2.x); g2[1] = bf_hi(a2.x); g2[2] = bf_lo(a2.y); g2[3] = bf_hi(a2.y); g2[4] = bf_lo(a2.z); g2[5] = bf_hi(a2.z); g2[6] = bf_lo(a2.w); g2[7] = bf_hi(a2.w);
                v1[0] = bf_lo(c1.x); v1[1] = bf_hi(c1.x); v1[2] = bf_lo(c1.y); v1[3] = bf_hi(c1.y); v1[4] = bf_lo(c1.z); v1[5] = bf_hi(c1.z); v1[6] = bf_lo(c1.w); v1[7] = bf_hi(c1.w);
                v2[0] = bf_lo(c2.x); v2[1] = bf_hi(c2.x); v2[2] = bf_lo(c2.y); v2[3] = bf_hi(c2.y); v2[4] = bf_lo(c2.z); v2[5] = bf_hi(c2.z); v2[6] = bf_lo(c2.w); v2[7] = bf_hi(c2.w);
            }
            for (int r = r0; r < r0 + RUN; ++r) {
                const v4u a0 = *(const GAS v4u*)(UPB + (size_t)r * DFF2 + j0), c0 = *(const GAS v4u*)(UPB + (size_t)r * DFF2 + DFF + j0);
                float g0[8], v0[8], o[8];
                g0[0] = bf_lo(a0.x); g0[1] = bf_hi(a0.x); g0[2] = bf_lo(a0.y); g0[3] = bf_hi(a0.y); g0[4] = bf_lo(a0.z); g0[5] = bf_hi(a0.z); g0[6] = bf_lo(a0.w); g0[7] = bf_hi(a0.w);
                v0[0] = bf_lo(c0.x); v0[1] = bf_hi(c0.x); v0[2] = bf_lo(c0.y); v0[3] = bf_hi(c0.y); v0[4] = bf_lo(c0.z); v0[5] = bf_hi(c0.z); v0[6] = bf_lo(c0.w); v0[7] = bf_hi(c0.w);
#pragma unroll
                for (int e = 0; e < 8; ++e) {
                    const float cg = g0[e] * wg[2][e] + g1[e] * wg[1][e] + g2[e] * wg[0][e] + bg[e];
                    const float cv = v0[e] * wv[2][e] + v1[e] * wv[1][e] + v2[e] * wv[0][e] + bvv[e];
                    o[e] = cg * __builtin_amdgcn_rcpf(1.0f + __builtin_amdgcn_exp2f(-LOG2E * cg)) * cv;
                    g2[e] = g1[e]; g1[e] = g0[e]; v2[e] = v1[e]; v1[e] = v0[e]; }
                v4u w; w.x = pk2(o[0], o[1]); w.y = pk2(o[2], o[3]); w.z = pk2(o[4], o[5]); w.w = pk2(o[6], o[7]);
                *(GAS v4u*)(ACT + (size_t)r * DFF + j0) = w;
            }
        }
        if (BOTH(8)) GRID_BAR();
    }

    if (IN(9)) {
        pg8::Gemm g{ACT, Wt_down, M, DM, DFF}; pg8::StaticOrder S; S.init(M, DM, F.G, (int)blockIdx.x);
        pg8::EpiResid2 E{out, DM};
        pg8::gemm_phase<pg8::EpiResid2, pg8::StaticOrder, PG8_ALIGN, PG8_SP2>(F.lds + RING_OFF, g, S, E);
        if (BOTH(9)) GRID_BAR();
    }

    if (IN(10)) {
        for (int m = gw; m < M; m += NGW) {
            GAS f32x4* xr = (GAS f32x4*)(out + (size_t)m * DM) + F.lane; const GAS f32x4* gr = (const GAS f32x4*)norm_final + F.lane;
            f32x4 v[8]; float s = 0.f;
#pragma unroll
            for (int j = 0; j < 8; ++j) { v[j] = xr[64 * j]; s += (v[j].x * v[j].x + v[j].y * v[j].y) + (v[j].z * v[j].z + v[j].w * v[j].w); }
            const float rstd = 1.0f / sqrtf(wave_sum(s) * (1.f / DM) + RMS_EPS);
#pragma unroll
            for (int j = 0; j < 8; ++j) xr[64 * j] = v[j] * rstd * gr[64 * j];
        }
    }
#undef IN
#undef BOTH
}

extern "C" void kernel_launch(void* const* d_in, const int* in_sizes, int n_in, void* d_out, int out_size, void* d_ws, size_t ws_size, hipStream_t stream) {
    static int grid = 0;
    if (grid == 0) {
        if (n_in != 23 || in_sizes[0] != M * DM || out_size != M * DM || ws_size < WS_END) { fprintf(stderr, "kernel_launch: unexpected shapes: n_in %d in0 %d out %d ws %zu (need %zu); nothing launched\n", n_in, n_in > 0 ? in_sizes[0] : -1, out_size, ws_size, (size_t)WS_END); grid = -1; return; }
        int dev = 0, cus = 0, per_cu = 0;
        if (hipGetDevice(&dev) != hipSuccess || hipDeviceGetAttribute(&cus, hipDeviceAttributeMultiprocessorCount, dev) != hipSuccess) { fprintf(stderr, "kernel_launch: device query failed\n"); grid = -1; return; }
        if (hipFuncSetAttribute((const void*)skel_fwd, hipFuncAttributeMaxDynamicSharedMemorySize, LDS_BYTES) != hipSuccess) { fprintf(stderr, "kernel_launch: hipFuncSetAttribute failed\n"); grid = -1; return; }
        if (hipOccupancyMaxActiveBlocksPerMultiprocessor(&per_cu, (const void*)skel_fwd, NWAVES * 64, LDS_BYTES) != hipSuccess || per_cu < 1)
            fprintf(stderr, "kernel_launch: note: occupancy query reports %d workgroups per CU\n", per_cu);
        (void)hipGetLastError();
        grid = cus;
        if (grid < SG) { fprintf(stderr, "kernel_launch: needs >= %d CUs\n", SG); grid = -1; return; }
    }
    if (grid < 0) return;
    if (hipMemsetAsync((char*)d_ws + WS_CTL, 0, CTL_ZERO_BYTES, stream) != hipSuccess) { fprintf(stderr, "kernel_launch: hipMemsetAsync failed\n"); return; }
    Args a{};
    for (int i = 0; i < 23; ++i) a.in[i] = (const float*)d_in[i];
    a.out = (float*)d_out; a.ws = (unsigned char*)d_ws;
    for (int li = 0; li < N_LAUNCHES; ++li) {
        a.ph_lo = (N_LAUNCHES == 1) ? 0 : li; a.ph_hi = (N_LAUNCHES == 1) ? NPH : li + 1; a.li = li;
        hipLaunchKernelGGL(skel_fwd, dim3(grid), dim3(NWAVES * 64), LDS_BYTES, stream, a);
        const hipError_t le = hipPeekAtLastError();
        if (le != hipSuccess) { fprintf(stderr, "kernel_launch: launch %d failed: %s\n", li, hipGetErrorName(le)); break; }
    }
}
```

```cpp
#define F8_UP 1
#define F8_DN 0
#ifndef SSM_FAST
#define SSM_FAST 1
#endif
#ifndef F8_UP
#define F8_UP 1
#endif
#ifndef F8_DN
#define F8_DN 1
#endif
#include <hip/hip_runtime.h>
#include <cstdio>
#include <cstdint>
namespace pg8 {
#define PG8_LAS __attribute__((address_space(3)))
typedef unsigned short bf16_t;
typedef short bf16x8 __attribute__((ext_vector_type(8)));
typedef float f32x4 __attribute__((ext_vector_type(4)));
typedef unsigned u32x4 __attribute__((ext_vector_type(4)));
constexpr int BM = 256, BK = 64, HALF = 128, HTB = HALF * BK * 2  , STAGE_BYTES = 8 * HTB, NXCD = 8, WGM = 8;

__host__ __device__ __forceinline__ int lds_byte(int r, int c) { const int st = (r >> 4) * 2 + (c >> 5), rr = r & 15, cc = c & 31, ob = rr * 64 + cc * 2; return st * 1024 + (ob ^ (((ob >> 9) & 1) << 5)); }
__host__ __device__ __forceinline__ void stage_rc(int b, int& R, int& C) { const int st = b / 1024, sb = b % 1024, swz = sb ^ (((sb >> 9) & 1) << 5); R = (st >> 1) * 16 + swz / 64; C = (st & 1) * 32 + (swz % 64) / 2; }
__host__ __device__ __forceinline__ int perm32(int rho) { const int n = rho >> 4, i = rho & 15; return 8 * (i >> 2) + 4 * n + (i & 3); }

struct Unit { int pm, pn; };
struct Gemm { const bf16_t* A; const bf16_t* Bt; int M, N, K; int lda, ldb; };

struct StaticOrder {
    int nM, nN, nwg, G, c;
    __host__ __device__ void init(int M, int N, int G_, int c_) { nM = M / BM; nN = N / BM; nwg = nM * nN; G = G_; c = c_; }
    __host__ __device__ bool next(int i, Unit& u) const {
        const long L = (long)i * G + c; if (L >= nwg) return false;
        int wgid = (int)L; { const int q = nwg / NXCD, r = nwg % NXCD, xcd = wgid % NXCD, off = wgid / NXCD; wgid = (xcd < r ? xcd * (q + 1) : r * (q + 1) + (xcd - r) * q) + off; }
        const int nig = WGM * nN, gid = wgid / nig, fm = gid * WGM, gsz = (nM - fm) < WGM ? (nM - fm) : WGM;
        u.pm = fm + ((wgid % nig) % gsz); u.pn = (wgid % nig) / gsz; return true;
    }
    __device__ __forceinline__ void a_ready(const Unit&) const {}
    __device__ __forceinline__ void done(const Unit&) const {}
};

__device__ __forceinline__ unsigned cvt_pk_bf16(float lo, float hi) { unsigned r; asm volatile("v_cvt_pk_bf16_f32 %0, %1, %2" : "=v"(r) : "v"(lo), "v"(hi)); return r; }
typedef float f32x2 __attribute__((ext_vector_type(2)));
__device__ __forceinline__ f32x2 gelu_pk(f32x2 v) {
    const f32x2 av = __builtin_elementwise_abs(v), d = av * 0.2316418882f + 1.0f;
    f32x2 t; t.x = __builtin_amdgcn_rcpf(d.x); t.y = __builtin_amdgcn_rcpf(d.y);
    f32x2 q = t * 0.5307027145f + (-0.7265760135f); q = q * t + 0.7107068705f; q = q * t + (-0.142248368f); q = q * t + 0.127414796f; q = q * t;
    const f32x2 s = (v * v) * (-0.72134752044f);
    f32x2 e; e.x = __builtin_amdgcn_exp2f(s.x); e.y = __builtin_amdgcn_exp2f(s.y);
    const f32x2 m = v * (q * e), r = v - m;
    f32x2 o; o.x = v.x < 0.f ? m.x : r.x; o.y = v.y < 0.f ? m.y : r.y; return o;
}

template <int ACT  > struct EpiBf16 {
    static constexpr bool PERM = true, AFTER_DRAIN = false; static_assert(ACT == 0 || ACT == 1, "EpiBf16: ACT is 0 (none) or 1 (gelu_pk)");
    bf16_t* O; int ldc; const float* bias; int split_cols; size_t split_stride; float scale0;
    __device__ __forceinline__ void operator()(const f32x4 (&acc)[2][2][4][2], const Unit& u, int wr, int wc, int fr, int fq) const {
        const int row0 = u.pm * BM + wr * 64 + fr; int colt = u.pn * BM; bf16_t* base = O;
        float sc = 1.f; if (split_cols) { const int t = colt / split_cols; base += (size_t)t * split_stride; colt -= t * split_cols; if (t == 0) sc = scale0; }
        const int col0 = colt + wc * 32 + 8 * fq, bcol0 = u.pn * BM + wc * 32 + 8 * fq;
        f32x4 bv[2][2];
#pragma unroll
        for (int bj = 0; bj < 2; ++bj)
#pragma unroll
            for (int n = 0; n < 2; ++n) bv[bj][n] = bias ? *(const f32x4*)(bias + bcol0 + bj * HALF + 4 * n) : (f32x4){0.f, 0.f, 0.f, 0.f};
#pragma unroll
        for (int ai = 0; ai < 2; ++ai)
#pragma unroll
            for (int m = 0; m < 4; ++m) { bf16_t* rowp = base + (size_t)(row0 + ai * HALF + m * 16) * ldc + col0;
#pragma unroll
                for (int bj = 0; bj < 2; ++bj) { f32x4 v0 = acc[ai][bj][m][0] + bv[bj][0], v1 = acc[ai][bj][m][1] + bv[bj][1];
                    if (ACT == 1) { f32x2 a = gelu_pk((f32x2){v0[0], v0[1]}), b = gelu_pk((f32x2){v0[2], v0[3]}), c = gelu_pk((f32x2){v1[0], v1[1]}), d = gelu_pk((f32x2){v1[2], v1[3]});
                        v0 = (f32x4){a.x, a.y, b.x, b.y}; v1 = (f32x4){c.x, c.y, d.x, d.y}; }
                    v0 = v0 * sc; v1 = v1 * sc; u32x4 w; w.x = cvt_pk_bf16(v0[0], v0[1]); w.y = cvt_pk_bf16(v0[2], v0[3]); w.z = cvt_pk_bf16(v1[0], v1[1]); w.w = cvt_pk_bf16(v1[2], v1[3]);
                    *(u32x4*)(rowp + bj * HALF) = w; } }
    }
};

typedef unsigned u32x2 __attribute__((ext_vector_type(2)));
__device__ __forceinline__ unsigned pk4_fp8(float a, float b, float c, float d) {
    unsigned w = 0u; w = __builtin_amdgcn_cvt_pk_fp8_f32(a, b, w, false); w = __builtin_amdgcn_cvt_pk_fp8_f32(c, d, w, true); return w; }
__device__ __forceinline__ float bf_lo(unsigned w) { return __uint_as_float(w << 16); }
__device__ __forceinline__ float bf_hi(unsigned w) { return __uint_as_float(w & 0xffff0000u); }
__device__ __forceinline__ float sigmoid_f(float v) { return __builtin_amdgcn_rcpf(1.0f + __builtin_amdgcn_exp2f(-1.4426950408889634f * v)); }
struct EpiGlu {
    static constexpr bool PERM = true, AFTER_DRAIN = false;
    const bf16_t* Y; bf16_t* Z; int ldc; const float* bias;
    __device__ __forceinline__ void operator()(const f32x4 (&acc)[2][2][4][2], const Unit& u, int wr, int wc, int fr, int fq) const {
        const int row0 = u.pm * BM + wr * 64 + fr, col0 = u.pn * BM + wc * 32 + 8 * fq;
        f32x4 bv[2][2];
#pragma unroll
        for (int bj = 0; bj < 2; ++bj)
#pragma unroll
            for (int n = 0; n < 2; ++n) bv[bj][n] = *(const f32x4*)(bias + col0 + bj * HALF + 4 * n);
#pragma unroll
        for (int ai = 0; ai < 2; ++ai)
#pragma unroll
            for (int m = 0; m < 4; ++m) { const size_t off = (size_t)(row0 + ai * HALF + m * 16) * ldc + col0;
#pragma unroll
                for (int bj = 0; bj < 2; ++bj) { const u32x4 yv = *(const u32x4*)(Y + off + bj * HALF);
                    const f32x4 v0 = acc[ai][bj][m][0] + bv[bj][0], v1 = acc[ai][bj][m][1] + bv[bj][1];
                    u32x4 w;
                    w.x = cvt_pk_bf16(bf_lo(yv.x) * sigmoid_f(v0[0]), bf_hi(yv.x) * sigmoid_f(v0[1]));
                    w.y = cvt_pk_bf16(bf_lo(yv.y) * sigmoid_f(v0[2]), bf_hi(yv.y) * sigmoid_f(v0[3]));
                    w.z = cvt_pk_bf16(bf_lo(yv.z) * sigmoid_f(v1[0]), bf_hi(yv.z) * sigmoid_f(v1[1]));
                    w.w = cvt_pk_bf16(bf_lo(yv.w) * sigmoid_f(v1[2]), bf_hi(yv.w) * sigmoid_f(v1[3]));
                    *(u32x4*)(Z + off + bj * HALF) = w; } }
    }
};
template <bool F8O> struct EpiResid1 {
    static constexpr bool PERM = true, AFTER_DRAIN = false;
    const float* X; float* X1; unsigned char* X1G; const float* gw; float* ssq; int ldc;
    __device__ __forceinline__ void operator()(const f32x4 (&acc)[2][2][4][2], const Unit& u, int wr, int wc, int fr, int fq) const {
        const int row0 = u.pm * BM + wr * 64 + fr, col0 = u.pn * BM + wc * 32 + 8 * fq;
        f32x4 gv[2][2];
#pragma unroll
        for (int bj = 0; bj < 2; ++bj)
#pragma unroll
            for (int n = 0; n < 2; ++n) gv[bj][n] = *(const f32x4*)(gw + col0 + bj * HALF + 4 * n);
#pragma unroll
        for (int ai = 0; ai < 2; ++ai)
#pragma unroll
            for (int m = 0; m < 4; ++m) { const int row = row0 + ai * HALF + m * 16; const size_t off = (size_t)row * ldc + col0; float s = 0.f;
#pragma unroll
                for (int bj = 0; bj < 2; ++bj) {
                    const f32x4 v0 = *(const f32x4*)(X + off + bj * HALF) + acc[ai][bj][m][0], v1 = *(const f32x4*)(X + off + bj * HALF + 4) + acc[ai][bj][m][1];
                    *(f32x4*)(X1 + off + bj * HALF) = v0; *(f32x4*)(X1 + off + bj * HALF + 4) = v1;
                    s += (v0[0] * v0[0] + v0[1] * v0[1]) + (v0[2] * v0[2] + v0[3] * v0[3]) + (v1[0] * v1[0] + v1[1] * v1[1]) + (v1[2] * v1[2] + v1[3] * v1[3]);
                    const f32x4 g0 = v0 * gv[bj][0], g1 = v1 * gv[bj][1];
                    if constexpr (F8O) { u32x2 w; w.x = pk4_fp8(g0[0], g0[1], g0[2], g0[3]); w.y = pk4_fp8(g1[0], g1[1], g1[2], g1[3]); *(u32x2*)(X1G + off + bj * HALF) = w; }
                    else { u32x4 w; w.x = cvt_pk_bf16(g0[0], g0[1]); w.y = cvt_pk_bf16(g0[2], g0[3]); w.z = cvt_pk_bf16(g1[0], g1[1]); w.w = cvt_pk_bf16(g1[2], g1[3]); *(u32x4*)((bf16_t*)X1G + off + bj * HALF) = w; } }
                s += __shfl_xor(s, 16); s += __shfl_xor(s, 32);
                if (fq == 0) ssq[(size_t)row * 32 + u.pn * 4 + wc] = s; }
    }
};
struct EpiUp {
    static constexpr bool PERM = true, AFTER_DRAIN = false;
    bf16_t* O; int ldc; const float* ssq; float inv_n, eps, wscale;
    __device__ __forceinline__ void operator()(const f32x4 (&acc)[2][2][4][2], const Unit& u, int wr, int wc, int fr, int fq) const {
        const int row0 = u.pm * BM + wr * 64 + fr, col0 = u.pn * BM + wc * 32 + 8 * fq;
#pragma unroll
        for (int ai = 0; ai < 2; ++ai)
#pragma unroll
            for (int m = 0; m < 4; ++m) { const int row = row0 + ai * HALF + m * 16; const f32x4* sp = (const f32x4*)(ssq + (size_t)row * 32);
                f32x4 t = sp[0];
#pragma unroll
                for (int k = 1; k < 8; ++k) t += sp[k];
                const float rstd = __builtin_amdgcn_rsqf(((t[0] + t[1]) + (t[2] + t[3])) * inv_n + eps) * wscale;
                bf16_t* rowp = O + (size_t)row * ldc + col0;
#pragma unroll
                for (int bj = 0; bj < 2; ++bj) { const f32x4 v0 = acc[ai][bj][m][0] * rstd, v1 = acc[ai][bj][m][1] * rstd; u32x4 w;
                    w.x = cvt_pk_bf16(v0[0], v0[1]); w.y = cvt_pk_bf16(v0[2], v0[3]); w.z = cvt_pk_bf16(v1[0], v1[1]); w.w = cvt_pk_bf16(v1[2], v1[3]);
                    *(u32x4*)(rowp + bj * HALF) = w; } }
    }
};
struct EpiResid2 {
    static constexpr bool PERM = true, AFTER_DRAIN = false;
    float* OUT; int ldc; float wscale;
    __device__ __forceinline__ void operator()(const f32x4 (&acc)[2][2][4][2], const Unit& u, int wr, int wc, int fr, int fq) const {
        const int row0 = u.pm * BM + wr * 64 + fr, col0 = u.pn * BM + wc * 32 + 8 * fq;
#pragma unroll
        for (int ai = 0; ai < 2; ++ai)
#pragma unroll
            for (int m = 0; m < 4; ++m) { float* rowp = OUT + (size_t)(row0 + ai * HALF + m * 16) * ldc + col0;
#pragma unroll
                for (int bj = 0; bj < 2; ++bj) { f32x4* p = (f32x4*)(rowp + bj * HALF); const f32x4 a = p[0], b = p[1]; p[0] = a + acc[ai][bj][m][0] * wscale; p[1] = b + acc[ai][bj][m][1] * wscale; } }
    }
};
__device__ __forceinline__ float gelu_tanh_f(float y) {
    const float u = 0.7978845608028654f * (y + 0.044715f * y * y * y);
    const float e = __builtin_amdgcn_exp2f(2.0f * 1.4426950408889634f * u);
    return 0.5f * y * (2.0f - 2.0f * __builtin_amdgcn_rcpf(e + 1.0f));
}
struct EpiQKVU {
    static constexpr bool PERM = true, AFTER_DRAIN = false;
    bf16_t* Q; size_t split_stride; bf16_t* A2; float scale0;
    __device__ __forceinline__ void operator()(const f32x4 (&acc)[2][2][4][2], const Unit& u, int wr, int wc, int fr, int fq) const {
        const int row0 = u.pm * BM + wr * 64 + fr; const int colt = u.pn * BM, t = colt >> 10, col0 = (colt & 1023) + wc * 32 + 8 * fq;
        const float sc = (t == 0) ? scale0 : 1.f;
#pragma unroll
        for (int ai = 0; ai < 2; ++ai)
#pragma unroll
            for (int m = 0; m < 4; ++m) { const int row = row0 + ai * HALF + m * 16;
#pragma unroll
                for (int bj = 0; bj < 2; ++bj) { const int c = col0 + bj * HALF; const f32x4 v0 = acc[ai][bj][m][0] * sc, v1 = acc[ai][bj][m][1] * sc; u32x4 w;
                    w.x = cvt_pk_bf16(v0[0], v0[1]); w.y = cvt_pk_bf16(v0[2], v0[3]); w.z = cvt_pk_bf16(v1[0], v1[1]); w.w = cvt_pk_bf16(v1[2], v1[3]);
                    if (t < 3) *(u32x4*)(Q + (size_t)t * split_stride + (size_t)row * 1024 + c) = w;
                    else { const int b = row >> 12, tok = row & 4095; *(u32x4*)(A2 + ((size_t)((c >> 4) * 256 + b * 128 + (tok >> 5)) * 640 + (tok & 31) * 16 + (c & 15))) = w; } } }
    }
};
struct EpiS {
    static constexpr bool PERM = false, AFTER_DRAIN = false;
    float* S;
    __device__ __forceinline__ void operator()(const f32x4 (&acc)[2][2][4][2], const Unit& u, int wr, int wc, int fr, int fq) const {
        const int row0 = wr * 64 + fr, col0 = wc * 32 + 4 * fq;
#pragma unroll
        for (int ai = 0; ai < 2; ++ai)
#pragma unroll
            for (int m = 0; m < 4; ++m) { float* rowp = S + ((size_t)u.pm * 256 + row0 + ai * HALF + m * 16) * 128 + col0;
#pragma unroll
                for (int n = 0; n < 2; ++n) *(f32x4*)(rowp + n * 16) = acc[ai][0][m][n]; }
    }
};
struct EpiY {
    static constexpr bool PERM = true, AFTER_DRAIN = false;
    bf16_t* Y;
    __device__ __forceinline__ void operator()(const f32x4 (&acc)[2][2][4][2], const Unit& u, int wr, int wc, int fr, int fq) const {
        const int row0 = wr * 64 + fr, col0 = (u.pn & 1) * BM + wc * 32 + 8 * fq, g = u.pm;
#pragma unroll
        for (int ai = 0; ai < 2; ++ai)
#pragma unroll
            for (int m = 0; m < 4; ++m) { const int R = row0 + ai * HALF + m * 16, b = R >> 7, c = R & 127;
#pragma unroll
                for (int bj = 0; bj < 2; ++bj) { const int cl = col0 + bj * HALF, t = cl >> 4, h0 = cl & 15; const f32x4 v0 = acc[ai][bj][m][0], v1 = acc[ai][bj][m][1]; u32x4 w;
                    w.x = cvt_pk_bf16(gelu_tanh_f(v0[0]), gelu_tanh_f(v0[1])); w.y = cvt_pk_bf16(gelu_tanh_f(v0[2]), gelu_tanh_f(v0[3]));
                    w.z = cvt_pk_bf16(gelu_tanh_f(v1[0]), gelu_tanh_f(v1[1])); w.w = cvt_pk_bf16(gelu_tanh_f(v1[2]), gelu_tanh_f(v1[3]));
                    *(u32x4*)(Y + (size_t)(b * 4096 + c * 32 + t) * 1024 + g * 16 + h0) = w; } }
    }
};
struct GroupOrder {
    int g, nu, pn0;
    __device__ __forceinline__ bool next(int i, Unit& u) const { if (i >= nu) return false; u.pm = g; u.pn = pn0 + i; return true; }
    __device__ __forceinline__ void a_ready(const Unit&) const {}
    __device__ __forceinline__ void done(const Unit&) const {}
};
typedef int v4i32_t __attribute__((ext_vector_type(4)));
typedef int v8i32_t __attribute__((ext_vector_type(8)));
__device__ __forceinline__ f32x4 mfma8(bf16x8 b0, bf16x8 b1, bf16x8 a0, bf16x8 a1, f32x4 c) {
    const v8i32_t bb = __builtin_shufflevector(__builtin_bit_cast(v4i32_t, b0), __builtin_bit_cast(v4i32_t, b1), 0, 1, 2, 3, 4, 5, 6, 7);
    const v8i32_t aa = __builtin_shufflevector(__builtin_bit_cast(v4i32_t, a0), __builtin_bit_cast(v4i32_t, a1), 0, 1, 2, 3, 4, 5, 6, 7);
    return __builtin_amdgcn_mfma_scale_f32_16x16x128_f8f6f4(bb, aa, c, 0, 0, 0, 0, 0, 0);
}
template <class Epi, class Sched, bool ALIGN_EPI = false, bool SP2 = false, bool F8 = false>
__device__ __forceinline__ void gemm_phase(PG8_LAS unsigned char* lds, const Gemm g, const Sched& S, const Epi& E) {
    const int tid = threadIdx.x, wid = __builtin_amdgcn_readfirstlane(tid >> 6), lane = tid & 63, wr = wid >> 2, wc = wid & 3, fr = lane & 15, fq = lane >> 4;
    const int K = g.K, nt = K / BK, lda = g.lda ? g.lda : K, ldb = g.ldb ? g.ldb : K;
    unsigned voffA[2], voffB[2];
#pragma unroll
    for (int i = 0; i < 2; ++i) { int R, C; stage_rc(tid * 16 + i * 8192, R, C); const int Rb = Epi::PERM ? ((R & ~31) + perm32(R & 31)) : R;
        voffA[i] = (unsigned)(R * lda + C) * 2u; voffB[i] = (unsigned)(Rb * ldb + C) * 2u; }
    const size_t kstep = (size_t)(BK * 2);
    const size_t hstepA = (size_t)HALF * lda * 2, hstepB = (size_t)HALF * ldb * 2;
    const size_t tstepA = 2 * hstepA, tstepB = 2 * hstepB;
    const unsigned ldsw = (unsigned)wid * 1024u;
    const int aoff = lds_byte(wr * 64 + fr, fq * 8), boff = lds_byte(wc * 32 + fr, fq * 8);
#define PG8_SA(b, h) (((b) * 2 + (h)) * HTB)
#define PG8_SB(b, h) ((4 + (b) * 2 + (h)) * HTB)
#define PG8_STAGE(bufoff, gbase, voff) do { _Pragma("unroll") for (int _i = 0; _i < 2; ++_i) \
        __builtin_amdgcn_global_load_lds((const unsigned*)((const char*)(gbase) + (voff)[_i]), (PG8_LAS unsigned*)(lds + (bufoff) + ldsw + _i * 8192), 16, 0, 0); } while (0)
#define PG8_LD8(addr) __builtin_shufflevector(*(const PG8_LAS v4i32_t*)(addr), *(const PG8_LAS v4i32_t*)((addr) + 1024), 0, 1, 2, 3, 4, 5, 6, 7)
#define PG8_LDA(dst, b, h) do { if constexpr (F8) { _Pragma("unroll") for (int m = 0; m < 4; ++m) dst##8[m] = PG8_LD8(lds + PG8_SA(b, h) + aoff + m * 2048); } else { \
        _Pragma("unroll") for (int m = 0; m < 4; ++m) _Pragma("unroll") for (int k = 0; k < 2; ++k) dst[m][k] = *(const PG8_LAS bf16x8*)(lds + PG8_SA(b, h) + aoff + m * 2048 + k * 1024); } } while (0)
#define PG8_LDB(dst, b, h) do { if constexpr (F8) { _Pragma("unroll") for (int n = 0; n < 2; ++n) dst##8[n] = PG8_LD8(lds + PG8_SB(b, h) + boff + n * 2048); } else { \
        _Pragma("unroll") for (int n = 0; n < 2; ++n) _Pragma("unroll") for (int k = 0; k < 2; ++k) dst[n][k] = *(const PG8_LAS bf16x8*)(lds + PG8_SB(b, h) + boff + n * 2048 + k * 1024); } } while (0)
#define PG8_MMA(ai, bj, At, Bt) do { __builtin_amdgcn_s_setprio(1); \
        if constexpr (F8) { _Pragma("unroll") for (int m = 0; m < 4; ++m) _Pragma("unroll") for (int n = 0; n < 2; ++n) asm volatile("v_mfma_f32_16x16x128_f8f6f4 %0, %1, %2, %0" : "+v"(acc[ai][bj][m][n]) : "v"(Bt##8[n]), "v"(At##8[m])); } \
        else { _Pragma("unroll") for (int m = 0; m < 4; ++m) _Pragma("unroll") for (int n = 0; n < 2; ++n) _Pragma("unroll") for (int k = 0; k < 2; ++k) \
        acc[ai][bj][m][n] = __builtin_amdgcn_mfma_f32_16x16x32_bf16(Bt[n][k], At[m][k], acc[ai][bj][m][n], 0, 0, 0); } __builtin_amdgcn_s_setprio(0); } while (0)
#define PG8_WAIT_V(n) asm volatile("s_waitcnt vmcnt(" #n ")" ::: "memory")
#define PG8_WAIT_L(n) asm volatile("s_waitcnt lgkmcnt(" #n ")" ::: "memory")
#define PG8_BAR __builtin_amdgcn_s_barrier()
#define PG8_SCHED __builtin_amdgcn_sched_barrier(0)
    Unit cur, nxt; int ui = 0;
    if (!S.next(0, cur)) return;
    f32x4 acc[2][2][4][2];
#pragma unroll
    for (int a = 0; a < 2; ++a)
#pragma unroll
        for (int b = 0; b < 2; ++b)
#pragma unroll
            for (int m = 0; m < 4; ++m)
#pragma unroll
                for (int n = 0; n < 2; ++n) acc[a][b][m][n] = (f32x4){0.f, 0.f, 0.f, 0.f};
    bf16x8 At[4][2], B0[2][2], B1[2][2]; v8i32_t At8[4], B08[2], B18[2];
    const char* cA = (const char*)g.A + (size_t)cur.pm * tstepA; const char* cB = (const char*)g.Bt + (size_t)cur.pn * tstepB;
    S.a_ready(cur);
    if constexpr (SP2) {
        PG8_STAGE(PG8_SB(0, 0), cB, voffB); PG8_STAGE(PG8_SB(0, 1), cB + hstepB, voffB); PG8_STAGE(PG8_SA(0, 0), cA, voffA); PG8_STAGE(PG8_SA(0, 1), cA + hstepA, voffA);
        if (wr == 1) PG8_BAR;
        PG8_WAIT_V(2); PG8_BAR;
        PG8_STAGE(PG8_SB(1, 0), cB + kstep, voffB); PG8_STAGE(PG8_SA(1, 0), cA + kstep, voffA); PG8_STAGE(PG8_SB(1, 1), cB + hstepB + kstep, voffB);
        PG8_WAIT_V(6); PG8_BAR;
    } else {
        PG8_STAGE(PG8_SB(0, 0), cB, voffB); PG8_STAGE(PG8_SA(0, 0), cA, voffA); PG8_STAGE(PG8_SB(0, 1), cB + hstepB, voffB); PG8_STAGE(PG8_SA(0, 1), cA + hstepA, voffA);
        if (wr == 1) PG8_BAR;
        PG8_WAIT_V(4); PG8_BAR;
        PG8_STAGE(PG8_SB(1, 0), cB + kstep, voffB); PG8_STAGE(PG8_SA(1, 0), cA + kstep, voffA); PG8_STAGE(PG8_SB(1, 1), cB + hstepB + kstep, voffB);
        PG8_WAIT_V(6); PG8_BAR;
    }
    for (;;) {
        const bool has_next = S.next(ui + 1, nxt);
        const char* nA = has_next ? (const char*)g.A + (size_t)nxt.pm * tstepA : cA; const char* nB = has_next ? (const char*)g.Bt + (size_t)nxt.pn * tstepB : cB;
        for (int t = 0; t < nt; t += 2) {
            const bool last = (t == nt - 2);
            const char* a1 = cA + (size_t)(t + 1) * kstep;
            const char* a2 = last ? nA : cA + (size_t)(t + 2) * kstep; const char* b2 = last ? nB : cB + (size_t)(t + 2) * kstep;
            const char* a3 = a2 + kstep; const char* b3 = b2 + kstep;
            if (last && has_next) S.a_ready(nxt);
            if constexpr (SP2) {
            PG8_LDB(B0, 0, 0); PG8_LDB(B1, 0, 1); PG8_SCHED; PG8_LDA(At, 0, 0); PG8_STAGE(PG8_SA(1, 1), a1 + hstepA, voffA);
            PG8_WAIT_V(8); PG8_WAIT_L(0); PG8_BAR; PG8_MMA(0, 0, At, B0); PG8_MMA(0, 1, At, B1); PG8_BAR; PG8_SCHED;
            PG8_LDA(At, 0, 1); PG8_STAGE(PG8_SB(0, 0), b2, voffB); PG8_STAGE(PG8_SB(0, 1), b2 + hstepB, voffB); PG8_STAGE(PG8_SA(0, 0), a2, voffA);
            PG8_WAIT_V(8); PG8_WAIT_L(0); PG8_BAR; PG8_MMA(1, 0, At, B0); PG8_MMA(1, 1, At, B1); PG8_BAR; PG8_SCHED;
            PG8_LDB(B0, 1, 0); PG8_LDB(B1, 1, 1); PG8_SCHED; PG8_LDA(At, 1, 0); PG8_STAGE(PG8_SA(0, 1), a2 + hstepA, voffA);
            PG8_WAIT_V(8); PG8_WAIT_L(0); PG8_BAR; PG8_MMA(0, 0, At, B0); PG8_MMA(0, 1, At, B1); PG8_BAR; PG8_SCHED;
            PG8_LDA(At, 1, 1); PG8_STAGE(PG8_SB(1, 0), b3, voffB); PG8_STAGE(PG8_SB(1, 1), b3 + hstepB, voffB); PG8_STAGE(PG8_SA(1, 0), a3, voffA);
            PG8_WAIT_V(8); PG8_WAIT_L(0); PG8_BAR; PG8_MMA(1, 0, At, B0); PG8_MMA(1, 1, At, B1); PG8_BAR; PG8_SCHED;
            } else {
            PG8_LDB(B0, 0, 0); PG8_SCHED; PG8_LDA(At, 0, 0); PG8_STAGE(PG8_SA(1, 1), a1 + hstepA, voffA);
            PG8_WAIT_L(8); PG8_BAR; PG8_WAIT_L(0); PG8_MMA(0, 0, At, B0); PG8_BAR; PG8_SCHED;
            PG8_LDB(B1, 0, 1); PG8_STAGE(PG8_SB(0, 0), b2, voffB);
            PG8_BAR; PG8_WAIT_L(0); PG8_MMA(0, 1, At, B1); PG8_BAR;
            PG8_LDA(At, 0, 1); PG8_STAGE(PG8_SA(0, 0), a2, voffA);
            PG8_BAR; PG8_WAIT_L(0); PG8_MMA(1, 0, At, B0); PG8_BAR; PG8_SCHED;
            PG8_STAGE(PG8_SB(0, 1), b2 + hstepB, voffB);
            PG8_WAIT_V(6); PG8_BAR; PG8_MMA(1, 1, At, B1); PG8_BAR;
            PG8_LDB(B0, 1, 0); PG8_SCHED; PG8_LDA(At, 1, 0); PG8_STAGE(PG8_SA(0, 1), a2 + hstepA, voffA);
            PG8_WAIT_L(8); PG8_BAR; PG8_WAIT_L(0); PG8_MMA(0, 0, At, B0); PG8_BAR; PG8_SCHED;
            PG8_LDB(B1, 1, 1); PG8_STAGE(PG8_SB(1, 0), b3, voffB);
            PG8_BAR; PG8_WAIT_L(0); PG8_MMA(0, 1, At, B1); PG8_BAR;
            PG8_LDA(At, 1, 1); PG8_STAGE(PG8_SA(1, 0), a3, voffA);
            PG8_BAR; PG8_WAIT_L(0); PG8_MMA(1, 0, At, B0); PG8_BAR; PG8_SCHED;
            PG8_STAGE(PG8_SB(1, 1), b3 + hstepB, voffB);
            PG8_WAIT_V(6); PG8_BAR; PG8_MMA(1, 1, At, B1); PG8_BAR;
            }
        }
        if constexpr (ALIGN_EPI) { if (wr == 0) PG8_BAR; }
        if constexpr (F8) {
            asm volatile("s_nop 15\n\ts_nop 15" : "+v"(acc[0][0][0][0]), "+v"(acc[0][0][0][1]), "+v"(acc[0][0][1][0]), "+v"(acc[0][0][1][1]), "+v"(acc[0][0][2][0]), "+v"(acc[0][0][2][1]), "+v"(acc[0][0][3][0]), "+v"(acc[0][0][3][1]),
                                                  "+v"(acc[0][1][0][0]), "+v"(acc[0][1][0][1]), "+v"(acc[0][1][1][0]), "+v"(acc[0][1][1][1]), "+v"(acc[0][1][2][0]), "+v"(acc[0][1][2][1]), "+v"(acc[0][1][3][0]), "+v"(acc[0][1][3][1]));
            asm volatile("" : "+v"(acc[1][0][0][0]), "+v"(acc[1][0][0][1]), "+v"(acc[1][0][1][0]), "+v"(acc[1][0][1][1]), "+v"(acc[1][0][2][0]), "+v"(acc[1][0][2][1]), "+v"(acc[1][0][3][0]), "+v"(acc[1][0][3][1]),
                              "+v"(acc[1][1][0][0]), "+v"(acc[1][1][0][1]), "+v"(acc[1][1][1][0]), "+v"(acc[1][1][1][1]), "+v"(acc[1][1][2][0]), "+v"(acc[1][1][2][1]), "+v"(acc[1][1][3][0]), "+v"(acc[1][1][3][1])); }
        if constexpr (!Epi::AFTER_DRAIN) { E(acc, cur, wr, wc, fr, fq); S.done(cur); }
        if (!has_next) break;
#pragma unroll
        for (int a = 0; a < 2; ++a)
#pragma unroll
            for (int b = 0; b < 2; ++b)
#pragma unroll
                for (int m = 0; m < 4; ++m)
#pragma unroll
                    for (int n = 0; n < 2; ++n) acc[a][b][m][n] = (f32x4){0.f, 0.f, 0.f, 0.f};
        cur = nxt; cA = nA; cB = nB; ++ui;
        if constexpr (ALIGN_EPI) { if (wr == 1) PG8_BAR; }
    }
    PG8_WAIT_V(0);
    if constexpr (!ALIGN_EPI) { if (wr == 0) PG8_BAR; }
    PG8_BAR;
    if constexpr (Epi::AFTER_DRAIN) { E.fused(acc, cur, wr, wc, fr, fq, lds, wid, lane); S.done(cur); }
#undef PG8_SA
#undef PG8_SB
#undef PG8_STAGE
#undef PG8_LDA
#undef PG8_LD8
#undef PG8_LDB
#undef PG8_MMA
#undef PG8_WAIT_V
#undef PG8_WAIT_L
#undef PG8_BAR
#undef PG8_SCHED
}
}

#ifndef PG8_SP2
#define PG8_SP2 true
#endif
#ifndef PG8_ALIGN
#define PG8_ALIGN true
#endif
#include <cmath>

constexpr int NWAVES = 8;
constexpr int NPH = 11;
#ifndef MK_N_LAUNCHES
#define MK_N_LAUNCHES 1
#endif
constexpr int N_LAUNCHES = MK_N_LAUNCHES;
static_assert(N_LAUNCHES == 1 || N_LAUNCHES == NPH, "MK_N_LAUNCHES is 1 or NPH");

constexpr int BATCH = 2, SEQ = 4096, DM = 2048, M = BATCH * SEQ;
constexpr int AH = 16, HD = 64, AW = AH * HD;
constexpr int SG = 64, SC = 16, SW = SG * SC, SP = 64;
constexpr int INC = 3 * AW + SW;
constexpr int MOBA_BLK = 256, NBLK = SEQ / MOBA_BLK, TOPK = 3;
constexpr int DFF = 5632, DFF2 = 2 * DFF;
constexpr float RMS_EPS = 1e-6f;
constexpr float LOG2E = 1.4426950408889634f;
constexpr float WSCALE = 64.0f;
constexpr float C2 = 0.125f * LOG2E;

constexpr size_t MiB = 1u << 20;
constexpr size_t WS_CTL = 0, CTL_ZERO_BYTES = 1 * MiB;
constexpr size_t WS_WDOWN = 1 * MiB;
constexpr size_t WS_WIN = 23 * MiB;
constexpr size_t WS_WGLU = 39 * MiB;
constexpr size_t WS_WOUT = 41 * MiB;
constexpr size_t WS_WUP = 49 * MiB;
constexpr size_t WS_XN = 93 * MiB;
constexpr size_t WS_Q = 125 * MiB, WS_K = 141 * MiB, WS_V = 157 * MiB, WS_U = 173 * MiB;
constexpr size_t WS_Y = 189 * MiB, WS_Z = 205 * MiB;
constexpr size_t WS_UP = 125 * MiB;
constexpr size_t WS_X1G = 301 * MiB;
constexpr size_t WS_ACT = 23 * MiB;
constexpr size_t WS_SSQ = 333 * MiB;
constexpr size_t WS_KMEAN = 334 * MiB;
constexpr size_t WS_T5B = 335 * MiB;
constexpr size_t WS_A2 = 221 * MiB;
constexpr size_t WS_S = 241 * MiB;
constexpr size_t WS_BTS = 249 * MiB;
constexpr size_t WS_BT2 = 265 * MiB;
constexpr size_t WS_END = 336 * MiB;
static_assert(WS_ACT + (size_t)M * DFF * 2 <= WS_Q && WS_UP + (size_t)M * DFF2 * 2 <= WS_X1G && WS_WUP + (size_t)DFF2 * DM * 2 <= WS_XN, "d_ws map");
constexpr int CW_TMO = 0, CW_CODE = 1;
constexpr int CW_BAR = 4096;

constexpr int RING_OFF = 0, RING_BYTES = 131072;
constexpr int LDSCTL_OFF = RING_BYTES, MISC_OFF = LDSCTL_OFF + 320;
constexpr int LDS_BYTES = 147456;
static_assert(MISC_OFF + 128 <= LDS_BYTES, "LDS map");

#include <hip/hip_bf16.h>
#include <cmath>
namespace attn_body {
using bf16=__hip_bfloat16;
using bf16x8=__attribute__((ext_vector_type(8)))short;
using s16x4=__attribute__((ext_vector_type(4)))short;
using f32x16=__attribute__((ext_vector_type(16)))float;
using u32x4=__attribute__((ext_vector_type(4)))unsigned;
using f32x4_=__attribute__((ext_vector_type(4)))float;
constexpr int BATCH=2,NHEAD=16,SEQ=4096,D=64,DM=NHEAD*D;
constexpr int NW=8,QBLK=32,QB=QBLK*NW,KVBLK=64,NQB=SEQ/QB;
constexpr int ATTN_PITCH=DM, ATTN_UNIT_ROWS=QB;
__device__ __forceinline__ int crow(int r,int hi){return (r&3)+8*(r>>2)+4*hi;}
#define SBAR() __builtin_amdgcn_sched_barrier(0)
__device__ __forceinline__ void cmask(f32x16&p0,f32x16&p1,int jb,int qrel,int hi){
  const float NEG=-INFINITY; int kb=64*jb+4*hi;
  #pragma unroll
  for(int r=0;r<16;++r){int kv=kb+(r&3)+8*(r>>2); if(kv>qrel)p0[r]=NEG; if(kv+32>qrel)p1[r]=NEG;}
}

typedef __attribute__((address_space(3))) const float* lds_cfptr;
__device__ __forceinline__ void abias(f32x16&p0,f32x16&p1,int jb,int qrel,int hi,int wid,lds_cfptr Tp){
  if(32*wid-64*jb-63>=113)return;
  const lds_cfptr tb=Tp+(255-59+qrel-64*jb-4*hi);
  #pragma unroll
  for(int r=0;r<16;++r){ p0[r]+=tb[59-((r&3)+8*(r>>2))]; p1[r]+=tb[27-((r&3)+8*(r>>2))]; }
}
constexpr int NSLOT=3, SLOTB=8192;
constexpr int LDS_K=0, LDS_V=NSLOT*SLOTB, LDS_WS=2*NSLOT*SLOTB, LDS_OST=LDS_WS+NW*64*4, LDS_KM=LDS_OST+NW*4096, LDS_BIAS=LDS_KM+4096, LDS_BYTES=LDS_BIAS+2560;
constexpr float C2=0.125f*1.4426950408889634f;
__device__ __forceinline__ void glds16(const void*gsrc,unsigned lds_dst){unsigned keep;
  asm volatile("s_mov_b32 %0, m0\n\ts_mov_b32 m0, %2\n\ts_nop 0\n\tglobal_load_lds_dwordx4 %1, off\n\ts_mov_b32 m0, %0":"=&s"(keep):"v"(gsrc),"s"(lds_dst):"memory");}
__device__ __forceinline__ float max3f(float a,float b,float c){float r;asm("v_max3_f32 %0, %1, %2, %3":"=v"(r):"v"(a),"v"(b),"v"(c));return r;}
__device__ __forceinline__ float max2f(float a,float b){float r;asm("v_max_f32_e32 %0, %1, %2":"=v"(r):"v"(a),"v"(b));return r;}
__device__ __forceinline__ float fadd_s(float a,float b){float r;asm("v_add_f32_e32 %0, %1, %2":"=v"(r):"v"(a),"v"(b));return r;}
__device__ __forceinline__ float fsub_s(float a,float b){float r;asm("v_sub_f32_e32 %0, %1, %2":"=v"(r):"v"(a),"v"(b));return r;}
typedef float f32x2_t __attribute__((ext_vector_type(2))); typedef __bf16 bf16x2_t __attribute__((ext_vector_type(2)));
__device__ __forceinline__ unsigned cvtpk_s(float lo,float hi){f32x2_t v={lo,hi};bf16x2_t b=__builtin_convertvector(v,bf16x2_t);return __builtin_bit_cast(unsigned,b);}
#define WAIT_BAR(N) asm volatile("s_waitcnt vmcnt(" #N ") lgkmcnt(0)\n\ts_barrier":::"memory")

__device__ __forceinline__ void qkt(f32x16&p0,f32x16&p1,const char*Kslot,const bf16x8*qr,const f32x16&negm,int r32,int hi){
  const char*kb=Kslot+hi*1024+r32*16;
  #pragma unroll
  for(int d0=0;d0<4;++d0){
    const bf16x8 b0=*reinterpret_cast<const bf16x8*>(kb+d0*2048);
    const bf16x8 b1=*reinterpret_cast<const bf16x8*>(kb+d0*2048+512);
    if(d0==0){p0=__builtin_amdgcn_mfma_f32_32x32x16_bf16(b0,qr[0],negm,0,0,0);p1=__builtin_amdgcn_mfma_f32_32x32x16_bf16(b1,qr[0],negm,0,0,0);}
    else{p0=__builtin_amdgcn_mfma_f32_32x32x16_bf16(b0,qr[d0],p0,0,0,0);p1=__builtin_amdgcn_mfma_f32_32x32x16_bf16(b1,qr[d0],p1,0,0,0);}}
}
typedef __attribute__((address_space(3))) const char* lds_cptr;
typedef short v4i16_t __attribute__((ext_vector_type(4)));
__device__ __forceinline__ void kload8(bf16x8*kf,lds_cptr kp){
  kf[0]=*(const __attribute__((address_space(3))) bf16x8*)(kp);      kf[1]=*(const __attribute__((address_space(3))) bf16x8*)(kp+512);
  kf[2]=*(const __attribute__((address_space(3))) bf16x8*)(kp+2048); kf[3]=*(const __attribute__((address_space(3))) bf16x8*)(kp+2560);
  kf[4]=*(const __attribute__((address_space(3))) bf16x8*)(kp+4096); kf[5]=*(const __attribute__((address_space(3))) bf16x8*)(kp+4608);
  kf[6]=*(const __attribute__((address_space(3))) bf16x8*)(kp+6144); kf[7]=*(const __attribute__((address_space(3))) bf16x8*)(kp+6656);
}
__device__ __forceinline__ void kload2(bf16x8*kf,lds_cptr kp,int j){ kf[2*j]=*(const __attribute__((address_space(3))) bf16x8*)(kp+j*2048); kf[2*j+1]=*(const __attribute__((address_space(3))) bf16x8*)(kp+j*2048+512); }
__device__ __forceinline__ s16x4 vtr(lds_cptr p){ return __builtin_bit_cast(s16x4,__builtin_amdgcn_ds_read_tr16_b64_v4i16((__attribute__((address_space(3))) v4i16_t*)p)); }
__device__ __forceinline__ float rowmax(const f32x16&p0,const f32x16&p1){
  float a=max3f(p0[0],p0[1],p1[0]),b=max3f(p0[2],p0[3],p1[1]);a=max3f(a,p1[2],p1[3]);
  #pragma unroll
  for(int r=4;r<16;r+=4){a=max3f(a,p0[r],p0[r+1]);b=max3f(b,p0[r+2],p0[r+3]);a=max3f(a,p1[r],p1[r+1]);b=max3f(b,p1[r+2],p1[r+3]);}
  const float m=max2f(a,b);
  auto rr=__builtin_amdgcn_permlane32_swap(__float_as_uint(m),__float_as_uint(m),false,false);
  return max2f(__uint_as_float(rr[0]),__uint_as_float(rr[1]));
}
__device__ __forceinline__ void pv(f32x16*o,int vb,bf16x8 pa0,bf16x8 pa1,bf16x8 pa2,bf16x8 pa3){
  #pragma unroll
  for(int d0=0;d0<2;++d0){s16x4 lo[4],hi[4];
    #pragma unroll
    for(int ks=0;ks<4;++ks){
      asm volatile("ds_read_b64_tr_b16 %0,%1 offset:%c2":"=&v"(lo[ks]):"v"(vb),"i"(d0*4096+ks*1024):"memory");
      asm volatile("ds_read_b64_tr_b16 %0,%1 offset:%c2":"=&v"(hi[ks]):"v"(vb),"i"(d0*4096+ks*1024+512):"memory");}
    asm volatile("s_waitcnt lgkmcnt(0)":::"memory");SBAR();
    #define PK(k) (bf16x8){lo[k][0],lo[k][1],lo[k][2],lo[k][3],hi[k][0],hi[k][1],hi[k][2],hi[k][3]}
    o[d0]=__builtin_amdgcn_mfma_f32_32x32x16_bf16(pa0,PK(0),o[d0],0,0,0);
    o[d0]=__builtin_amdgcn_mfma_f32_32x32x16_bf16(pa1,PK(1),o[d0],0,0,0);
    o[d0]=__builtin_amdgcn_mfma_f32_32x32x16_bf16(pa2,PK(2),o[d0],0,0,0);
    o[d0]=__builtin_amdgcn_mfma_f32_32x32x16_bf16(pa3,PK(3),o[d0],0,0,0);
    #undef PK
  }
}

#ifndef ATTN_STORE16
#define ATTN_STORE16(p,v) (*(u32x4*)(p)=(v))
#endif
template<int THRL> __device__ __forceinline__ void attn_unit(int b,int h,int qb,const bf16*Q,const bf16*__restrict__ K,const bf16*__restrict__ V,bf16*O,const float*KM,const float*TB,char*shm){
  int tid_=threadIdx.x; asm volatile("":"+v"(tid_));
  const int tid=tid_,lane=tid&63,r32=lane&31,hi=lane>>5; const int wid=__builtin_amdgcn_readfirstlane(tid>>6);
  const long rowbase=(long)b*SEQ; const int q0=qb*QB;
  const bf16*Qw=Q+(rowbase+q0+wid*QBLK)*DM+h*D;
  const bf16*Kh=K+rowbase*DM+h*D,*Vh=V+rowbase*DM+h*D;
  const unsigned lds0=(unsigned)(uintptr_t)shm;
  float*wsf=(float*)(shm+LDS_WS)+wid*64;
  const bf16*ksrc=Kh+(long)lane*DM+wid*8;
  const bf16*vsrc=Vh+(long)(16*(wid&3)+(lane>>2))*DM+(wid>>2)*32+(lane&3)*8;
  const unsigned kdst=lds0+LDS_K+wid*1024, vdst=lds0+LDS_V+wid*1024;
  #define DMA_K(t,slot) glds16(ksrc+(long)(t)*KVBLK*DM,(unsigned)__builtin_amdgcn_readfirstlane(kdst+(slot)))
  #define DMA_V(t,slot) glds16(vsrc+(long)(t)*KVBLK*DM,(unsigned)__builtin_amdgcn_readfirstlane(vdst+(slot)))
  const int vb0=(int)(lds0+LDS_V)+((lane>>4)&1)*32+(lane&3)*8+(4*hi+((lane&15)>>2))*64;
  const char*Kbase=shm+LDS_K; bf16x8 kf[8];
  const lds_cptr shm3=(lds_cptr)shm; const lds_cptr kp0=shm3+LDS_K+hi*1024+r32*16; const lds_cptr vp0=shm3+LDS_V+((lane>>4)&1)*32+(lane&3)*8+(4*hi+((lane&15)>>2))*64;
  const int NT=(q0+QB)/KVBLK;
  DMA_K(0,0);DMA_V(0,0);DMA_K(1,SLOTB);
  bf16x8 qr[4];
  #pragma unroll
  for(int d0=0;d0<4;++d0)qr[d0]=*reinterpret_cast<const bf16x8*>(&Qw[(long)r32*DM+d0*16+hi*8]);
  { typedef float f32x2_ __attribute__((ext_vector_type(2))); int tid2=tid; asm volatile("":"+v"(tid2));
    *(__attribute__((address_space(3))) f32x2_*)((__attribute__((address_space(3))) char*)shm3+LDS_KM+tid2*8)=*(const f32x2_*)(KM+tid2*2);
    for(int i_=tid2;i_<640;i_+=512){ const int d_=i_-255; *(__attribute__((address_space(3))) float*)((__attribute__((address_space(3))) char*)shm3+LDS_BIAS+i_*4)=(d_>=0&&d_<128)?TB[d_]-TB[511]:0.f; } }
  const lds_cfptr Tb=(lds_cfptr)(shm3+LDS_BIAS);
  float mhat=0.f,l_reg=0.f;f32x16 o[2];o[0]=f32x16{};o[1]=f32x16{};f32x16 negm=f32x16{};asm volatile("":"+v"(negm));
  unsigned selm=1u<<qb;
  #define NEGM_SET(tn) do{ const float cv_=((selm>>((tn)>>2))&1u)?-mhat:-INFINITY; _Pragma("unroll") for(int r=0;r<16;++r)negm[r]=cv_; asm volatile("":"+v"(negm)); }while(0)
  const int qrel=wid*QBLK+r32;
  #define CMASK(P0,P1,t) do{int jb_=(t)-(NT-4); if(jb_>=-2){int q2_=qrel,h2_=hi; asm volatile("":"+v"(q2_),"+v"(h2_)); abias(P0,P1,jb_,q2_,h2_,wid,Tb);} if(jb_>=0)cmask(P0,P1,jb_,qrel,hi);}while(0)
  bool resc=false;
  #define START(P0,P1) do{ const float rm=rowmax(P0,P1); resc=false; \
    { const float dl=(rm>-1e30f)?rm:0.f; mhat=fadd_s(mhat,dl); \
      _Pragma("unroll") for(int r=0;r<16;++r){P0[r]=fsub_s(P0[r],dl);P1[r]=fsub_s(P1[r],dl);} \
      NEGM_SET(1); } \
    _Pragma("unroll") for(int r=0;r<16;++r)P0[r]=__builtin_amdgcn_exp2f(P0[r]); }while(0)
  #define RESC() do{ if(resc){ asm volatile("s_waitcnt lgkmcnt(0)":::"memory"); \
      _Pragma("unroll") for(int d_=0;d_<2;++d_) _Pragma("unroll") for(int r=0;r<16;++r)o[d_][r]*=wsf[crow(r,hi)]; } }while(0)
  f32x16 pA0,pA1,pB0,pB1;
  int sl_prev=0,sl_cur=0,sl_next=SLOTB;
  #define ROT() do{sl_prev=sl_cur;sl_cur=sl_next;sl_next=(sl_next==(NSLOT-1)*SLOTB)?0:sl_next+SLOTB;}while(0)
  DMA_K(2,2*SLOTB);
  WAIT_BAR(3);
  { float qf[32]; int hi2=hi; asm volatile("":"+v"(hi2));
    #pragma unroll
    for(int d0=0;d0<4;++d0)
      #pragma unroll
      for(int j=0;j<8;++j)qf[d0*8+j]=__uint_as_float(((unsigned)(unsigned short)qr[d0][j])<<16);
    float v1=-INFINITY,v2=-INFINITY,v3=-INFINITY; int i1=-1,i2=-1,i3=-1;
    const __attribute__((address_space(3))) float* kml=(const __attribute__((address_space(3))) float*)(shm3+LDS_KM)+8*hi2;
    for(int n=0;n<qb;++n){ float a=0.f;
      #pragma unroll
      for(int d0=0;d0<4;++d0){ const f32x4_ k0=*(const __attribute__((address_space(3))) f32x4_*)(kml+n*64+16*d0), k1=*(const __attribute__((address_space(3))) f32x4_*)(kml+n*64+16*d0+4);
        a+=qf[d0*8+0]*k0[0]+qf[d0*8+1]*k0[1]+qf[d0*8+2]*k0[2]+qf[d0*8+3]*k0[3]+qf[d0*8+4]*k1[0]+qf[d0*8+5]*k1[1]+qf[d0*8+6]*k1[2]+qf[d0*8+7]*k1[3]; }
      { auto rr=__builtin_amdgcn_permlane32_swap(__float_as_uint(a),__float_as_uint(a),false,false); a=__uint_as_float(rr[0])+__uint_as_float(rr[1]); }
      if(a>v1){v3=v2;i3=i2;v2=v1;i2=i1;v1=a;i1=n;} else if(a>v2){v3=v2;i3=i2;v2=a;i2=n;} else if(a>v3){v3=a;i3=n;} }
    if(i1>=0)selm|=1u<<i1; if(i2>=0)selm|=1u<<i2; if(i3>=0)selm|=1u<<i3; }
  NEGM_SET(0);
  qkt(pA0,pA1,Kbase,qr,negm,r32,hi);asm volatile("s_nop 15\n\ts_nop 7":"+v"(pA0),"+v"(pA1));CMASK(pA0,pA1,0);
  START(pA0,pA1);
  _Pragma("unroll") for(int r=0;r<16;++r)pA1[r]=__builtin_amdgcn_exp2f(pA1[r]);
  WAIT_BAR(0);
  DMA_K(3,0);DMA_V(1,SLOTB);
  ROT();
  kload8(kf,kp0+sl_cur);
  WAIT_BAR(2);
  s16x4 vlo[8],vhi[8]; u32x4 pw0,pw1,pw2,pw3;
  #define PKW(P,B) cvtpk_s(P[B],P[B+1])
  #define PAF(k) __builtin_bit_cast(bf16x8,pw##k)
  #define VFR(i) (bf16x8){vlo[i][0],vlo[i][1],vlo[i][2],vlo[i][3],vhi[i][0],vhi[i][1],vhi[i][2],vhi[i][3]}
  #define PIN(x) asm volatile("":"+v"(x))
  #define MX3(a,b,c) __builtin_fmaxf(__builtin_fmaxf((a),(b)),(c))
  #define GAPA(MF,A0,A1,A2,A3,W0,W1,PW) do{ MF; sacc+=A0; sacc+=A1; sacc+=A2; sacc+=A3; PIN(sacc); W0; W1; PIN(PW); SBAR(); }while(0)
  #define EX(v) __builtin_amdgcn_exp2f(v)
  #define GAPB(MF,X,B) do{ MF; X[B]=EX(X[B]); X[B+1]=EX(X[B+1]); X[B+2]=EX(X[B+2]); X[B+3]=EX(X[B+3]); PIN(X); SBAR(); }while(0)
  #define VRD(i) do{ vlo[i]=vtr(vp_+(((i)>>2)*4096+((i)&3)*1024)); vhi[i]=vtr(vp_+(((i)>>2)*4096+((i)&3)*1024+512)); }while(0)
  #define KRD(G,j) do{ if(G){ kload2(kf,kp0+sl_next,j); SBAR(); } }while(0)
  #define STEP(C0,C1,P0,P1,t,GK,GV,GL) do{ SBAR(); \
    const lds_cptr vp_=vp0+sl_prev; \
    VRD(0); SBAR(); float sacc=(P0[0]+P0[1]); \
    GAPA(C0=__builtin_amdgcn_mfma_f32_32x32x16_bf16(kf[0],qr[0],negm,0,0,0), P0[2],P0[3],P0[4],P0[5],     pw0[0]=PKW(P0,0), pw0[1]=PKW(P0,2), pw0); \
    VRD(4); SBAR(); GAPA(C1=__builtin_amdgcn_mfma_f32_32x32x16_bf16(kf[1],qr[0],negm,0,0,0), P0[6],P0[7],P0[8],P0[9],     pw0[2]=PKW(P0,4), pw0[3]=PKW(P0,6), pw0); \
    VRD(1); SBAR(); GAPA(C0=__builtin_amdgcn_mfma_f32_32x32x16_bf16(kf[2],qr[1],C0,0,0,0),   P0[10],P0[11],P0[12],P0[13], pw1[0]=PKW(P0,8), pw1[1]=PKW(P0,10), pw1); \
    VRD(5); SBAR(); GAPA(C1=__builtin_amdgcn_mfma_f32_32x32x16_bf16(kf[3],qr[1],C1,0,0,0),   P0[14],P0[15],P1[0],P1[1],   pw1[2]=PKW(P0,12),pw1[3]=PKW(P0,14), pw1); \
    VRD(2); SBAR(); GAPA(C0=__builtin_amdgcn_mfma_f32_32x32x16_bf16(kf[4],qr[2],C0,0,0,0),   P1[2],P1[3],P1[4],P1[5],     pw2[0]=PKW(P1,0), pw2[1]=PKW(P1,2), pw2); \
    VRD(6); SBAR(); GAPA(C1=__builtin_amdgcn_mfma_f32_32x32x16_bf16(kf[5],qr[2],C1,0,0,0),   P1[6],P1[7],P1[8],P1[9],     pw2[2]=PKW(P1,4), pw2[3]=PKW(P1,6), pw2); \
    VRD(3); SBAR(); GAPA(C0=__builtin_amdgcn_mfma_f32_32x32x16_bf16(kf[6],qr[3],C0,0,0,0),   P1[10],P1[11],P1[12],P1[13], pw3[0]=PKW(P1,8), pw3[1]=PKW(P1,10), pw3); \
    VRD(7); SBAR(); GAPA(C1=__builtin_amdgcn_mfma_f32_32x32x16_bf16(kf[7],qr[3],C1,0,0,0),   P1[14],P1[15],0.f,0.f,       pw3[2]=PKW(P1,12),pw3[3]=PKW(P1,14), pw3); \
    l_reg+=sacc; \
    if(GK){DMA_K((t)+3,sl_cur);} if(GV){DMA_V((t)+1,sl_next);} \
    CMASK(C0,C1,t); \
    { float a=MX3(C0[0],C0[1],C1[0]),b=MX3(C0[2],C0[3],C1[1]); a=MX3(a,C1[2],C1[3]); \
      _Pragma("unroll") for(int r=4;r<16;r+=4){a=MX3(a,C0[r],C0[r+1]);b=MX3(b,C0[r+2],C0[r+3]);a=MX3(a,C1[r],C1[r+1]);b=MX3(b,C1[r+2],C1[r+3]);} \
      float rm=__builtin_fmaxf(a,b); { auto rr=__builtin_amdgcn_permlane32_swap(__float_as_uint(rm),__float_as_uint(rm),false,false); rm=__builtin_fmaxf(__uint_as_float(rr[0]),__uint_as_float(rr[1])); } \
      resc=false; \
      if(__builtin_expect(__any(rm>(float)THRL),0)){ const float dl=__builtin_fmaxf(rm,0.f); mhat+=dl; \
        _Pragma("unroll") for(int r=0;r<16;++r){C0[r]-=dl;C1[r]-=dl;} \
        const float f=__builtin_amdgcn_exp2f(-dl); l_reg*=f; if(hi==0)wsf[r32]=f; resc=true; } \
      if(resc||((((t)+1)&3)==0)){ NEGM_SET((t)+1); } } \
    SBAR(); \
    GAPB(o[0]=__builtin_amdgcn_mfma_f32_32x32x16_bf16(PAF(0),VFR(0),o[0],0,0,0), C0,0); \
    GAPB(o[1]=__builtin_amdgcn_mfma_f32_32x32x16_bf16(PAF(0),VFR(4),o[1],0,0,0), C0,4); \
    KRD(GL,0); GAPB(o[0]=__builtin_amdgcn_mfma_f32_32x32x16_bf16(PAF(1),VFR(1),o[0],0,0,0), C0,8); \
    KRD(GL,1); GAPB(o[1]=__builtin_amdgcn_mfma_f32_32x32x16_bf16(PAF(1),VFR(5),o[1],0,0,0), C0,12); \
    KRD(GL,2); GAPB(o[0]=__builtin_amdgcn_mfma_f32_32x32x16_bf16(PAF(2),VFR(2),o[0],0,0,0), C1,0); \
    KRD(GL,3); GAPB(o[1]=__builtin_amdgcn_mfma_f32_32x32x16_bf16(PAF(2),VFR(6),o[1],0,0,0), C1,4); \
    GAPB(o[0]=__builtin_amdgcn_mfma_f32_32x32x16_bf16(PAF(3),VFR(3),o[0],0,0,0), C1,8); \
    GAPB(o[1]=__builtin_amdgcn_mfma_f32_32x32x16_bf16(PAF(3),VFR(7),o[1],0,0,0), C1,12); \
    }while(0)
  int t=1;
  #undef CMASK
  #define CMASK(P0,P1,t) do{}while(0)
  for(;t+7<NT;t+=2){
    STEP(pB0,pB1,pA0,pA1,t,true,true,true);     WAIT_BAR(2); RESC(); ROT();
    STEP(pA0,pA1,pB0,pB1,t+1,true,true,true);   WAIT_BAR(2); RESC(); ROT();
  }
  #undef CMASK
  #define CMASK(P0,P1,t) do{int jb_=(t)-(NT-4); if(jb_>=-2){int q2_=qrel,h2_=hi; asm volatile("":"+v"(q2_),"+v"(h2_)); abias(P0,P1,jb_,q2_,h2_,wid,Tb);} if(jb_>=0)cmask(P0,P1,jb_,qrel,hi);}while(0)
  #define ENDW(tt) do{ if((tt)+3<NT){WAIT_BAR(2);} else if((tt)+2<NT){WAIT_BAR(1);} else {WAIT_BAR(0);} }while(0)
  for(;t+1<NT;t+=2){
    STEP(pB0,pB1,pA0,pA1,t,(t+3<NT),(t+1<NT),(t+1<NT));       ENDW(t);   RESC(); ROT();
    STEP(pA0,pA1,pB0,pB1,t+1,(t+4<NT),(t+2<NT),(t+2<NT));     ENDW(t+1); RESC(); ROT();
  }
  STEP(pB0,pB1,pA0,pA1,NT-1,false,false,false); RESC();
  { float sacc=pB0[0]+pB0[1]; _Pragma("unroll") for(int r=2;r<16;++r)sacc+=pB0[r]; _Pragma("unroll") for(int r=0;r<16;++r)sacc+=pB1[r]; l_reg+=sacc;
    pw0=(u32x4){PKW(pB0,0),PKW(pB0,2),PKW(pB0,4),PKW(pB0,6)};pw1=(u32x4){PKW(pB0,8),PKW(pB0,10),PKW(pB0,12),PKW(pB0,14)};pw2=(u32x4){PKW(pB1,0),PKW(pB1,2),PKW(pB1,4),PKW(pB1,6)};pw3=(u32x4){PKW(pB1,8),PKW(pB1,10),PKW(pB1,12),PKW(pB1,14)};
    SBAR(); pv(o,vb0+sl_cur,PAF(0),PAF(1),PAF(2),PAF(3)); }
  #undef PKW
  #undef PAF
  #undef VFR
  #undef PIN
  #undef MX3
  #undef GAPA
  #undef GAPB
  #undef EX
  #undef VRD
  #undef KRD
  #undef STEP
  #undef ENDW
  {auto rr=__builtin_amdgcn_permlane32_swap(__float_as_uint(l_reg),__float_as_uint(l_reg),false,false);l_reg=__uint_as_float(rr[0])+__uint_as_float(rr[1]);}
  if(hi==0)wsf[32+r32]=l_reg;asm volatile("s_waitcnt lgkmcnt(0)":::"memory");
  float rli[16];
  #pragma unroll
  for(int r=0;r<16;++r)rli[r]=__builtin_amdgcn_rcpf(wsf[32+crow(r,hi)]);
  bf16*Ow=O+(rowbase+q0+wid*QBLK)*DM+h*D;
  { bf16*stg=(bf16*)(shm+LDS_OST)+wid*2048;
    #pragma unroll
    for(int r=0;r<16;++r){const int orow=crow(r,hi);
      #pragma unroll
      for(int d0=0;d0<2;++d0)stg[orow*64+d0*32+r32]=__float2bfloat16(o[d0][r]*rli[r]);}
    asm volatile("s_waitcnt lgkmcnt(0)":::"memory");
    #pragma unroll
    for(int i=0;i<4;++i){const int row=i*8+(lane>>3),ch=lane&7; const u32x4 v=*(const u32x4*)(stg+row*64+ch*8); ATTN_STORE16(Ow+(long)row*DM+ch*8,v);} }
  asm volatile("s_waitcnt lgkmcnt(0)\n\ts_barrier":::"memory");
  #undef DMA_K
  #undef DMA_V
  #undef CMASK
  #undef START
  #undef RESC
  #undef ROT
  #undef NEGM_SET
}
constexpr int ATTN_LDS_BYTES=LDS_BYTES;
struct AttnTensors { const bf16* Q; const bf16* K; const bf16* V; bf16* O; const float* KM; const float* TB; };
struct AttnUnit { int bh; int qb; };
struct StaticOrder {
  int vcu,G;
  __device__ __forceinline__ explicit StaticOrder(int grid,int block):vcu((grid%8==0)?(block%8)*(grid/8)+block/8:block),G(grid){}
  __device__ __forceinline__ bool next(int i,AttnUnit&u)const{ const int p=vcu+(i>>1)*G; if(p>=BATCH*NHEAD*8)return false; const int s=p&7; u.bh=p>>3; u.qb=(i&1)?15-s:s; return true; }
  __device__ __forceinline__ void a_ready(const AttnUnit&)const{}
  __device__ __forceinline__ void done(const AttnUnit&)const{}
};
template<class Sched,int THRL=8> __device__ __forceinline__ void attn_phase(char*lds,const AttnTensors&T,const Sched&S){
  AttnUnit u;
  for(int i=0;S.next(i,u);++i){ S.a_ready(u); attn_unit<THRL>(u.bh/NHEAD,u.bh%NHEAD,u.qb,T.Q,T.K,T.V,T.O,T.KM+(size_t)u.bh*(16*64),T.TB+(u.bh%NHEAD)*512,lds); S.done(u); }
}
#undef SBAR
#undef WAIT_BAR
}
#define GAS __attribute__((address_space(1)))
#define LAS __attribute__((address_space(3)))
typedef unsigned short bf16;
typedef unsigned v4u __attribute__((ext_vector_type(4)));
typedef unsigned v2u __attribute__((ext_vector_type(2)));
typedef float f32x4 __attribute__((ext_vector_type(4)));
typedef short bf16x8 __attribute__((ext_vector_type(8)));
typedef GAS unsigned gu32;
typedef GAS unsigned long long gu64;
#define RLX_AGENT __ATOMIC_RELAXED, __HIP_MEMORY_SCOPE_AGENT
#define LDS_WAIT() asm volatile("s_waitcnt lgkmcnt(0)" ::: "memory")
#define VM_WAIT() asm volatile("s_waitcnt vmcnt(0)" ::: "memory")
__device__ __forceinline__ unsigned long long rt() { return __builtin_amdgcn_s_memrealtime(); }
__device__ __forceinline__ unsigned f2bf(float f) { unsigned u = __builtin_bit_cast(unsigned, f); return (u + 0x7fffu + ((u >> 16) & 1u)) >> 16; }
__device__ __forceinline__ unsigned pk2(float lo, float hi) { return f2bf(lo) | (f2bf(hi) << 16); }

#define XB_TMO      128
#define XB_XCNT(j)  (256  + 64 * (j))
#define XB_XSUB(j)  (1280 + 64 * (j))
#define XB_XGEN(j)  (2304 + 64 * (j))
#define XB_TOP      3328
#define XB_TOPGEN   3392
#define XCD_BAR_WORDS 3456
#define XB_SPIN_CAP (1u << 18)

__device__ __forceinline__ unsigned xb_ld(unsigned* p)              { return __hip_atomic_load(p, __ATOMIC_RELAXED, __HIP_MEMORY_SCOPE_AGENT); }
__device__ __forceinline__ unsigned xb_add(unsigned* p, unsigned v) { return __hip_atomic_fetch_add(p, v, __ATOMIC_RELAXED, __HIP_MEMORY_SCOPE_AGENT); }
__device__ __forceinline__ unsigned xb_xcc_id() { return (unsigned)__builtin_amdgcn_s_getreg((3 << 11) | 20) & 0xFu; }
#define XB_SPIN(cond, bar) do { unsigned _sp = 0; while (cond) { __builtin_amdgcn_s_sleep(1); \
    if ((++_sp & 255u) == 0u) { if (xb_ld(&(bar)[XB_TMO])) break; if (_sp > XB_SPIN_CAP) { atomicAdd(&(bar)[XB_TMO], 1u); break; } } } } while (0)

struct XcdBarrier {
    unsigned* bar; unsigned x;
    volatile LAS unsigned* st;
};

__device__ __forceinline__ XcdBarrier xcd_barrier_post(unsigned* bar, volatile LAS unsigned* st) {
    XcdBarrier b; b.bar = bar; b.x = xb_xcc_id(); b.st = st;
    if (threadIdx.x == 0) (void)xb_add(&bar[XB_XCNT(b.x)], 1u);
    return b;
}
__device__ __forceinline__ void xcd_barrier_complete(unsigned* bar, unsigned x, unsigned& nloc, unsigned& nx) {
    const unsigned G = gridDim.x * gridDim.y * gridDim.z;
    unsigned sum, cnt, mine, sp = 0u;
    for (;;) {
        sum = 0u; cnt = 0u; mine = 0u;
#pragma unroll
        for (unsigned j = 0; j < 16; ++j) { const unsigned c = xb_ld(&bar[XB_XCNT(j)]); sum += c; cnt += (c > 0u) ? 1u : 0u; mine = (j == x) ? c : mine; }
        if (sum == G) break;
        __builtin_amdgcn_s_sleep(1);
        if ((++sp & 255u) == 0u) { if (xb_ld(&bar[XB_TMO])) break; if (sp > XB_SPIN_CAP) { atomicAdd(&bar[XB_TMO], 1u); break; } }
    }
    nloc = mine > 0u ? mine : 1u; nx = cnt > 0u ? cnt : 1u;
}

__device__ __forceinline__ void xcd_barrier(const XcdBarrier& b) {
    asm volatile("s_waitcnt vmcnt(0)" ::: "memory");
    __syncthreads();
    if (threadIdx.x == 0) {
        unsigned* bar = b.bar;
        __builtin_amdgcn_s_waitcnt(0);
        unsigned nloc = b.st[0], nx = b.st[1];
        if (nloc == 0u) { xcd_barrier_complete(bar, b.x, nloc, nx); b.st[0] = nloc; b.st[1] = nx; }
        const unsigned old = xb_add(&bar[XB_XSUB(b.x)], 1u);
        const unsigned gen = old / nloc;
        if (old + 1u == (gen + 1u) * nloc) {
            __builtin_amdgcn_fence(__ATOMIC_RELEASE, "agent");
            asm volatile("s_waitcnt vmcnt(0)" ::: "memory");
            const unsigned og = xb_add(&bar[XB_TOP], 1u);
            const unsigned tg = og / nx;
            if (og + 1u == (tg + 1u) * nx) xb_add(&bar[XB_TOPGEN], 1u);
            else XB_SPIN(xb_ld(&bar[XB_TOPGEN]) == tg, bar);
            __builtin_amdgcn_fence(__ATOMIC_ACQUIRE, "agent");
            xb_add(&bar[XB_XGEN(b.x)], 1u);
            asm volatile("s_waitcnt vmcnt(0)" ::: "memory");
        } else {
            XB_SPIN(xb_ld(&bar[XB_XGEN(b.x)]) == gen, bar);
            __builtin_amdgcn_fence(__ATOMIC_ACQUIRE, "agent");
            asm volatile("s_waitcnt vmcnt(0)" ::: "memory");
        }
    }
    __syncthreads();
}

struct Frame {
    LAS unsigned char* lds;
    volatile LAS unsigned* MISC;
    gu32* ctl;
    int tid, lane, wave;
    int vcu, G;
};
__device__ __forceinline__ float wave_sum(float v) {
#pragma unroll
    for (int o = 1; o < 64; o <<= 1) v += __shfl_xor(v, o);
    return v;
}
__device__ __forceinline__ float wave_max(float v) {
#pragma unroll
    for (int o = 1; o < 64; o <<= 1) v = fmaxf(v, __shfl_xor(v, o));
    return v;
}
__device__ __forceinline__ float bf_lo(unsigned w) { return __uint_as_float(w << 16); }
__device__ __forceinline__ float bf_hi(unsigned w) { return __uint_as_float(w & 0xffff0000u); }
__device__ __forceinline__ float bf2f(bf16 h) { return __uint_as_float((unsigned)h << 16); }

__device__ __forceinline__ void p0_transpose_item(const float* W, int K, int N, bf16* WT, int row_off, LAS float* scr, int item, int lane) {
    const int nblk = N / 32, kb = item / nblk, nb = item % nblk, k0 = 64 * kb, n0 = 32 * nb;
#pragma unroll 8
    for (int i = 0; i < 32; ++i) { const int kk = 2 * i + (lane >> 5); scr[kk * 33 + (lane & 31)] = W[(size_t)(k0 + kk) * N + n0 + (lane & 31)]; }
    LDS_WAIT(); asm volatile("" ::: "memory");
    const int c = lane & 7;
#pragma unroll
    for (int j = 0; j < 4; ++j) { const int n = (lane >> 3) + 8 * j; const LAS float* s = scr + (8 * c) * 33 + n;
        v4u o; o.x = pk2(s[0 * 33], s[1 * 33]); o.y = pk2(s[2 * 33], s[3 * 33]); o.z = pk2(s[4 * 33], s[5 * 33]); o.w = pk2(s[6 * 33], s[7 * 33]);
        *(GAS v4u*)(WT + (size_t)(row_off + n0 + n) * K + k0 + 8 * c) = o; }
    LDS_WAIT(); asm volatile("" ::: "memory");
}
__device__ __forceinline__ unsigned pk4_fp8(float a, float b, float c, float d) { unsigned w = 0u; w = __builtin_amdgcn_cvt_pk_fp8_f32(a, b, w, false); w = __builtin_amdgcn_cvt_pk_fp8_f32(c, d, w, true); return w; }
__device__ __forceinline__ void p0_transpose_item_f8(const float* W, int K, int N, unsigned char* WT, float scale, LAS unsigned char* scr, int item, int lane) {
    const int nblk = N / 32, kb = item / nblk, nb = item % nblk, k0 = 128 * kb, n0 = 32 * nb;
#pragma unroll 8
    for (int i = 0; i < 64; ++i) { const int kk = 2 * i + (lane >> 5); const float v = W[(size_t)(k0 + kk) * N + n0 + (lane & 31)] * scale;
        scr[(lane & 31) * 144 + kk] = (unsigned char)(__builtin_amdgcn_cvt_pk_fp8_f32(v, 0.f, 0u, false) & 0xffu); }
    LDS_WAIT(); asm volatile("" ::: "memory");
    const int c = lane & 7;
#pragma unroll
    for (int j = 0; j < 4; ++j) { const int n = (lane >> 3) + 8 * j; const v4u o = *(const LAS v4u*)(scr + n * 144 + 16 * c);
        *(GAS v4u*)(WT + (size_t)(n0 + n) * K + k0 + 16 * c) = o; }
    LDS_WAIT(); asm volatile("" ::: "memory");
}
__device__ __forceinline__ void rms_row_to_bf16(int lane, const float* xrow, const float* g, bf16* orow) {
    const GAS f32x4* xr = (const GAS f32x4*)xrow + lane; const GAS f32x4* gr = (const GAS f32x4*)g + lane;
    f32x4 v[8]; float s = 0.f;
#pragma unroll
    for (int j = 0; j < 8; ++j) { v[j] = xr[64 * j]; s += (v[j].x * v[j].x + v[j].y * v[j].y) + (v[j].z * v[j].z + v[j].w * v[j].w); }
    const float rstd = 1.0f / sqrtf(wave_sum(s) * (1.f / DM) + RMS_EPS);
    GAS unsigned long long* o8 = (GAS unsigned long long*)orow + lane;
#pragma unroll
    for (int j = 0; j < 8; ++j) { const f32x4 gg = gr[64 * j]; const f32x4 o = v[j] * rstd * gg;
        o8[64 * j] = (unsigned long long)pk2(o.x, o.y) | ((unsigned long long)pk2(o.z, o.w) << 32); }
}
__device__ __forceinline__ void rms_row1024_bf16(int lane, const bf16* irow, const float* g, bf16* orow) {
    float v[16]; float s = 0.f;
#pragma unroll
    for (int j = 0; j < 2; ++j) { const v4u w = *((const GAS v4u*)irow + lane + 64 * j);
        v[8 * j + 0] = bf_lo(w.x); v[8 * j + 1] = bf_hi(w.x); v[8 * j + 2] = bf_lo(w.y); v[8 * j + 3] = bf_hi(w.y);
        v[8 * j + 4] = bf_lo(w.z); v[8 * j + 5] = bf_hi(w.z); v[8 * j + 6] = bf_lo(w.w); v[8 * j + 7] = bf_hi(w.w); }
#pragma unroll
    for (int k = 0; k < 16; ++k) s += v[k] * v[k];
    const float rstd = 1.0f / sqrtf(wave_sum(s) * (1.f / 1024.f) + RMS_EPS);
#pragma unroll
    for (int j = 0; j < 2; ++j) { const f32x4 g0 = *((const GAS f32x4*)g + 2 * (lane + 64 * j)), g1 = *((const GAS f32x4*)g + 2 * (lane + 64 * j) + 1);
        v4u o; o.x = pk2(v[8 * j + 0] * rstd * g0.x, v[8 * j + 1] * rstd * g0.y); o.y = pk2(v[8 * j + 2] * rstd * g0.z, v[8 * j + 3] * rstd * g0.w);
        o.z = pk2(v[8 * j + 4] * rstd * g1.x, v[8 * j + 5] * rstd * g1.y); o.w = pk2(v[8 * j + 6] * rstd * g1.z, v[8 * j + 7] * rstd * g1.w);
        *((GAS v4u*)orow + lane + 64 * j) = o; }
}
__device__ __forceinline__ int t5_bucket(int dist) {
    if (dist < 16) return dist;
    const float lr = logf((float)dist / 16.0f) / logf(8.0f) * 16.0f;
    int b = 16 + (int)lr; return b < 31 ? b : 31;
}
__device__ __forceinline__ float gelu_tanh(float y) {
    const float u = 0.7978845608028654f * (y + 0.044715f * y * y * y);
    const float e = __builtin_amdgcn_exp2f(2.0f * LOG2E * u);
    const float th = 1.0f - 2.0f * __builtin_amdgcn_rcpf(e + 1.0f);
    return 0.5f * y * (1.0f + th);
}

struct Args { const float* in[23]; float* out; unsigned char* ws; int ph_lo, ph_hi, li, pad; };
__global__ void __launch_bounds__(NWAVES * 64, 2) skel_fwd(Args args) {
    extern __shared__ __attribute__((aligned(16))) unsigned char lds[];
    Frame F;
    F.lds = (LAS unsigned char*)lds;
    F.MISC = (volatile LAS unsigned*)(F.lds + MISC_OFF);
    F.tid = threadIdx.x; F.lane = F.tid & 63; F.wave = __builtin_amdgcn_readfirstlane(F.tid >> 6);
    F.G = gridDim.x; { const int bx = blockIdx.x; F.vcu = (F.G % 8 == 0) ? (bx % 8) * (F.G / 8) + bx / 8 : bx; }
    unsigned char* ws = args.ws;
    F.ctl = (gu32*)(ws + WS_CTL);
    const float* x = args.in[0]; const float* norm_mix = args.in[1]; const float* w_in = args.in[2]; const float* rel_bias = args.in[3];
    const float* lam_re = args.in[4]; const float* lam_im = args.in[5]; const float* log_dt = args.in[6];
    const float* b_re = args.in[7]; const float* b_im = args.in[8]; const float* c_re = args.in[9]; const float* c_im = args.in[10]; const float* d_skip = args.in[11];
    const float* w_glu = args.in[12]; const float* b_glu = args.in[13]; const float* norm_attn = args.in[14]; const float* norm_ssm = args.in[15];
    const float* w_out = args.in[16]; const float* norm_ffn = args.in[17]; const float* w_up = args.in[18]; const float* conv_w = args.in[19]; const float* conv_b = args.in[20];
    const float* w_down = args.in[21]; const float* norm_final = args.in[22];
    float* out = args.out;
    bf16* Wt_in = (bf16*)(ws + WS_WIN); bf16* Wt_glu = (bf16*)(ws + WS_WGLU); bf16* Wt_out = (bf16*)(ws + WS_WOUT); unsigned char* Wt_up = (unsigned char*)(ws + WS_WUP); unsigned char* Wt_down = (unsigned char*)(ws + WS_WDOWN);
    bf16* XN = (bf16*)(ws + WS_XN); bf16* QB = (bf16*)(ws + WS_Q); bf16* KB = (bf16*)(ws + WS_K); bf16* VB = (bf16*)(ws + WS_V); bf16* UB = (bf16*)(ws + WS_U);
    bf16* YB = (bf16*)(ws + WS_Y); bf16* ZB = (bf16*)(ws + WS_Z); bf16* UPB = (bf16*)(ws + WS_UP); unsigned char* X1G = (unsigned char*)(ws + WS_X1G); unsigned char* ACT = (unsigned char*)(ws + WS_ACT);
    float* SSQ = (float*)(ws + WS_SSQ); float* KMEAN = (float*)(ws + WS_KMEAN); float* T5B = (float*)(ws + WS_T5B);
    bf16* A2 = (bf16*)(ws + WS_A2); float* SBUF = (float*)(ws + WS_S); bf16* BTS = (bf16*)(ws + WS_BTS); bf16* BT2 = (bf16*)(ws + WS_BT2);

    for (int u = F.tid; u < (LDS_BYTES - LDSCTL_OFF) / 4; u += NWAVES * 64) ((LAS unsigned*)(F.lds + LDSCTL_OFF))[u] = 0u;
    __syncthreads();
    XcdBarrier bar; bar.bar = (unsigned*)(F.ctl + CW_BAR); bar.x = 0; bar.st = nullptr;
    if (N_LAUNCHES == 1) bar = xcd_barrier_post((unsigned*)(F.ctl + CW_BAR), F.MISC + 8);
#define GRID_BAR() do { if (N_LAUNCHES == 1) xcd_barrier(bar); } while (0)
    const int lo = args.ph_lo, hi = args.ph_hi;
#define IN(k) (lo <= (k) && (k) < hi)
#define BOTH(k) (IN(k) && IN((k) + 1))
    const int gw = F.vcu * NWAVES + F.wave, NGW = F.G * NWAVES;
    const int gt = gw * 64 + F.lane, NGT = NGW * 64;

    if (IN(0)) {
        {
            LAS float* L = (LAS float*)(F.lds + RING_OFF);
            LAS float* pwr = L; LAS float* pwi = pwr + 33 * 65; LAS float* bbr = pwi + 33 * 65; LAS float* bbi = bbr + 1024;
            LAS float* ccr = bbi + 1024; LAS float* cci = ccr + 16 * 65; LAS float* dsk = cci + 16 * 65; LAS float* Kd = dsk + 16;
            for (int it = blockIdx.x; it < SG * 4; it += F.G) {
                const int g = it >> 2, q = it & 3;
                __syncthreads();
                const float dt = expf(log_dt[g]);
                for (int i = F.tid; i < 33 * 64; i += NWAVES * 64) { const int d = i >> 6, p = i & 63; const float lr = lam_re[g * SP + p], li = lam_im[g * SP + p];
                    const float mag = expf(lr * dt * (float)d), ang = li * dt * (float)d; pwr[d * 65 + p] = mag * cosf(ang); pwi[d * 65 + p] = mag * sinf(ang); }
                for (int i = F.tid; i < 64 * 16; i += NWAVES * 64) { const int p = i >> 4; const float lr = lam_re[g * SP + p], li = lam_im[g * SP + p];
                    const float er = expf(lr * dt), lbr = er * cosf(li * dt), lbi = er * sinf(li * dt);
                    const float nr = lbr - 1.0f, ni = lbi, den = lr * lr + li * li, cr_ = (nr * lr + ni * li) / den, ci_ = (ni * lr - nr * li) / den;
                    const float bre = b_re[(size_t)(g * SP) * SC + i], bim = b_im[(size_t)(g * SP) * SC + i];
                    bbr[i] = cr_ * bre - ci_ * bim; bbi[i] = cr_ * bim + ci_ * bre; }
                for (int i = F.tid; i < 16 * 64; i += NWAVES * 64) { const int h = i >> 6, p = i & 63; ccr[h * 65 + p] = c_re[(size_t)(g * SC) * SP + i]; cci[h * 65 + p] = c_im[(size_t)(g * SC) * SP + i]; }
                if (F.tid < 16) dsk[F.tid] = d_skip[g * SC + F.tid];
                __syncthreads();
                {
                    const int d = F.tid >> 4, h = F.tid & 15; float a16[16];
#pragma unroll
                    for (int e = 0; e < 16; ++e) a16[e] = 0.f;
                    for (int p = 0; p < 64; ++p) { const float cr = ccr[h * 65 + p], ci = cci[h * 65 + p], pr = pwr[d * 65 + p], pi = pwi[d * 65 + p];
                        const float ar = cr * pr - ci * pi, ai_ = cr * pi + ci * pr;
#pragma unroll
                        for (int e = 0; e < 16; ++e) a16[e] += ar * bbr[p * 16 + e] - ai_ * bbi[p * 16 + e]; }
                    const float dd = dsk[h];
#pragma unroll
                    for (int e = 0; e < 16; ++e) Kd[(d * 16 + h) * 16 + e] = a16[e] + ((d == 0 && e == h) ? dd : 0.f);
                }
                __syncthreads();
                for (int i = F.tid; i < 128 * 80; i += NWAVES * 64) {
                    const int rl = i / 80, k8 = i - rl * 80, n = q * 128 + rl, t = n >> 4, h = n & 15; float v[8];
                    if (k8 < 64) { const int s = k8 >> 1, h0 = (k8 & 1) * 8;
                        if (s <= t) { const LAS float* kp = Kd + ((t - s) * 16 + h) * 16 + h0;
#pragma unroll
                            for (int e = 0; e < 8; ++e) v[e] = kp[e]; }
                        else {
#pragma unroll
                            for (int e = 0; e < 8; ++e) v[e] = 0.f; } }
                    else { const int j0 = (k8 - 64) * 8, p0 = j0 & 63; const bool im = j0 >= 64;
#pragma unroll
                        for (int e = 0; e < 8; ++e) { const int p = p0 + e; const float cr = ccr[h * 65 + p], ci = cci[h * 65 + p], pr = pwr[(t + 1) * 65 + p], pi = pwi[(t + 1) * 65 + p];
                            v[e] = im ? -(cr * pi + ci * pr) : (cr * pr - ci * pi); } }
                    v4u o; o.x = pk2(v[0], v[1]); o.y = pk2(v[2], v[3]); o.z = pk2(v[4], v[5]); o.w = pk2(v[6], v[7]);
                    *(GAS v4u*)(BT2 + ((size_t)(g * 512 + n)) * 640 + k8 * 8) = o;
                }
                for (int i = F.tid; i < 64 * 64; i += NWAVES * 64) {
                    const int rl = i >> 6, k8 = i & 63, j = q * 64 + rl; float v[8];
                    if (j < 128) { const int p = j & 63, s = k8 >> 1, h0 = (k8 & 1) * 8; const bool im = j >= 64; const float pr = pwr[(31 - s) * 65 + p], pi = pwi[(31 - s) * 65 + p];
#pragma unroll
                        for (int e = 0; e < 8; ++e) { const float br = bbr[p * 16 + h0 + e], bi = bbi[p * 16 + h0 + e]; v[e] = im ? (pr * bi + pi * br) : (pr * br - pi * bi); } }
                    else {
#pragma unroll
                        for (int e = 0; e < 8; ++e) v[e] = 0.f; }
                    v4u o; o.x = pk2(v[0], v[1]); o.y = pk2(v[2], v[3]); o.z = pk2(v[4], v[5]); o.w = pk2(v[6], v[7]);
                    *(GAS v4u*)(BTS + ((size_t)(g * 256 + j)) * 512 + k8 * 8) = o;
                }
            }
            __syncthreads();
        }
        LAS float* scr = (LAS float*)(F.lds + RING_OFF + F.wave * 16384);
        constexpr int I_IN = (DM / 64) * (INC / 32), I_GLU = (SW / 64) * (SW / 32), I_OUT = (DM / 64) * (DM / 32), I_UP = (DM / (F8_UP ? 128 : 64)) * (DFF2 / 32), I_DN = (DFF / (F8_DN ? 128 : 64)) * (DM / 32);
        constexpr int NITEMS = I_IN + I_GLU + I_OUT + I_UP + I_DN;
        for (int it = gw; it < NITEMS; it += NGW) {
            int r = it;
            if (r < I_IN) { p0_transpose_item(w_in, DM, INC, Wt_in, 0, scr, r, F.lane); continue; } r -= I_IN;
            if (r < I_GLU) { p0_transpose_item(w_glu, SW, SW, Wt_glu, 0, scr, r, F.lane); continue; } r -= I_GLU;
            if (r < I_OUT) { p0_transpose_item(w_out, DM, DM, Wt_out, 0, scr, r, F.lane); continue; } r -= I_OUT;
            if (r < I_UP) { if (F8_UP) p0_transpose_item_f8(w_up, DM, DFF2, Wt_up, WSCALE, (LAS unsigned char*)scr, r, F.lane); else p0_transpose_item(w_up, DM, DFF2, (bf16*)Wt_up, 0, scr, r, F.lane); continue; } r -= I_UP;
            if (F8_DN) p0_transpose_item_f8(w_down, DFF, DM, Wt_down, WSCALE, (LAS unsigned char*)scr, r, F.lane); else p0_transpose_item(w_down, DFF, DM, (bf16*)Wt_down, 0, scr, r, F.lane);
        }
        for (int m = gw; m < M; m += NGW) rms_row_to_bf16(F.lane, x + (size_t)m * DM, norm_mix, XN + (size_t)m * DM);
        for (int i = gt; i < AH * 512; i += NGT) { const int h = i >> 9, d = i & 511; T5B[i] = LOG2E * rel_bias[t5_bucket(d) * AH + h]; }
        if (BOTH(0)) GRID_BAR();
    }

    if (IN(1)) {
        pg8::Gemm g{XN, Wt_in, M, INC, DM}; pg8::StaticOrder S; S.init(M, INC, F.G, (int)blockIdx.x);
        pg8::EpiQKVU E{QB, (size_t)(WS_K - WS_Q) / 2, A2, C2};
        pg8::gemm_phase<pg8::EpiQKVU, pg8::StaticOrder, PG8_ALIGN, PG8_SP2>(F.lds + RING_OFF, g, S, E);
        if (BOTH(1)) GRID_BAR();
    }

    if (IN(2)) {
        for (int it = gw; it < BATCH * AH * NBLK; it += NGW) {
            const int n = it % NBLK, h = (it / NBLK) % AH, b = it / (NBLK * AH);
            const bf16* kp = KB + ((size_t)(b * SEQ + n * MOBA_BLK + (F.lane >> 3))) * AW + h * HD + (F.lane & 7) * 8;
            float a[8];
#pragma unroll
            for (int k = 0; k < 8; ++k) a[k] = 0.f;
            for (int i = 0; i < 32; ++i) { const v4u w = *(const GAS v4u*)(kp + (size_t)i * 8 * AW);
                a[0] += bf_lo(w.x); a[1] += bf_hi(w.x); a[2] += bf_lo(w.y); a[3] += bf_hi(w.y); a[4] += bf_lo(w.z); a[5] += bf_hi(w.z); a[6] += bf_lo(w.w); a[7] += bf_hi(w.w); }
#pragma unroll
            for (int k = 0; k < 8; ++k) { a[k] += __shfl_xor(a[k], 8); a[k] += __shfl_xor(a[k], 16); a[k] += __shfl_xor(a[k], 32); }
            if (F.lane < 8) { float* o = KMEAN + (size_t)it * HD + F.lane * 8;
#pragma unroll
                for (int k = 0; k < 8; ++k) o[k] = a[k] * (1.0f / MOBA_BLK); }
        }
#if SSM_FAST
        if ((int)blockIdx.x < SG) { const int g = blockIdx.x;
            { pg8::Gemm g1{A2, BTS, 0, 0, 512, 640, 512}; pg8::GroupOrder S1{g, 1, g}; pg8::EpiS E1{SBUF};
              pg8::gemm_phase<pg8::EpiS, pg8::GroupOrder, false, PG8_SP2>(F.lds + RING_OFF, g1, S1, E1); }
            VM_WAIT(); __syncthreads();
            if (F.tid < 128) { const int b = F.tid >> 6, p = F.tid & 63;
                const float lr = lam_re[g * SP + p], li = lam_im[g * SP + p], dt = expf(log_dt[g]);
                const float mag = expf(lr * dt * 32.0f), ang = li * dt * 32.0f, l32r = mag * cosf(ang), l32i = mag * sinf(ang);
                float xr = 0.f, xi = 0.f;
                const unsigned* sp = (const unsigned*)(SBUF + ((size_t)g * 256 + b * 128) * 128 + p);
                bf16* xp = A2 + ((size_t)(g * 256 + b * 128)) * 640 + 512 + p;
                for (int c0 = 0; c0 < 128; c0 += 8) { float sr[8], si[8];
#pragma unroll
                    for (int k = 0; k < 8; ++k) { sr[k] = __uint_as_float(__hip_atomic_load(sp + (size_t)(c0 + k) * 128, __ATOMIC_RELAXED, __HIP_MEMORY_SCOPE_AGENT));
                                                  si[k] = __uint_as_float(__hip_atomic_load(sp + (size_t)(c0 + k) * 128 + 64, __ATOMIC_RELAXED, __HIP_MEMORY_SCOPE_AGENT)); }
#pragma unroll
                    for (int k = 0; k < 8; ++k) { xp[(size_t)(c0 + k) * 640] = (bf16)f2bf(xr); xp[(size_t)(c0 + k) * 640 + 64] = (bf16)f2bf(xi);
                        const float nxr = l32r * xr - l32i * xi + sr[k], nxi = l32r * xi + l32i * xr + si[k]; xr = nxr; xi = nxi; } }
            }
            VM_WAIT(); __syncthreads();
            { pg8::Gemm g2{A2, BT2, 0, 0, 640, 640, 640}; pg8::GroupOrder S2{g, 2, 2 * g}; pg8::EpiY E2{YB};
              pg8::gemm_phase<pg8::EpiY, pg8::GroupOrder, PG8_ALIGN, PG8_SP2>(F.lds + RING_OFF, g2, S2, E2); }
        }
#else
        for (int it = gw; it < BATCH * SG; it += NGW) {
            const int g = it % SG, b = it / SG, p = F.lane;
            const float lr = lam_re[g * SP + p], li = lam_im[g * SP + p], dt = expf(log_dt[g]);
            const float er = expf(lr * dt), lbr = er * cosf(li * dt), lbi = er * sinf(li * dt);
            const float nr = lbr - 1.0f, ni = lbi, den = lr * lr + li * li;
            const float cr_ = (nr * lr + ni * li) / den, ci_ = (ni * lr - nr * li) / den;
            float bbr[16], bbi[16], ccr[16], cci[16];
#pragma unroll
            for (int h = 0; h < 16; ++h) { const float bre = b_re[(size_t)(g * SP + p) * SC + h], bim = b_im[(size_t)(g * SP + p) * SC + h];
                bbr[h] = cr_ * bre - ci_ * bim; bbi[h] = cr_ * bim + ci_ * bre;
                ccr[h] = c_re[(size_t)(g * SC + h) * SP + p]; cci[h] = c_im[(size_t)(g * SC + h) * SP + p]; }
            const float dsk = d_skip[g * SC + (F.lane & 15)];
            float xr = 0.f, xi = 0.f;
            const bf16* up = A2 + (size_t)(g * 256 + b * 128) * 640;
            v4u n0 = *(const GAS v4u*)(up), n1 = *(const GAS v4u*)(up + 8);
            for (int t = 0; t < SEQ; ++t) {
                const v4u c0 = n0, c1 = n1;
                if (t + 1 < SEQ) { const bf16* un = up + (size_t)((t + 1) >> 5) * 640 + ((t + 1) & 31) * 16; n0 = *(const GAS v4u*)(un); n1 = *(const GAS v4u*)(un + 8); }
                float uf[16];
                uf[0] = bf_lo(c0.x); uf[1] = bf_hi(c0.x); uf[2] = bf_lo(c0.y); uf[3] = bf_hi(c0.y); uf[4] = bf_lo(c0.z); uf[5] = bf_hi(c0.z); uf[6] = bf_lo(c0.w); uf[7] = bf_hi(c0.w);
                uf[8] = bf_lo(c1.x); uf[9] = bf_hi(c1.x); uf[10] = bf_lo(c1.y); uf[11] = bf_hi(c1.y); uf[12] = bf_lo(c1.z); uf[13] = bf_hi(c1.z); uf[14] = bf_lo(c1.w); uf[15] = bf_hi(c1.w);
                float bur = 0.f, bui = 0.f;
#pragma unroll
                for (int h = 0; h < 16; ++h) { bur += uf[h] * bbr[h]; bui += uf[h] * bbi[h]; }
                const float nxr = lbr * xr - lbi * xi + bur, nxi = lbr * xi + lbi * xr + bui; xr = nxr; xi = nxi;
                float yv = 0.f;
#pragma unroll
                for (int h = 0; h < 16; ++h) { const float v = wave_sum(xr * ccr[h] - xi * cci[h]); if (F.lane == h) yv = v + dsk * uf[h]; }
                if (F.lane < 16) YB[(size_t)(b * SEQ + t) * SW + g * SC + F.lane] = (bf16)f2bf(gelu_tanh(yv));
            }
        }
#endif
        if (BOTH(2)) GRID_BAR();
    }

    if (IN(3)) {
        static_assert(attn_body::ATTN_LDS_BYTES <= RING_BYTES && attn_body::ATTN_PITCH == AW, "attention body geometry vs frame");
        const attn_body::AttnTensors AT{(const attn_body::bf16*)QB, (const attn_body::bf16*)KB, (const attn_body::bf16*)VB, (attn_body::bf16*)QB, KMEAN, T5B};
        const attn_body::StaticOrder S((int)F.G, (int)blockIdx.x);
        attn_body::attn_phase<attn_body::StaticOrder>((char*)lds + RING_OFF, AT, S);
        if (BOTH(3)) GRID_BAR();
    }

    if (IN(4)) {
        pg8::Gemm g{YB, Wt_glu, M, SW, SW}; pg8::StaticOrder S; S.init(M, SW, F.G, (int)blockIdx.x);
        pg8::EpiGlu E{YB, ZB, SW, b_glu};
        pg8::gemm_phase<pg8::EpiGlu, pg8::StaticOrder, PG8_ALIGN, PG8_SP2>(F.lds + RING_OFF, g, S, E);
        if (BOTH(4)) GRID_BAR();
    }

    if (IN(5)) {
        for (int m = gw; m < M; m += NGW) {
            rms_row1024_bf16(F.lane, QB + (size_t)m * AW, norm_attn, XN + (size_t)m * DM);
            rms_row1024_bf16(F.lane, ZB + (size_t)m * SW, norm_ssm, XN + (size_t)m * DM + AW);
        }
        if (BOTH(5)) GRID_BAR();
    }

    if (IN(6)) {
        pg8::Gemm g{XN, Wt_out, M, DM, DM}; pg8::StaticOrder S; S.init(M, DM, F.G, (int)blockIdx.x);
        pg8::EpiResid1<F8_UP> E{x, out, X1G, norm_ffn, SSQ, DM};
        pg8::gemm_phase<pg8::EpiResid1<F8_UP>, pg8::StaticOrder, PG8_ALIGN, PG8_SP2>(F.lds + RING_OFF, g, S, E);
        if (BOTH(6)) GRID_BAR();
    }

    if (IN(7)) {
        pg8::Gemm g{(const bf16*)X1G, (const bf16*)Wt_up, M, DFF2, F8_UP ? DM / 2 : DM, 0, 0}; pg8::StaticOrder S; S.init(M, DFF2, F.G, (int)blockIdx.x);
        pg8::EpiUp E{UPB, DFF2, SSQ, 1.0f / DM, RMS_EPS, F8_UP ? 1.0f / WSCALE : 1.0f};
        pg8::gemm_phase<pg8::EpiUp, pg8::StaticOrder, PG8_ALIGN, PG8_SP2, F8_UP>(F.lds + RING_OFF, g, S, E);
        if (BOTH(7)) GRID_BAR();
    }

    if (IN(8)) {
        constexpr int NCC = DFF / 8, RUN = 32, NRUN = M / RUN;
        for (int it = gt; it < NCC * NRUN; it += NGT) {
            const int cc = it % NCC, rr = it / NCC, j0 = cc * 8, r0 = rr * RUN;
            float wg[3][8], wv[3][8], bg[8], bvv[8];
#pragma unroll
            for (int k = 0; k < 3; ++k)
#pragma unroll
                for (int e = 0; e < 8; ++e) { wg[k][e] = conv_w[(size_t)k * DFF2 + j0 + e]; wv[k][e] = conv_w[(size_t)k * DFF2 + DFF + j0 + e]; }
#pragma unroll
            for (int e = 0; e < 8; ++e) { bg[e] = conv_b[j0 + e]; bvv[e] = conv_b[DFF + j0 + e]; }
            float g1[8], g2[8], v1[8], v2[8];
#pragma unroll
            for (int e = 0; e < 8; ++e) { g1[e] = 0.f; g2[e] = 0.f; v1[e] = 0.f; v2[e] = 0.f; }
            if ((r0 % SEQ) != 0) {
                const v4u a1 = *(const GAS v4u*)(UPB + (size_t)(r0 - 1) * DFF2 + j0), a2 = *(const GAS v4u*)(UPB + (size_t)(r0 - 2) * DFF2 + j0);
                const v4u c1 = *(const GAS v4u*)(UPB + (size_t)(r0 - 1) * DFF2 + DFF + j0), c2 = *(const GAS v4u*)(UPB + (size_t)(r0 - 2) * DFF2 + DFF + j0);
                g1[0] = bf_lo(a1.x); g1[1] = bf_hi(a1.x); g1[2] = bf_lo(a1.y); g1[3] = bf_hi(a1.y); g1[4] = bf_lo(a1.z); g1[5] = bf_hi(a1.z); g1[6] = bf_lo(a1.w); g1[7] = bf_hi(a1.w);
                g2[0] = bf_lo(a2.x); g2[1] = bf_hi(a2.x); g2[2] = bf_lo(a2.y); g2[3] = bf_hi(a2.y); g2[4] = bf_lo(a2.z); g2[5] = bf_hi(a2.z); g2[6] = bf_lo(a2.w); g2[7] = bf_hi(a2.w);
                v1[0] = bf_lo(c1.x); v1[1] = bf_hi(c1.x); v1[2] = bf_lo(c1.y); v1[3] = bf_hi(c1.y); v1[4] = bf_lo(c1.z); v1[5] = bf_hi(c1.z); v1[6] = bf_lo(c1.w); v1[7] = bf_hi(c1.w);
                v2[0] = bf_lo(c2.x); v2[1] = bf_hi(c2.x); v2[2] = bf_lo(c2.y); v2[3] = bf_hi(c2.y); v2[4] = bf_lo(c2.z); v2[5] = bf_hi(c2.z); v2[6] = bf_lo(c2.w); v2[7] = bf_hi(c2.w);
            }
            for (int r = r0; r < r0 + RUN; ++r) {
                const v4u a0 = *(const GAS v4u*)(UPB + (size_t)r * DFF2 + j0), c0 = *(const GAS v4u*)(UPB + (size_t)r * DFF2 + DFF + j0);
                float g0[8], v0[8], o[8];
                g0[0] = bf_lo(a0.x); g0[1] = bf_hi(a0.x); g0[2] = bf_lo(a0.y); g0[3] = bf_hi(a0.y); g0[4] = bf_lo(a0.z); g0[5] = bf_hi(a0.z); g0[6] = bf_lo(a0.w); g0[7] = bf_hi(a0.w);
                v0[0] = bf_lo(c0.x); v0[1] = bf_hi(c0.x); v0[2] = bf_lo(c0.y); v0[3] = bf_hi(c0.y); v0[4] = bf_lo(c0.z); v0[5] = bf_hi(c0.z); v0[6] = bf_lo(c0.w); v0[7] = bf_hi(c0.w);
#pragma unroll
                for (int e = 0; e < 8; ++e) {
                    const float cg = g0[e] * wg[2][e] + g1[e] * wg[1][e] + g2[e] * wg[0][e] + bg[e];
                    const float cv = v0[e] * wv[2][e] + v1[e] * wv[1][e] + v2[e] * wv[0][e] + bvv[e];
                    o[e] = cg * __builtin_amdgcn_rcpf(1.0f + __builtin_amdgcn_exp2f(-LOG2E * cg)) * cv;
                    g2[e] = g1[e]; g1[e] = g0[e]; v2[e] = v1[e]; v1[e] = v0[e]; }
                if (F8_DN) { v2u w; w.x = pk4_fp8(o[0], o[1], o[2], o[3]); w.y = pk4_fp8(o[4], o[5], o[6], o[7]); *(GAS v2u*)(ACT + (size_t)r * DFF + j0) = w; }
                else { v4u w; w.x = pk2(o[0], o[1]); w.y = pk2(o[2], o[3]); w.z = pk2(o[4], o[5]); w.w = pk2(o[6], o[7]); *(GAS v4u*)((bf16*)ACT + (size_t)r * DFF + j0) = w; }
            }
        }
        if (BOTH(8)) GRID_BAR();
    }

    if (IN(9)) {
        pg8::Gemm g{(const bf16*)ACT, (const bf16*)Wt_down, M, DM, F8_DN ? DFF / 2 : DFF, 0, 0}; pg8::StaticOrder S; S.init(M, DM, F.G, (int)blockIdx.x);
        pg8::EpiResid2 E{out, DM, F8_DN ? 1.0f / WSCALE : 1.0f};
        pg8::gemm_phase<pg8::EpiResid2, pg8::StaticOrder, PG8_ALIGN, PG8_SP2, F8_DN>(F.lds + RING_OFF, g, S, E);
        if (BOTH(9)) GRID_BAR();
    }

    if (IN(10)) {
        for (int m = gw; m < M; m += NGW) {
            GAS f32x4* xr = (GAS f32x4*)(out + (size_t)m * DM) + F.lane; const GAS f32x4* gr = (const GAS f32x4*)norm_final + F.lane;
            f32x4 v[8]; float s = 0.f;
#pragma unroll
            for (int j = 0; j < 8; ++j) { v[j] = xr[64 * j]; s += (v[j].x * v[j].x + v[j].y * v[j].y) + (v[j].z * v[j].z + v[j].w * v[j].w); }
            const float rstd = 1.0f / sqrtf(wave_sum(s) * (1.f / DM) + RMS_EPS);
#pragma unroll
            for (int j = 0; j < 8; ++j) xr[64 * j] = v[j] * rstd * gr[64 * j];
        }
    }
#undef IN
#undef BOTH
}

extern "C" void kernel_launch(void* const* d_in, const int* in_sizes, int n_in, void* d_out, int out_size, void* d_ws, size_t ws_size, hipStream_t stream) {
    static int grid = 0;
    if (grid == 0) {
        if (n_in != 23 || in_sizes[0] != M * DM || out_size != M * DM || ws_size < WS_END) { fprintf(stderr, "kernel_launch: unexpected shapes: n_in %d in0 %d out %d ws %zu (need %zu); nothing launched\n", n_in, n_in > 0 ? in_sizes[0] : -1, out_size, ws_size, (size_t)WS_END); grid = -1; return; }
        int dev = 0, cus = 0, per_cu = 0;
        if (hipGetDevice(&dev) != hipSuccess || hipDeviceGetAttribute(&cus, hipDeviceAttributeMultiprocessorCount, dev) != hipSuccess) { fprintf(stderr, "kernel_launch: device query failed\n"); grid = -1; return; }
        if (hipFuncSetAttribute((const void*)skel_fwd, hipFuncAttributeMaxDynamicSharedMemorySize, LDS_BYTES) != hipSuccess) { fprintf(stderr, "kernel_launch: hipFuncSetAttribute failed\n"); grid = -1; return; }
        if (hipOccupancyMaxActiveBlocksPerMultiprocessor(&per_cu, (const void*)skel_fwd, NWAVES * 64, LDS_BYTES) != hipSuccess || per_cu < 1)
            fprintf(stderr, "kernel_launch: note: occupancy query reports %d workgroups per CU\n", per_cu);
        (void)hipGetLastError();
        grid = cus;
        if (grid < SG) { fprintf(stderr, "kernel_launch: needs >= %d CUs\n", SG); grid = -1; return; }
    }
    if (grid < 0) return;
    if (hipMemsetAsync((char*)d_ws + WS_CTL, 0, CTL_ZERO_BYTES, stream) != hipSuccess) { fprintf(stderr, "kernel_launch: hipMemsetAsync failed\n"); return; }
    Args a{};
    for (int i = 0; i < 23; ++i) a.in[i] = (const float*)d_in[i];
    a.out = (float*)d_out; a.ws = (unsigned char*)d_ws;
    for (int li = 0; li < N_LAUNCHES; ++li) {
        a.ph_lo = (N_LAUNCHES == 1) ? 0 : li; a.ph_hi = (N_LAUNCHES == 1) ? NPH : li + 1; a.li = li;
        hipLaunchKernelGGL(skel_fwd, dim3(grid), dim3(NWAVES * 64), LDS_BYTES, stream, a);
        const hipError_t le = hipPeekAtLastError();
        if (le != hipSuccess) { fprintf(stderr, "kernel_launch: launch %d failed: %s\n", li, hipGetErrorName(le)); break; }
    }
}
```

```cpp
#define F8_UP 1
#define F8_DN 0
#ifndef SSM_FAST
#define SSM_FAST 1
#endif
#ifndef F8_UP
#define F8_UP 1
#endif
#ifndef F8_DN
#define F8_DN 1
#endif
#include <hip/hip_runtime.h>
#include <cstdio>
#include <cstdint>
namespace pg8 {
#define PG8_LAS __attribute__((address_space(3)))
typedef unsigned short bf16_t;
typedef short bf16x8 __attribute__((ext_vector_type(8)));
typedef float f32x4 __attribute__((ext_vector_type(4)));
typedef unsigned u32x4 __attribute__((ext_vector_type(4)));
constexpr int BM = 256, BK = 64, HALF = 128, HTB = HALF * BK * 2  , STAGE_BYTES = 8 * HTB, NXCD = 8, WGM = 8;

__host__ __device__ __forceinline__ int lds_byte(int r, int c) { const int st = (r >> 4) * 2 + (c >> 5), rr = r & 15, cc = c & 31, ob = rr * 64 + cc * 2; return st * 1024 + (ob ^ (((ob >> 9) & 1) << 5)); }
__host__ __device__ __forceinline__ void stage_rc(int b, int& R, int& C) { const int st = b / 1024, sb = b % 1024, swz = sb ^ (((sb >> 9) & 1) << 5); R = (st >> 1) * 16 + swz / 64; C = (st & 1) * 32 + (swz % 64) / 2; }
__host__ __device__ __forceinline__ int perm32(int rho) { const int n = rho >> 4, i = rho & 15; return 8 * (i >> 2) + 4 * n + (i & 3); }

struct Unit { int pm, pn; };
struct Gemm { const bf16_t* A; const bf16_t* Bt; int M, N, K; int lda, ldb; };

struct StaticOrder {
    int nM, nN, nwg, G, c;
    __host__ __device__ void init(int M, int N, int G_, int c_) { nM = M / BM; nN = N / BM; nwg = nM * nN; G = G_; c = c_; }
    __host__ __device__ bool next(int i, Unit& u) const {
        const long L = (long)i * G + c; if (L >= nwg) return false;
        int wgid = (int)L; { const int q = nwg / NXCD, r = nwg % NXCD, xcd = wgid % NXCD, off = wgid / NXCD; wgid = (xcd < r ? xcd * (q + 1) : r * (q + 1) + (xcd - r) * q) + off; }
        const int nig = WGM * nN, gid = wgid / nig, fm = gid * WGM, gsz = (nM - fm) < WGM ? (nM - fm) : WGM;
        u.pm = fm + ((wgid % nig) % gsz); u.pn = (wgid % nig) / gsz; return true;
    }
    __device__ __forceinline__ void a_ready(const Unit&) const {}
    __device__ __forceinline__ void done(const Unit&) const {}
    __device__ __forceinline__ int arow(const Unit& u) const { return u.pm * BM; }
};

__device__ __forceinline__ unsigned cvt_pk_bf16(float lo, float hi) { unsigned r; asm volatile("v_cvt_pk_bf16_f32 %0, %1, %2" : "=v"(r) : "v"(lo), "v"(hi)); return r; }
typedef float f32x2 __attribute__((ext_vector_type(2)));
__device__ __forceinline__ f32x2 gelu_pk(f32x2 v) {
    const f32x2 av = __builtin_elementwise_abs(v), d = av * 0.2316418882f + 1.0f;
    f32x2 t; t.x = __builtin_amdgcn_rcpf(d.x); t.y = __builtin_amdgcn_rcpf(d.y);
    f32x2 q = t * 0.5307027145f + (-0.7265760135f); q = q * t + 0.7107068705f; q = q * t + (-0.142248368f); q = q * t + 0.127414796f; q = q * t;
    const f32x2 s = (v * v) * (-0.72134752044f);
    f32x2 e; e.x = __builtin_amdgcn_exp2f(s.x); e.y = __builtin_amdgcn_exp2f(s.y);
    const f32x2 m = v * (q * e), r = v - m;
    f32x2 o; o.x = v.x < 0.f ? m.x : r.x; o.y = v.y < 0.f ? m.y : r.y; return o;
}

template <int ACT  > struct EpiBf16 {
    static constexpr bool PERM = true, AFTER_DRAIN = false; static_assert(ACT == 0 || ACT == 1, "EpiBf16: ACT is 0 (none) or 1 (gelu_pk)");
    bf16_t* O; int ldc; const float* bias; int split_cols; size_t split_stride; float scale0;
    __device__ __forceinline__ void operator()(const f32x4 (&acc)[2][2][4][2], const Unit& u, int wr, int wc, int fr, int fq) const {
        const int row0 = u.pm * BM + wr * 64 + fr; int colt = u.pn * BM; bf16_t* base = O;
        float sc = 1.f; if (split_cols) { const int t = colt / split_cols; base += (size_t)t * split_stride; colt -= t * split_cols; if (t == 0) sc = scale0; }
        const int col0 = colt + wc * 32 + 8 * fq, bcol0 = u.pn * BM + wc * 32 + 8 * fq;
        f32x4 bv[2][2];
#pragma unroll
        for (int bj = 0; bj < 2; ++bj)
#pragma unroll
            for (int n = 0; n < 2; ++n) bv[bj][n] = bias ? *(const f32x4*)(bias + bcol0 + bj * HALF + 4 * n) : (f32x4){0.f, 0.f, 0.f, 0.f};
#pragma unroll
        for (int ai = 0; ai < 2; ++ai)
#pragma unroll
            for (int m = 0; m < 4; ++m) { bf16_t* rowp = base + (size_t)(row0 + ai * HALF + m * 16) * ldc + col0;
#pragma unroll
                for (int bj = 0; bj < 2; ++bj) { f32x4 v0 = acc[ai][bj][m][0] + bv[bj][0], v1 = acc[ai][bj][m][1] + bv[bj][1];
                    if (ACT == 1) { f32x2 a = gelu_pk((f32x2){v0[0], v0[1]}), b = gelu_pk((f32x2){v0[2], v0[3]}), c = gelu_pk((f32x2){v1[0], v1[1]}), d = gelu_pk((f32x2){v1[2], v1[3]});
                        v0 = (f32x4){a.x, a.y, b.x, b.y}; v1 = (f32x4){c.x, c.y, d.x, d.y}; }
                    v0 = v0 * sc; v1 = v1 * sc; u32x4 w; w.x = cvt_pk_bf16(v0[0], v0[1]); w.y = cvt_pk_bf16(v0[2], v0[3]); w.z = cvt_pk_bf16(v1[0], v1[1]); w.w = cvt_pk_bf16(v1[2], v1[3]);
                    *(u32x4*)(rowp + bj * HALF) = w; } }
    }
};

typedef unsigned u32x2 __attribute__((ext_vector_type(2)));
__device__ __forceinline__ unsigned pk4_fp8(float a, float b, float c, float d) {
    unsigned w = 0u; w = __builtin_amdgcn_cvt_pk_fp8_f32(a, b, w, false); w = __builtin_amdgcn_cvt_pk_fp8_f32(c, d, w, true); return w; }
__device__ __forceinline__ float bf_lo(unsigned w) { return __uint_as_float(w << 16); }
__device__ __forceinline__ float bf_hi(unsigned w) { return __uint_as_float(w & 0xffff0000u); }
__device__ __forceinline__ float sigmoid_f(float v) { return __builtin_amdgcn_rcpf(1.0f + __builtin_amdgcn_exp2f(-1.4426950408889634f * v)); }
struct EpiGlu {
    static constexpr bool PERM = true, AFTER_DRAIN = false;
    const bf16_t* Y; bf16_t* Z; int ldc; const float* bias;
    __device__ __forceinline__ void operator()(const f32x4 (&acc)[2][2][4][2], const Unit& u, int wr, int wc, int fr, int fq) const {
        const int row0 = u.pm * BM + wr * 64 + fr, col0 = u.pn * BM + wc * 32 + 8 * fq;
        f32x4 bv[2][2];
#pragma unroll
        for (int bj = 0; bj < 2; ++bj)
#pragma unroll
            for (int n = 0; n < 2; ++n) bv[bj][n] = *(const f32x4*)(bias + col0 + bj * HALF + 4 * n);
#pragma unroll
        for (int ai = 0; ai < 2; ++ai)
#pragma unroll
            for (int m = 0; m < 4; ++m) { const size_t off = (size_t)(row0 + ai * HALF + m * 16) * ldc + col0;
#pragma unroll
                for (int bj = 0; bj < 2; ++bj) { const u32x4 yv = *(const u32x4*)(Y + off + bj * HALF);
                    const f32x4 v0 = acc[ai][bj][m][0] + bv[bj][0], v1 = acc[ai][bj][m][1] + bv[bj][1];
                    u32x4 w;
                    w.x = cvt_pk_bf16(bf_lo(yv.x) * sigmoid_f(v0[0]), bf_hi(yv.x) * sigmoid_f(v0[1]));
                    w.y = cvt_pk_bf16(bf_lo(yv.y) * sigmoid_f(v0[2]), bf_hi(yv.y) * sigmoid_f(v0[3]));
                    w.z = cvt_pk_bf16(bf_lo(yv.z) * sigmoid_f(v1[0]), bf_hi(yv.z) * sigmoid_f(v1[1]));
                    w.w = cvt_pk_bf16(bf_lo(yv.w) * sigmoid_f(v1[2]), bf_hi(yv.w) * sigmoid_f(v1[3]));
                    *(u32x4*)(Z + off + bj * HALF) = w; } }
    }
};
template <bool F8O> struct EpiResid1 {
    static constexpr bool PERM = true, AFTER_DRAIN = false;
    const float* X; float* X1; unsigned char* X1G; const float* gw; float* ssq; int ldc;
    __device__ __forceinline__ void operator()(const f32x4 (&acc)[2][2][4][2], const Unit& u, int wr, int wc, int fr, int fq) const {
        const int row0 = u.pm * BM + wr * 64 + fr, col0 = u.pn * BM + wc * 32 + 8 * fq;
        f32x4 gv[2][2];
#pragma unroll
        for (int bj = 0; bj < 2; ++bj)
#pragma unroll
            for (int n = 0; n < 2; ++n) gv[bj][n] = *(const f32x4*)(gw + col0 + bj * HALF + 4 * n);
#pragma unroll
        for (int ai = 0; ai < 2; ++ai)
#pragma unroll
            for (int m = 0; m < 4; ++m) { const int row = row0 + ai * HALF + m * 16; const size_t off = (size_t)row * ldc + col0; float s = 0.f;
#pragma unroll
                for (int bj = 0; bj < 2; ++bj) {
                    const f32x4 v0 = *(const f32x4*)(X + off + bj * HALF) + acc[ai][bj][m][0], v1 = *(const f32x4*)(X + off + bj * HALF + 4) + acc[ai][bj][m][1];
                    *(f32x4*)(X1 + off + bj * HALF) = v0; *(f32x4*)(X1 + off + bj * HALF + 4) = v1;
                    s += (v0[0] * v0[0] + v0[1] * v0[1]) + (v0[2] * v0[2] + v0[3] * v0[3]) + (v1[0] * v1[0] + v1[1] * v1[1]) + (v1[2] * v1[2] + v1[3] * v1[3]);
                    const f32x4 g0 = v0 * gv[bj][0], g1 = v1 * gv[bj][1];
                    if constexpr (F8O) { u32x2 w; w.x = pk4_fp8(g0[0], g0[1], g0[2], g0[3]); w.y = pk4_fp8(g1[0], g1[1], g1[2], g1[3]); *(u32x2*)(X1G + off + bj * HALF) = w; }
                    else { u32x4 w; w.x = cvt_pk_bf16(g0[0], g0[1]); w.y = cvt_pk_bf16(g0[2], g0[3]); w.z = cvt_pk_bf16(g1[0], g1[1]); w.w = cvt_pk_bf16(g1[2], g1[3]); *(u32x4*)((bf16_t*)X1G + off + bj * HALF) = w; } }
                s += __shfl_xor(s, 16); s += __shfl_xor(s, 32);
                if (fq == 0) ssq[(size_t)row * 32 + u.pn * 4 + wc] = s; }
    }
};
struct EpiUp {
    static constexpr bool PERM = true, AFTER_DRAIN = false;
    bf16_t* O; int ldc; const float* ssq; float inv_n, eps, wscale;
    __device__ __forceinline__ void operator()(const f32x4 (&acc)[2][2][4][2], const Unit& u, int wr, int wc, int fr, int fq) const {
        const int row0 = u.pm * BM + wr * 64 + fr, col0 = u.pn * BM + wc * 32 + 8 * fq;
#pragma unroll
        for (int ai = 0; ai < 2; ++ai)
#pragma unroll
            for (int m = 0; m < 4; ++m) { const int row = row0 + ai * HALF + m * 16; const f32x4* sp = (const f32x4*)(ssq + (size_t)row * 32);
                f32x4 t = sp[0];
#pragma unroll
                for (int k = 1; k < 8; ++k) t += sp[k];
                const float rstd = __builtin_amdgcn_rsqf(((t[0] + t[1]) + (t[2] + t[3])) * inv_n + eps) * wscale;
                bf16_t* rowp = O + (size_t)row * ldc + col0;
#pragma unroll
                for (int bj = 0; bj < 2; ++bj) { const f32x4 v0 = acc[ai][bj][m][0] * rstd, v1 = acc[ai][bj][m][1] * rstd; u32x4 w;
                    w.x = cvt_pk_bf16(v0[0], v0[1]); w.y = cvt_pk_bf16(v0[2], v0[3]); w.z = cvt_pk_bf16(v1[0], v1[1]); w.w = cvt_pk_bf16(v1[2], v1[3]);
                    *(u32x4*)(rowp + bj * HALF) = w; } }
    }
};
struct EpiResid2 {
    static constexpr bool PERM = true, AFTER_DRAIN = false;
    float* OUT; int ldc; float wscale;
    __device__ __forceinline__ void operator()(const f32x4 (&acc)[2][2][4][2], const Unit& u, int wr, int wc, int fr, int fq) const {
        const int row0 = u.pm * BM + wr * 64 + fr, col0 = u.pn * BM + wc * 32 + 8 * fq;
#pragma unroll
        for (int ai = 0; ai < 2; ++ai)
#pragma unroll
            for (int m = 0; m < 4; ++m) { float* rowp = OUT + (size_t)(row0 + ai * HALF + m * 16) * ldc + col0;
#pragma unroll
                for (int bj = 0; bj < 2; ++bj) { f32x4* p = (f32x4*)(rowp + bj * HALF); const f32x4 a = p[0], b = p[1]; p[0] = a + acc[ai][bj][m][0] * wscale; p[1] = b + acc[ai][bj][m][1] * wscale; } }
    }
};
__device__ __forceinline__ float gelu_tanh_f(float y) {
    const float u = 0.7978845608028654f * (y + 0.044715f * y * y * y);
    const float e = __builtin_amdgcn_exp2f(2.0f * 1.4426950408889634f * u);
    return 0.5f * y * (2.0f - 2.0f * __builtin_amdgcn_rcpf(e + 1.0f));
}
struct EpiQKVU {
    static constexpr bool PERM = true, AFTER_DRAIN = false;
    bf16_t* Q; size_t split_stride; bf16_t* A2; float scale0;
    __device__ __forceinline__ void operator()(const f32x4 (&acc)[2][2][4][2], const Unit& u, int wr, int wc, int fr, int fq) const {
        const int row0 = u.pm * BM + wr * 64 + fr; const int colt = u.pn * BM, t = colt >> 10, col0 = (colt & 1023) + wc * 32 + 8 * fq;
        const float sc = (t == 0) ? scale0 : 1.f;
#pragma unroll
        for (int ai = 0; ai < 2; ++ai)
#pragma unroll
            for (int m = 0; m < 4; ++m) { const int row = row0 + ai * HALF + m * 16;
#pragma unroll
                for (int bj = 0; bj < 2; ++bj) { const int c = col0 + bj * HALF; const f32x4 v0 = acc[ai][bj][m][0] * sc, v1 = acc[ai][bj][m][1] * sc; u32x4 w;
                    w.x = cvt_pk_bf16(v0[0], v0[1]); w.y = cvt_pk_bf16(v0[2], v0[3]); w.z = cvt_pk_bf16(v1[0], v1[1]); w.w = cvt_pk_bf16(v1[2], v1[3]);
                    if (t < 3) *(u32x4*)(Q + (size_t)t * split_stride + (size_t)row * 1024 + c) = w;
                    else { const int b = row >> 12, tok = row & 4095; *(u32x4*)(A2 + ((size_t)((c >> 4) * 256 + b * 128 + (tok >> 5)) * 640 + (tok & 31) * 16 + (c & 15))) = w; } } }
    }
};
struct EpiS {
    static constexpr bool PERM = false, AFTER_DRAIN = false;
    float* S;
    __device__ __forceinline__ void operator()(const f32x4 (&acc)[2][2][4][2], const Unit& u, int wr, int wc, int fr, int fq) const {
        const int row0 = wr * 64 + fr, col0 = wc * 32 + 4 * fq;
#pragma unroll
        for (int ai = 0; ai < 2; ++ai)
#pragma unroll
            for (int m = 0; m < 4; ++m) { float* rowp = S + ((size_t)u.pm * 256 + row0 + ai * HALF + m * 16) * 128 + col0;
#pragma unroll
                for (int n = 0; n < 2; ++n) *(f32x4*)(rowp + n * 16) = acc[ai][0][m][n]; }
    }
};
struct EpiY {
    static constexpr bool PERM = true, AFTER_DRAIN = false;
    bf16_t* Y;
    __device__ __forceinline__ void operator()(const f32x4 (&acc)[2][2][4][2], const Unit& u, int wr, int wc, int fr, int fq) const {
        const int row0 = wr * 64 + fr, col0 = (u.pn & 1) * BM + wc * 32 + 8 * fq, g = u.pm;
#pragma unroll
        for (int ai = 0; ai < 2; ++ai)
#pragma unroll
            for (int m = 0; m < 4; ++m) { const int R = row0 + ai * HALF + m * 16, b = R >> 7, c = R & 127;
#pragma unroll
                for (int bj = 0; bj < 2; ++bj) { const int cl = col0 + bj * HALF, t = cl >> 4, h0 = cl & 15; const f32x4 v0 = acc[ai][bj][m][0], v1 = acc[ai][bj][m][1]; u32x4 w;
                    w.x = cvt_pk_bf16(gelu_tanh_f(v0[0]), gelu_tanh_f(v0[1])); w.y = cvt_pk_bf16(gelu_tanh_f(v0[2]), gelu_tanh_f(v0[3]));
                    w.z = cvt_pk_bf16(gelu_tanh_f(v1[0]), gelu_tanh_f(v1[1])); w.w = cvt_pk_bf16(gelu_tanh_f(v1[2]), gelu_tanh_f(v1[3]));
                    *(u32x4*)(Y + (size_t)(b * 4096 + c * 32 + t) * 1024 + g * 16 + h0) = w; } }
    }
};
struct GroupOrder {
    int g, nu, pn0;
    __device__ __forceinline__ bool next(int i, Unit& u) const { if (i >= nu) return false; u.pm = g; u.pn = pn0 + i; return true; }
    __device__ __forceinline__ void a_ready(const Unit&) const {}
    __device__ __forceinline__ void done(const Unit&) const {}
    __device__ __forceinline__ int arow(const Unit& u) const { return u.pm * BM; }
};
__host__ __device__ __forceinline__ int up_arow(int pm) { const int i = pm % 17, b = pm / 17; return b * 4096 + (i == 16 ? 3840 : 254 * i); }
template <int CTRL> __device__ __forceinline__ float dppf(float oldv, float src) {
    return __int_as_float(__builtin_amdgcn_update_dpp(__float_as_int(oldv), __float_as_int(src), CTRL, 0xf, 0xf, false)); }
template <bool F8O> struct EpiConv {
    static constexpr bool PERM = true, AFTER_DRAIN = false;
    unsigned char* ACT; const float* ssq; const float* cw; const float* cb; PG8_LAS float* xl; float inv_n, eps, wscale;
    __device__ __forceinline__ void operator()(const f32x4 (&acc)[2][2][4][2], const Unit& u, int wr, int wc, int fr, int fq) const {
        constexpr int DFFc = 5632;
        const int tid = threadIdx.x, wid = wr * 4 + wc;
        const int arow0 = up_arow(u.pm); const bool first = (u.pm % 17) == 0;
        PG8_LAS float* rs = xl; PG8_LAS float* hal = xl + 256;
        {
            const f32x4* sp = (const f32x4*)(ssq + (size_t)(arow0 + (tid >> 1)) * 32 + (tid & 1) * 16);
            const f32x4 t = (sp[0] + sp[1]) + (sp[2] + sp[3]); float s = (t[0] + t[1]) + (t[2] + t[3]); s += __shfl_xor(s, 1);
            if ((tid & 1) == 0) rs[tid >> 1] = __builtin_amdgcn_rsqf(s * inv_n + eps) * wscale;
        }
        if (fr >= 14) {
#pragma unroll
            for (int ai = 0; ai < 2; ++ai)
#pragma unroll
                for (int bj = 0; bj < 2; ++bj)
#pragma unroll
                    for (int n = 0; n < 2; ++n) *(PG8_LAS f32x4*)(hal + ((wid * 2 + ai) * 2 + (fr - 14)) * 64 + fq * 16 + bj * 8 + n * 4) = acc[ai][bj][3][n];
        }
        asm volatile("s_waitcnt lgkmcnt(0)" ::: "memory"); __builtin_amdgcn_s_barrier(); asm volatile("" ::: "memory");
        const int jg = u.pn * 128 + wc * 32 + 8 * fq;
        unsigned keep[2][4];
#pragma unroll
        for (int n = 0; n < 2; ++n) {
            f32x4 wg[3], wv[3], bgv, bvv;
#pragma unroll
            for (int k = 0; k < 3; ++k) { wg[k] = *(const f32x4*)(cw + (size_t)k * (2 * DFFc) + jg + 4 * n); wv[k] = *(const f32x4*)(cw + (size_t)k * (2 * DFFc) + DFFc + jg + 4 * n); }
            bgv = *(const f32x4*)(cb + jg + 4 * n); bvv = *(const f32x4*)(cb + DFFc + jg + 4 * n);
#pragma unroll
            for (int ai = 0; ai < 2; ++ai) {
                const int R0 = 128 * ai + 64 * wr;
                f32x4 o1g, o2g, o1v, o2v;
                if (ai == 0 && wr == 0) { o1g = (f32x4){0.f, 0.f, 0.f, 0.f}; o2g = o1g; o1v = o1g; o2v = o1g; }
                else { const int pw = (ai == 0) ? wc : (wr == 0 ? 4 + wc : wc), pai = (ai == 1 && wr == 1) ? 1 : 0;
                    const float r15 = rs[R0 - 1], r14 = rs[R0 - 2]; const PG8_LAS float* hp = hal + ((pw * 2 + pai) * 2) * 64 + fq * 16 + n * 4;
                    const f32x4 g14 = *(const PG8_LAS f32x4*)(hp) * r14, g15 = *(const PG8_LAS f32x4*)(hp + 64) * r15, v14 = *(const PG8_LAS f32x4*)(hp + 8) * r14, v15 = *(const PG8_LAS f32x4*)(hp + 64 + 8) * r15;
                    o1g = g15; o1v = v15; o2g = (fr == 0) ? g14 : g15; o2v = (fr == 0) ? v14 : v15; }
#pragma unroll
                for (int m = 0; m < 4; ++m) { const int rl = R0 + 16 * m + fr; const float rr = rs[rl];
                    const f32x4 cg = acc[ai][0][m][n] * rr, cv = acc[ai][1][m][n] * rr; f32x4 a;
#pragma unroll
                    for (int e = 0; e < 4; ++e) {
                        const float g1 = dppf<0x111>(o1g[e], cg[e]), g2 = dppf<0x112>(o2g[e], cg[e]), v1 = dppf<0x111>(o1v[e], cv[e]), v2 = dppf<0x112>(o2v[e], cv[e]);
                        const float xg = cg[e] * wg[2][e] + g1 * wg[1][e] + g2 * wg[0][e] + bgv[e], xv = cv[e] * wv[2][e] + v1 * wv[1][e] + v2 * wv[0][e] + bvv[e];
                        a[e] = xg * __builtin_amdgcn_rcpf(1.0f + __builtin_amdgcn_exp2f(-1.4426950408889634f * xg)) * xv;
                        o1g[e] = dppf<0x121>(cg[e], cg[e]); o2g[e] = dppf<0x122>(cg[e], cg[e]); o1v[e] = dppf<0x121>(cv[e], cv[e]); o2v[e] = dppf<0x122>(cv[e], cv[e]); }
                    const bool st = first || rl >= 2; const size_t row = (size_t)(arow0 + rl);
                    if constexpr (F8O) { const unsigned w = pk4_fp8(a[0], a[1], a[2], a[3]);
                        if (n == 0) keep[ai][m] = w; else if (st) { u32x2 o; o.x = keep[ai][m]; o.y = w; *(u32x2*)(ACT + row * DFFc + jg) = o; } }
                    else { u32x2 o; o.x = cvt_pk_bf16(a[0], a[1]); o.y = cvt_pk_bf16(a[2], a[3]); if (st) *(u32x2*)((bf16_t*)ACT + row * DFFc + jg + 4 * n) = o; }
                }
            }
        }
    }
};
struct UpOrder : StaticOrder {
    __host__ __device__ void init_up(int G_, int c_) { nM = 34; nN = 44; nwg = nM * nN; G = G_; c = c_; }
    __device__ __forceinline__ int arow(const Unit& u) const { return up_arow(u.pm); }
};
typedef int v4i32_t __attribute__((ext_vector_type(4)));
typedef int v8i32_t __attribute__((ext_vector_type(8)));
__device__ __forceinline__ f32x4 mfma8(bf16x8 b0, bf16x8 b1, bf16x8 a0, bf16x8 a1, f32x4 c) {
    const v8i32_t bb = __builtin_shufflevector(__builtin_bit_cast(v4i32_t, b0), __builtin_bit_cast(v4i32_t, b1), 0, 1, 2, 3, 4, 5, 6, 7);
    const v8i32_t aa = __builtin_shufflevector(__builtin_bit_cast(v4i32_t, a0), __builtin_bit_cast(v4i32_t, a1), 0, 1, 2, 3, 4, 5, 6, 7);
    return __builtin_amdgcn_mfma_scale_f32_16x16x128_f8f6f4(bb, aa, c, 0, 0, 0, 0, 0, 0);
}
template <class Epi, class Sched, bool ALIGN_EPI = false, bool SP2 = false, bool F8 = false>
__device__ __forceinline__ void gemm_phase(PG8_LAS unsigned char* lds, const Gemm g, const Sched& S, const Epi& E) {
    const int tid = threadIdx.x, wid = __builtin_amdgcn_readfirstlane(tid >> 6), lane = tid & 63, wr = wid >> 2, wc = wid & 3, fr = lane & 15, fq = lane >> 4;
    const int K = g.K, nt = K / BK, lda = g.lda ? g.lda : K, ldb = g.ldb ? g.ldb : K;
    unsigned voffA[2], voffB[2];
#pragma unroll
    for (int i = 0; i < 2; ++i) { int R, C; stage_rc(tid * 16 + i * 8192, R, C); const int Rb = Epi::PERM ? ((R & ~31) + perm32(R & 31)) : R;
        voffA[i] = (unsigned)(R * lda + C) * 2u; voffB[i] = (unsigned)(Rb * ldb + C) * 2u; }
    const size_t kstep = (size_t)(BK * 2);
    const size_t hstepA = (size_t)HALF * lda * 2, hstepB = (size_t)HALF * ldb * 2;
    const size_t tstepA = 2 * hstepA, tstepB = 2 * hstepB;
    const unsigned ldsw = (unsigned)wid * 1024u;
    const int aoff = lds_byte(wr * 64 + fr, fq * 8), boff = lds_byte(wc * 32 + fr, fq * 8);
#define PG8_SA(b, h) (((b) * 2 + (h)) * HTB)
#define PG8_SB(b, h) ((4 + (b) * 2 + (h)) * HTB)
#define PG8_STAGE(bufoff, gbase, voff) do { _Pragma("unroll") for (int _i = 0; _i < 2; ++_i) \
        __builtin_amdgcn_global_load_lds((const unsigned*)((const char*)(gbase) + (voff)[_i]), (PG8_LAS unsigned*)(lds + (bufoff) + ldsw + _i * 8192), 16, 0, 0); } while (0)
#define PG8_LD8(addr) __builtin_shufflevector(*(const PG8_LAS v4i32_t*)(addr), *(const PG8_LAS v4i32_t*)((addr) + 1024), 0, 1, 2, 3, 4, 5, 6, 7)
#define PG8_LDA(dst, b, h) do { if constexpr (F8) { _Pragma("unroll") for (int m = 0; m < 4; ++m) dst##8[m] = PG8_LD8(lds + PG8_SA(b, h) + aoff + m * 2048); } else { \
        _Pragma("unroll") for (int m = 0; m < 4; ++m) _Pragma("unroll") for (int k = 0; k < 2; ++k) dst[m][k] = *(const PG8_LAS bf16x8*)(lds + PG8_SA(b, h) + aoff + m * 2048 + k * 1024); } } while (0)
#define PG8_LDB(dst, b, h) do { if constexpr (F8) { _Pragma("unroll") for (int n = 0; n < 2; ++n) dst##8[n] = PG8_LD8(lds + PG8_SB(b, h) + boff + n * 2048); } else { \
        _Pragma("unroll") for (int n = 0; n < 2; ++n) _Pragma("unroll") for (int k = 0; k < 2; ++k) dst[n][k] = *(const PG8_LAS bf16x8*)(lds + PG8_SB(b, h) + boff + n * 2048 + k * 1024); } } while (0)
#define PG8_MMA(ai, bj, At, Bt) do { __builtin_amdgcn_s_setprio(1); \
        if constexpr (F8) { _Pragma("unroll") for (int m = 0; m < 4; ++m) _Pragma("unroll") for (int n = 0; n < 2; ++n) asm volatile("v_mfma_f32_16x16x128_f8f6f4 %0, %1, %2, %0" : "+v"(acc[ai][bj][m][n]) : "v"(Bt##8[n]), "v"(At##8[m])); } \
        else { _Pragma("unroll") for (int m = 0; m < 4; ++m) _Pragma("unroll") for (int n = 0; n < 2; ++n) _Pragma("unroll") for (int k = 0; k < 2; ++k) \
        acc[ai][bj][m][n] = __builtin_amdgcn_mfma_f32_16x16x32_bf16(Bt[n][k], At[m][k], acc[ai][bj][m][n], 0, 0, 0); } __builtin_amdgcn_s_setprio(0); } while (0)
#define PG8_WAIT_V(n) asm volatile("s_waitcnt vmcnt(" #n ")" ::: "memory")
#define PG8_WAIT_L(n) asm volatile("s_waitcnt lgkmcnt(" #n ")" ::: "memory")
#define PG8_BAR __builtin_amdgcn_s_barrier()
#define PG8_SCHED __builtin_amdgcn_sched_barrier(0)
    Unit cur, nxt; int ui = 0;
    if (!S.next(0, cur)) return;
    f32x4 acc[2][2][4][2];
#pragma unroll
    for (int a = 0; a < 2; ++a)
#pragma unroll
        for (int b = 0; b < 2; ++b)
#pragma unroll
            for (int m = 0; m < 4; ++m)
#pragma unroll
                for (int n = 0; n < 2; ++n) acc[a][b][m][n] = (f32x4){0.f, 0.f, 0.f, 0.f};
    bf16x8 At[4][2], B0[2][2], B1[2][2]; v8i32_t At8[4], B08[2], B18[2];
    const char* cA = (const char*)g.A + (size_t)S.arow(cur) * lda * 2; const char* cB = (const char*)g.Bt + (size_t)cur.pn * tstepB;
    S.a_ready(cur);
    if constexpr (SP2) {
        PG8_STAGE(PG8_SB(0, 0), cB, voffB); PG8_STAGE(PG8_SB(0, 1), cB + hstepB, voffB); PG8_STAGE(PG8_SA(0, 0), cA, voffA); PG8_STAGE(PG8_SA(0, 1), cA + hstepA, voffA);
        if (wr == 1) PG8_BAR;
        PG8_WAIT_V(2); PG8_BAR;
        PG8_STAGE(PG8_SB(1, 0), cB + kstep, voffB); PG8_STAGE(PG8_SA(1, 0), cA + kstep, voffA); PG8_STAGE(PG8_SB(1, 1), cB + hstepB + kstep, voffB);
        PG8_WAIT_V(6); PG8_BAR;
    } else {
        PG8_STAGE(PG8_SB(0, 0), cB, voffB); PG8_STAGE(PG8_SA(0, 0), cA, voffA); PG8_STAGE(PG8_SB(0, 1), cB + hstepB, voffB); PG8_STAGE(PG8_SA(0, 1), cA + hstepA, voffA);
        if (wr == 1) PG8_BAR;
        PG8_WAIT_V(4); PG8_BAR;
        PG8_STAGE(PG8_SB(1, 0), cB + kstep, voffB); PG8_STAGE(PG8_SA(1, 0), cA + kstep, voffA); PG8_STAGE(PG8_SB(1, 1), cB + hstepB + kstep, voffB);
        PG8_WAIT_V(6); PG8_BAR;
    }
    for (;;) {
        const bool has_next = S.next(ui + 1, nxt);
        const char* nA = has_next ? (const char*)g.A + (size_t)S.arow(nxt) * lda * 2 : cA; const char* nB = has_next ? (const char*)g.Bt + (size_t)nxt.pn * tstepB : cB;
        for (int t = 0; t < nt; t += 2) {
            const bool last = (t == nt - 2);
            const char* a1 = cA + (size_t)(t + 1) * kstep;
            const char* a2 = last ? nA : cA + (size_t)(t + 2) * kstep; const char* b2 = last ? nB : cB + (size_t)(t + 2) * kstep;
            const char* a3 = a2 + kstep; const char* b3 = b2 + kstep;
            if (last && has_next) S.a_ready(nxt);
            if constexpr (SP2) {
            PG8_LDB(B0, 0, 0); PG8_LDB(B1, 0, 1); PG8_SCHED; PG8_LDA(At, 0, 0); PG8_STAGE(PG8_SA(1, 1), a1 + hstepA, voffA);
            PG8_WAIT_V(8); PG8_WAIT_L(0); PG8_BAR; PG8_MMA(0, 0, At, B0); PG8_MMA(0, 1, At, B1); PG8_BAR; PG8_SCHED;
            PG8_LDA(At, 0, 1); PG8_STAGE(PG8_SB(0, 0), b2, voffB); PG8_STAGE(PG8_SB(0, 1), b2 + hstepB, voffB); PG8_STAGE(PG8_SA(0, 0), a2, voffA);
            PG8_WAIT_V(8); PG8_WAIT_L(0); PG8_BAR; PG8_MMA(1, 0, At, B0); PG8_MMA(1, 1, At, B1); PG8_BAR; PG8_SCHED;
            PG8_LDB(B0, 1, 0); PG8_LDB(B1, 1, 1); PG8_SCHED; PG8_LDA(At, 1, 0); PG8_STAGE(PG8_SA(0, 1), a2 + hstepA, voffA);
            PG8_WAIT_V(8); PG8_WAIT_L(0); PG8_BAR; PG8_MMA(0, 0, At, B0); PG8_MMA(0, 1, At, B1); PG8_BAR; PG8_SCHED;
            PG8_LDA(At, 1, 1); PG8_STAGE(PG8_SB(1, 0), b3, voffB); PG8_STAGE(PG8_SB(1, 1), b3 + hstepB, voffB); PG8_STAGE(PG8_SA(1, 0), a3, voffA);
            PG8_WAIT_V(8); PG8_WAIT_L(0); PG8_BAR; PG8_MMA(1, 0, At, B0); PG8_MMA(1, 1, At, B1); PG8_BAR; PG8_SCHED;
            } else {
            PG8_LDB(B0, 0, 0); PG8_SCHED; PG8_LDA(At, 0, 0); PG8_STAGE(PG8_SA(1, 1), a1 + hstepA, voffA);
            PG8_WAIT_L(8); PG8_BAR; PG8_WAIT_L(0); PG8_MMA(0, 0, At, B0); PG8_BAR; PG8_SCHED;
            PG8_LDB(B1, 0, 1); PG8_STAGE(PG8_SB(0, 0), b2, voffB);
            PG8_BAR; PG8_WAIT_L(0); PG8_MMA(0, 1, At, B1); PG8_BAR;
            PG8_LDA(At, 0, 1); PG8_STAGE(PG8_SA(0, 0), a2, voffA);
            PG8_BAR; PG8_WAIT_L(0); PG8_MMA(1, 0, At, B0); PG8_BAR; PG8_SCHED;
            PG8_STAGE(PG8_SB(0, 1), b2 + hstepB, voffB);
            PG8_WAIT_V(6); PG8_BAR; PG8_MMA(1, 1, At, B1); PG8_BAR;
            PG8_LDB(B0, 1, 0); PG8_SCHED; PG8_LDA(At, 1, 0); PG8_STAGE(PG8_SA(0, 1), a2 + hstepA, voffA);
            PG8_WAIT_L(8); PG8_BAR; PG8_WAIT_L(0); PG8_MMA(0, 0, At, B0); PG8_BAR; PG8_SCHED;
            PG8_LDB(B1, 1, 1); PG8_STAGE(PG8_SB(1, 0), b3, voffB);
            PG8_BAR; PG8_WAIT_L(0); PG8_MMA(0, 1, At, B1); PG8_BAR;
            PG8_LDA(At, 1, 1); PG8_STAGE(PG8_SA(1, 0), a3, voffA);
            PG8_BAR; PG8_WAIT_L(0); PG8_MMA(1, 0, At, B0); PG8_BAR; PG8_SCHED;
            PG8_STAGE(PG8_SB(1, 1), b3 + hstepB, voffB);
            PG8_WAIT_V(6); PG8_BAR; PG8_MMA(1, 1, At, B1); PG8_BAR;
            }
        }
        if constexpr (ALIGN_EPI) { if (wr == 0) PG8_BAR; }
        if constexpr (F8) {
            asm volatile("s_nop 15\n\ts_nop 15" : "+v"(acc[0][0][0][0]), "+v"(acc[0][0][0][1]), "+v"(acc[0][0][1][0]), "+v"(acc[0][0][1][1]), "+v"(acc[0][0][2][0]), "+v"(acc[0][0][2][1]), "+v"(acc[0][0][3][0]), "+v"(acc[0][0][3][1]),
                                                  "+v"(acc[0][1][0][0]), "+v"(acc[0][1][0][1]), "+v"(acc[0][1][1][0]), "+v"(acc[0][1][1][1]), "+v"(acc[0][1][2][0]), "+v"(acc[0][1][2][1]), "+v"(acc[0][1][3][0]), "+v"(acc[0][1][3][1]));
            asm volatile("" : "+v"(acc[1][0][0][0]), "+v"(acc[1][0][0][1]), "+v"(acc[1][0][1][0]), "+v"(acc[1][0][1][1]), "+v"(acc[1][0][2][0]), "+v"(acc[1][0][2][1]), "+v"(acc[1][0][3][0]), "+v"(acc[1][0][3][1]),
                              "+v"(acc[1][1][0][0]), "+v"(acc[1][1][0][1]), "+v"(acc[1][1][1][0]), "+v"(acc[1][1][1][1]), "+v"(acc[1][1][2][0]), "+v"(acc[1][1][2][1]), "+v"(acc[1][1][3][0]), "+v"(acc[1][1][3][1])); }
        if constexpr (!Epi::AFTER_DRAIN) { E(acc, cur, wr, wc, fr, fq); S.done(cur); }
        if (!has_next) break;
#pragma unroll
        for (int a = 0; a < 2; ++a)
#pragma unroll
            for (int b = 0; b < 2; ++b)
#pragma unroll
                for (int m = 0; m < 4; ++m)
#pragma unroll
                    for (int n = 0; n < 2; ++n) acc[a][b][m][n] = (f32x4){0.f, 0.f, 0.f, 0.f};
        cur = nxt; cA = nA; cB = nB; ++ui;
        if constexpr (ALIGN_EPI) { if (wr == 1) PG8_BAR; }
    }
    PG8_WAIT_V(0);
    if constexpr (!ALIGN_EPI) { if (wr == 0) PG8_BAR; }
    PG8_BAR;
    if constexpr (Epi::AFTER_DRAIN) { E.fused(acc, cur, wr, wc, fr, fq, lds, wid, lane); S.done(cur); }
#undef PG8_SA
#undef PG8_SB
#undef PG8_STAGE
#undef PG8_LDA
#undef PG8_LD8
#undef PG8_LDB
#undef PG8_MMA
#undef PG8_WAIT_V
#undef PG8_WAIT_L
#undef PG8_BAR
#undef PG8_SCHED
}
}

#ifndef PG8_SP2
#define PG8_SP2 true
#endif
#ifndef PG8_ALIGN
#define PG8_ALIGN true
#endif
#include <cmath>

constexpr int NWAVES = 8;
constexpr int NPH = 11;
#ifndef MK_N_LAUNCHES
#define MK_N_LAUNCHES 1
#endif
constexpr int N_LAUNCHES = MK_N_LAUNCHES;
static_assert(N_LAUNCHES == 1 || N_LAUNCHES == NPH, "MK_N_LAUNCHES is 1 or NPH");

constexpr int BATCH = 2, SEQ = 4096, DM = 2048, M = BATCH * SEQ;
constexpr int AH = 16, HD = 64, AW = AH * HD;
constexpr int SG = 64, SC = 16, SW = SG * SC, SP = 64;
constexpr int INC = 3 * AW + SW;
constexpr int MOBA_BLK = 256, NBLK = SEQ / MOBA_BLK, TOPK = 3;
constexpr int DFF = 5632, DFF2 = 2 * DFF;
constexpr float RMS_EPS = 1e-6f;
constexpr float LOG2E = 1.4426950408889634f;
constexpr float WSCALE = 64.0f;
constexpr float C2 = 0.125f * LOG2E;

constexpr size_t MiB = 1u << 20;
constexpr size_t WS_CTL = 0, CTL_ZERO_BYTES = 1 * MiB;
constexpr size_t WS_WDOWN = 1 * MiB;
constexpr size_t WS_WIN = 23 * MiB;
constexpr size_t WS_WGLU = 39 * MiB;
constexpr size_t WS_WOUT = 41 * MiB;
constexpr size_t WS_WUP = 49 * MiB;
constexpr size_t WS_XN = 93 * MiB;
constexpr size_t WS_Q = 125 * MiB, WS_K = 141 * MiB, WS_V = 157 * MiB;
constexpr size_t WS_Y = 173 * MiB, WS_Z = 189 * MiB;
constexpr size_t WS_A2 = 205 * MiB, WS_S = 225 * MiB, WS_BTS = 233 * MiB, WS_BT2 = 249 * MiB;
constexpr size_t WS_X1G = 289 * MiB;
constexpr size_t WS_SSQ = 321 * MiB;
constexpr size_t WS_KMEAN = 322 * MiB;
constexpr size_t WS_T5B = 323 * MiB;
constexpr size_t WS_ACT = 125 * MiB;
constexpr size_t WS_END = 324 * MiB;
static_assert(WS_ACT + (size_t)M * DFF * 2 <= WS_X1G && WS_BT2 + (size_t)SG * 512 * 640 * 2 <= WS_X1G && WS_WUP + (size_t)DFF2 * DM * 2 <= WS_XN, "d_ws map");
constexpr int CW_TMO = 0, CW_CODE = 1;
constexpr int CW_BAR = 4096;

constexpr int RING_OFF = 0, RING_BYTES = 131072;
constexpr int LDSCTL_OFF = RING_BYTES, MISC_OFF = LDSCTL_OFF + 320, XL_OFF = MISC_OFF + 128, XL_BYTES = 9216;
constexpr int LDS_BYTES = 147456;
static_assert(XL_OFF % 16 == 0 && XL_OFF + XL_BYTES <= LDS_BYTES, "LDS map");

#include <hip/hip_bf16.h>
#include <cmath>
namespace attn_body {
using bf16=__hip_bfloat16;
using bf16x8=__attribute__((ext_vector_type(8)))short;
using s16x4=__attribute__((ext_vector_type(4)))short;
using f32x16=__attribute__((ext_vector_type(16)))float;
using u32x4=__attribute__((ext_vector_type(4)))unsigned;
using f32x4_=__attribute__((ext_vector_type(4)))float;
constexpr int BATCH=2,NHEAD=16,SEQ=4096,D=64,DM=NHEAD*D;
constexpr int NW=8,QBLK=32,QB=QBLK*NW,KVBLK=64,NQB=SEQ/QB;
constexpr int ATTN_PITCH=DM, ATTN_UNIT_ROWS=QB;
__device__ __forceinline__ int crow(int r,int hi){return (r&3)+8*(r>>2)+4*hi;}
#define SBAR() __builtin_amdgcn_sched_barrier(0)
__device__ __forceinline__ void cmask(f32x16&p0,f32x16&p1,int jb,int qrel,int hi){
  const float NEG=-INFINITY; int kb=64*jb+4*hi;
  #pragma unroll
  for(int r=0;r<16;++r){int kv=kb+(r&3)+8*(r>>2); if(kv>qrel)p0[r]=NEG; if(kv+32>qrel)p1[r]=NEG;}
}

typedef __attribute__((address_space(3))) const float* lds_cfptr;
__device__ __forceinline__ void abias(f32x16&p0,f32x16&p1,int jb,int qrel,int hi,int wid,lds_cfptr Tp){
  if(32*wid-64*jb-63>=113)return;
  const lds_cfptr tb=Tp+(255-59+qrel-64*jb-4*hi);
  #pragma unroll
  for(int r=0;r<16;++r){ p0[r]+=tb[59-((r&3)+8*(r>>2))]; p1[r]+=tb[27-((r&3)+8*(r>>2))]; }
}
constexpr int NSLOT=3, SLOTB=8192;
constexpr int LDS_K=0, LDS_V=NSLOT*SLOTB, LDS_WS=2*NSLOT*SLOTB, LDS_OST=LDS_WS+NW*64*4, LDS_KM=LDS_OST+NW*4096, LDS_BIAS=LDS_KM+4096, LDS_BYTES=LDS_BIAS+2560;
constexpr float C2=0.125f*1.4426950408889634f;
__device__ __forceinline__ void glds16(const void*gsrc,unsigned lds_dst){unsigned keep;
  asm volatile("s_mov_b32 %0, m0\n\ts_mov_b32 m0, %2\n\ts_nop 0\n\tglobal_load_lds_dwordx4 %1, off\n\ts_mov_b32 m0, %0":"=&s"(keep):"v"(gsrc),"s"(lds_dst):"memory");}
__device__ __forceinline__ float max3f(float a,float b,float c){float r;asm("v_max3_f32 %0, %1, %2, %3":"=v"(r):"v"(a),"v"(b),"v"(c));return r;}
__device__ __forceinline__ float max2f(float a,float b){float r;asm("v_max_f32_e32 %0, %1, %2":"=v"(r):"v"(a),"v"(b));return r;}
__device__ __forceinline__ float fadd_s(float a,float b){float r;asm("v_add_f32_e32 %0, %1, %2":"=v"(r):"v"(a),"v"(b));return r;}
__device__ __forceinline__ float fsub_s(float a,float b){float r;asm("v_sub_f32_e32 %0, %1, %2":"=v"(r):"v"(a),"v"(b));return r;}
typedef float f32x2_t __attribute__((ext_vector_type(2))); typedef __bf16 bf16x2_t __attribute__((ext_vector_type(2)));
__device__ __forceinline__ unsigned cvtpk_s(float lo,float hi){f32x2_t v={lo,hi};bf16x2_t b=__builtin_convertvector(v,bf16x2_t);return __builtin_bit_cast(unsigned,b);}
#define WAIT_BAR(N) asm volatile("s_waitcnt vmcnt(" #N ") lgkmcnt(0)\n\ts_barrier":::"memory")

__device__ __forceinline__ void qkt(f32x16&p0,f32x16&p1,const char*Kslot,const bf16x8*qr,const f32x16&negm,int r32,int hi){
  const char*kb=Kslot+hi*1024+r32*16;
  #pragma unroll
  for(int d0=0;d0<4;++d0){
    const bf16x8 b0=*reinterpret_cast<const bf16x8*>(kb+d0*2048);
    const bf16x8 b1=*reinterpret_cast<const bf16x8*>(kb+d0*2048+512);
    if(d0==0){p0=__builtin_amdgcn_mfma_f32_32x32x16_bf16(b0,qr[0],negm,0,0,0);p1=__builtin_amdgcn_mfma_f32_32x32x16_bf16(b1,qr[0],negm,0,0,0);}
    else{p0=__builtin_amdgcn_mfma_f32_32x32x16_bf16(b0,qr[d0],p0,0,0,0);p1=__builtin_amdgcn_mfma_f32_32x32x16_bf16(b1,qr[d0],p1,0,0,0);}}
}
typedef __attribute__((address_space(3))) const char* lds_cptr;
typedef short v4i16_t __attribute__((ext_vector_type(4)));
__device__ __forceinline__ void kload8(bf16x8*kf,lds_cptr kp){
  kf[0]=*(const __attribute__((address_space(3))) bf16x8*)(kp);      kf[1]=*(const __attribute__((address_space(3))) bf16x8*)(kp+512);
  kf[2]=*(const __attribute__((address_space(3))) bf16x8*)(kp+2048); kf[3]=*(const __attribute__((address_space(3))) bf16x8*)(kp+2560);
  kf[4]=*(const __attribute__((address_space(3))) bf16x8*)(kp+4096); kf[5]=*(const __attribute__((address_space(3))) bf16x8*)(kp+4608);
  kf[6]=*(const __attribute__((address_space(3))) bf16x8*)(kp+6144); kf[7]=*(const __attribute__((address_space(3))) bf16x8*)(kp+6656);
}
__device__ __forceinline__ void kload2(bf16x8*kf,lds_cptr kp,int j){ kf[2*j]=*(const __attribute__((address_space(3))) bf16x8*)(kp+j*2048); kf[2*j+1]=*(const __attribute__((address_space(3))) bf16x8*)(kp+j*2048+512); }
__device__ __forceinline__ s16x4 vtr(lds_cptr p){ return __builtin_bit_cast(s16x4,__builtin_amdgcn_ds_read_tr16_b64_v4i16((__attribute__((address_space(3))) v4i16_t*)p)); }
__device__ __forceinline__ float rowmax(const f32x16&p0,const f32x16&p1){
  float a=max3f(p0[0],p0[1],p1[0]),b=max3f(p0[2],p0[3],p1[1]);a=max3f(a,p1[2],p1[3]);
  #pragma unroll
  for(int r=4;r<16;r+=4){a=max3f(a,p0[r],p0[r+1]);b=max3f(b,p0[r+2],p0[r+3]);a=max3f(a,p1[r],p1[r+1]);b=max3f(b,p1[r+2],p1[r+3]);}
  const float m=max2f(a,b);
  auto rr=__builtin_amdgcn_permlane32_swap(__float_as_uint(m),__float_as_uint(m),false,false);
  return max2f(__uint_as_float(rr[0]),__uint_as_float(rr[1]));
}
__device__ __forceinline__ void pv(f32x16*o,int vb,bf16x8 pa0,bf16x8 pa1,bf16x8 pa2,bf16x8 pa3){
  #pragma unroll
  for(int d0=0;d0<2;++d0){s16x4 lo[4],hi[4];
    #pragma unroll
    for(int ks=0;ks<4;++ks){
      asm volatile("ds_read_b64_tr_b16 %0,%1 offset:%c2":"=&v"(lo[ks]):"v"(vb),"i"(d0*4096+ks*1024):"memory");
      asm volatile("ds_read_b64_tr_b16 %0,%1 offset:%c2":"=&v"(hi[ks]):"v"(vb),"i"(d0*4096+ks*1024+512):"memory");}
    asm volatile("s_waitcnt lgkmcnt(0)":::"memory");SBAR();
    #define PK(k) (bf16x8){lo[k][0],lo[k][1],lo[k][2],lo[k][3],hi[k][0],hi[k][1],hi[k][2],hi[k][3]}
    o[d0]=__builtin_amdgcn_mfma_f32_32x32x16_bf16(pa0,PK(0),o[d0],0,0,0);
    o[d0]=__builtin_amdgcn_mfma_f32_32x32x16_bf16(pa1,PK(1),o[d0],0,0,0);
    o[d0]=__builtin_amdgcn_mfma_f32_32x32x16_bf16(pa2,PK(2),o[d0],0,0,0);
    o[d0]=__builtin_amdgcn_mfma_f32_32x32x16_bf16(pa3,PK(3),o[d0],0,0,0);
    #undef PK
  }
}

#ifndef ATTN_STORE16
#define ATTN_STORE16(p,v) (*(u32x4*)(p)=(v))
#endif
template<int THRL> __device__ __forceinline__ void attn_unit(int b,int h,int qb,const bf16*Q,const bf16*__restrict__ K,const bf16*__restrict__ V,bf16*O,const float*KM,const float*TB,char*shm){
  int tid_=threadIdx.x; asm volatile("":"+v"(tid_));
  const int tid=tid_,lane=tid&63,r32=lane&31,hi=lane>>5; const int wid=__builtin_amdgcn_readfirstlane(tid>>6);
  const long rowbase=(long)b*SEQ; const int q0=qb*QB;
  const bf16*Qw=Q+(rowbase+q0+wid*QBLK)*DM+h*D;
  const bf16*Kh=K+rowbase*DM+h*D,*Vh=V+rowbase*DM+h*D;
  const unsigned lds0=(unsigned)(uintptr_t)shm;
  float*wsf=(float*)(shm+LDS_WS)+wid*64;
  const bf16*ksrc=Kh+(long)lane*DM+wid*8;
  const bf16*vsrc=Vh+(long)(16*(wid&3)+(lane>>2))*DM+(wid>>2)*32+(lane&3)*8;
  const unsigned kdst=lds0+LDS_K+wid*1024, vdst=lds0+LDS_V+wid*1024;
  #define DMA_K(t,slot) glds16(ksrc+(long)(t)*KVBLK*DM,(unsigned)__builtin_amdgcn_readfirstlane(kdst+(slot)))
  #define DMA_V(t,slot) glds16(vsrc+(long)(t)*KVBLK*DM,(unsigned)__builtin_amdgcn_readfirstlane(vdst+(slot)))
  const int vb0=(int)(lds0+LDS_V)+((lane>>4)&1)*32+(lane&3)*8+(4*hi+((lane&15)>>2))*64;
  const char*Kbase=shm+LDS_K; bf16x8 kf[8];
  const lds_cptr shm3=(lds_cptr)shm; const lds_cptr kp0=shm3+LDS_K+hi*1024+r32*16; const lds_cptr vp0=shm3+LDS_V+((lane>>4)&1)*32+(lane&3)*8+(4*hi+((lane&15)>>2))*64;
  const int NT=(q0+QB)/KVBLK;
  DMA_K(0,0);DMA_V(0,0);DMA_K(1,SLOTB);
  bf16x8 qr[4];
  #pragma unroll
  for(int d0=0;d0<4;++d0)qr[d0]=*reinterpret_cast<const bf16x8*>(&Qw[(long)r32*DM+d0*16+hi*8]);
  { typedef float f32x2_ __attribute__((ext_vector_type(2))); int tid2=tid; asm volatile("":"+v"(tid2));
    *(__attribute__((address_space(3))) f32x2_*)((__attribute__((address_space(3))) char*)shm3+LDS_KM+tid2*8)=*(const f32x2_*)(KM+tid2*2);
    for(int i_=tid2;i_<640;i_+=512){ const int d_=i_-255; *(__attribute__((address_space(3))) float*)((__attribute__((address_space(3))) char*)shm3+LDS_BIAS+i_*4)=(d_>=0&&d_<128)?TB[d_]-TB[511]:0.f; } }
  const lds_cfptr Tb=(lds_cfptr)(shm3+LDS_BIAS);
  float mhat=0.f,l_reg=0.f;f32x16 o[2];o[0]=f32x16{};o[1]=f32x16{};f32x16 negm=f32x16{};asm volatile("":"+v"(negm));
  unsigned selm=1u<<qb;
  #define NEGM_SET(tn) do{ const float cv_=((selm>>((tn)>>2))&1u)?-mhat:-INFINITY; _Pragma("unroll") for(int r=0;r<16;++r)negm[r]=cv_; asm volatile("":"+v"(negm)); }while(0)
  const int qrel=wid*QBLK+r32;
  #define CMASK(P0,P1,t) do{int jb_=(t)-(NT-4); if(jb_>=-2){int q2_=qrel,h2_=hi; asm volatile("":"+v"(q2_),"+v"(h2_)); abias(P0,P1,jb_,q2_,h2_,wid,Tb);} if(jb_>=0)cmask(P0,P1,jb_,qrel,hi);}while(0)
  bool resc=false;
  #define START(P0,P1) do{ const float rm=rowmax(P0,P1); resc=false; \
    { const float dl=(rm>-1e30f)?rm:0.f; mhat=fadd_s(mhat,dl); \
      _Pragma("unroll") for(int r=0;r<16;++r){P0[r]=fsub_s(P0[r],dl);P1[r]=fsub_s(P1[r],dl);} \
      NEGM_SET(1); } \
    _Pragma("unroll") for(int r=0;r<16;++r)P0[r]=__builtin_amdgcn_exp2f(P0[r]); }while(0)
  #define RESC() do{ if(resc){ asm volatile("s_waitcnt lgkmcnt(0)":::"memory"); \
      _Pragma("unroll") for(int d_=0;d_<2;++d_) _Pragma("unroll") for(int r=0;r<16;++r)o[d_][r]*=wsf[crow(r,hi)]; } }while(0)
  f32x16 pA0,pA1,pB0,pB1;
  int sl_prev=0,sl_cur=0,sl_next=SLOTB;
  #define ROT() do{sl_prev=sl_cur;sl_cur=sl_next;sl_next=(sl_next==(NSLOT-1)*SLOTB)?0:sl_next+SLOTB;}while(0)
  DMA_K(2,2*SLOTB);
  WAIT_BAR(3);
  { float qf[32]; int hi2=hi; asm volatile("":"+v"(hi2));
    #pragma unroll
    for(int d0=0;d0<4;++d0)
      #pragma unroll
      for(int j=0;j<8;++j)qf[d0*8+j]=__uint_as_float(((unsigned)(unsigned short)qr[d0][j])<<16);
    float v1=-INFINITY,v2=-INFINITY,v3=-INFINITY; int i1=-1,i2=-1,i3=-1;
    const __attribute__((address_space(3))) float* kml=(const __attribute__((address_space(3))) float*)(shm3+LDS_KM)+8*hi2;
    for(int n=0;n<qb;++n){ float a=0.f;
      #pragma unroll
      for(int d0=0;d0<4;++d0){ const f32x4_ k0=*(const __attribute__((address_space(3))) f32x4_*)(kml+n*64+16*d0), k1=*(const __attribute__((address_space(3))) f32x4_*)(kml+n*64+16*d0+4);
        a+=qf[d0*8+0]*k0[0]+qf[d0*8+1]*k0[1]+qf[d0*8+2]*k0[2]+qf[d0*8+3]*k0[3]+qf[d0*8+4]*k1[0]+qf[d0*8+5]*k1[1]+qf[d0*8+6]*k1[2]+qf[d0*8+7]*k1[3]; }
      { auto rr=__builtin_amdgcn_permlane32_swap(__float_as_uint(a),__float_as_uint(a),false,false); a=__uint_as_float(rr[0])+__uint_as_float(rr[1]); }
      if(a>v1){v3=v2;i3=i2;v2=v1;i2=i1;v1=a;i1=n;} else if(a>v2){v3=v2;i3=i2;v2=a;i2=n;} else if(a>v3){v3=a;i3=n;} }
    if(i1>=0)selm|=1u<<i1; if(i2>=0)selm|=1u<<i2; if(i3>=0)selm|=1u<<i3; }
  NEGM_SET(0);
  qkt(pA0,pA1,Kbase,qr,negm,r32,hi);asm volatile("s_nop 15\n\ts_nop 7":"+v"(pA0),"+v"(pA1));CMASK(pA0,pA1,0);
  START(pA0,pA1);
  _Pragma("unroll") for(int r=0;r<16;++r)pA1[r]=__builtin_amdgcn_exp2f(pA1[r]);
  WAIT_BAR(0);
  DMA_K(3,0);DMA_V(1,SLOTB);
  ROT();
  kload8(kf,kp0+sl_cur);
  WAIT_BAR(2);
  s16x4 vlo[8],vhi[8]; u32x4 pw0,pw1,pw2,pw3;
  #define PKW(P,B) cvtpk_s(P[B],P[B+1])
  #define PAF(k) __builtin_bit_cast(bf16x8,pw##k)
  #define VFR(i) (bf16x8){vlo[i][0],vlo[i][1],vlo[i][2],vlo[i][3],vhi[i][0],vhi[i][1],vhi[i][2],vhi[i][3]}
  #define PIN(x) asm volatile("":"+v"(x))
  #define MX3(a,b,c) __builtin_fmaxf(__builtin_fmaxf((a),(b)),(c))
  #define GAPA(MF,A0,A1,A2,A3,W0,W1,PW) do{ MF; sacc+=A0; sacc+=A1; sacc+=A2; sacc+=A3; PIN(sacc); W0; W1; PIN(PW); SBAR(); }while(0)
  #define EX(v) __builtin_amdgcn_exp2f(v)
  #define GAPB(MF,X,B) do{ MF; X[B]=EX(X[B]); X[B+1]=EX(X[B+1]); X[B+2]=EX(X[B+2]); X[B+3]=EX(X[B+3]); PIN(X); SBAR(); }while(0)
  #define VRD(i) do{ vlo[i]=vtr(vp_+(((i)>>2)*4096+((i)&3)*1024)); vhi[i]=vtr(vp_+(((i)>>2)*4096+((i)&3)*1024+512)); }while(0)
  #define KRD(G,j) do{ if(G){ kload2(kf,kp0+sl_next,j); SBAR(); } }while(0)
  #define STEP(C0,C1,P0,P1,t,GK,GV,GL) do{ SBAR(); \
    const lds_cptr vp_=vp0+sl_prev; \
    VRD(0); SBAR(); float sacc=(P0[0]+P0[1]); \
    GAPA(C0=__builtin_amdgcn_mfma_f32_32x32x16_bf16(kf[0],qr[0],negm,0,0,0), P0[2],P0[3],P0[4],P0[5],     pw0[0]=PKW(P0,0), pw0[1]=PKW(P0,2), pw0); \
    VRD(4); SBAR(); GAPA(C1=__builtin_amdgcn_mfma_f32_32x32x16_bf16(kf[1],qr[0],negm,0,0,0), P0[6],P0[7],P0[8],P0[9],     pw0[2]=PKW(P0,4), pw0[3]=PKW(P0,6), pw0); \
    VRD(1); SBAR(); GAPA(C0=__builtin_amdgcn_mfma_f32_32x32x16_bf16(kf[2],qr[1],C0,0,0,0),   P0[10],P0[11],P0[12],P0[13], pw1[0]=PKW(P0,8), pw1[1]=PKW(P0,10), pw1); \
    VRD(5); SBAR(); GAPA(C1=__builtin_amdgcn_mfma_f32_32x32x16_bf16(kf[3],qr[1],C1,0,0,0),   P0[14],P0[15],P1[0],P1[1],   pw1[2]=PKW(P0,12),pw1[3]=PKW(P0,14), pw1); \
    VRD(2); SBAR(); GAPA(C0=__builtin_amdgcn_mfma_f32_32x32x16_bf16(kf[4],qr[2],C0,0,0,0),   P1[2],P1[3],P1[4],P1[5],     pw2[0]=PKW(P1,0), pw2[1]=PKW(P1,2), pw2); \
    VRD(6); SBAR(); GAPA(C1=__builtin_amdgcn_mfma_f32_32x32x16_bf16(kf[5],qr[2],C1,0,0,0),   P1[6],P1[7],P1[8],P1[9],     pw2[2]=PKW(P1,4), pw2[3]=PKW(P1,6), pw2); \
    VRD(3); SBAR(); GAPA(C0=__builtin_amdgcn_mfma_f32_32x32x16_bf16(kf[6],qr[3],C0,0,0,0),   P1[10],P1[11],P1[12],P1[13], pw3[0]=PKW(P1,8), pw3[1]=PKW(P1,10), pw3); \
    VRD(7); SBAR(); GAPA(C1=__builtin_amdgcn_mfma_f32_32x32x16_bf16(kf[7],qr[3],C1,0,0,0),   P1[14],P1[15],0.f,0.f,       pw3[2]=PKW(P1,12),pw3[3]=PKW(P1,14), pw3); \
    l_reg+=sacc; \
    if(GK){DMA_K((t)+3,sl_cur);} if(GV){DMA_V((t)+1,sl_next);} \
    CMASK(C0,C1,t); \
    { float a=MX3(C0[0],C0[1],C1[0]),b=MX3(C0[2],C0[3],C1[1]); a=MX3(a,C1[2],C1[3]); \
      _Pragma("unroll") for(int r=4;r<16;r+=4){a=MX3(a,C0[r],C0[r+1]);b=MX3(b,C0[r+2],C0[r+3]);a=MX3(a,C1[r],C1[r+1]);b=MX3(b,C1[r+2],C1[r+3]);} \
      float rm=__builtin_fmaxf(a,b); { auto rr=__builtin_amdgcn_permlane32_swap(__float_as_uint(rm),__float_as_uint(rm),false,false); rm=__builtin_fmaxf(__uint_as_float(rr[0]),__uint_as_float(rr[1])); } \
      resc=false; \
      if(__builtin_expect(__any(rm>(float)THRL),0)){ const float dl=__builtin_fmaxf(rm,0.f); mhat+=dl; \
        _Pragma("unroll") for(int r=0;r<16;++r){C0[r]-=dl;C1[r]-=dl;} \
        const float f=__builtin_amdgcn_exp2f(-dl); l_reg*=f; if(hi==0)wsf[r32]=f; resc=true; } \
      if(resc||((((t)+1)&3)==0)){ NEGM_SET((t)+1); } } \
    SBAR(); \
    GAPB(o[0]=__builtin_amdgcn_mfma_f32_32x32x16_bf16(PAF(0),VFR(0),o[0],0,0,0), C0,0); \
    GAPB(o[1]=__builtin_amdgcn_mfma_f32_32x32x16_bf16(PAF(0),VFR(4),o[1],0,0,0), C0,4); \
    KRD(GL,0); GAPB(o[0]=__builtin_amdgcn_mfma_f32_32x32x16_bf16(PAF(1),VFR(1),o[0],0,0,0), C0,8); \
    KRD(GL,1); GAPB(o[1]=__builtin_amdgcn_mfma_f32_32x32x16_bf16(PAF(1),VFR(5),o[1],0,0,0), C0,12); \
    KRD(GL,2); GAPB(o[0]=__builtin_amdgcn_mfma_f32_32x32x16_bf16(PAF(2),VFR(2),o[0],0,0,0), C1,0); \
    KRD(GL,3); GAPB(o[1]=__builtin_amdgcn_mfma_f32_32x32x16_bf16(PAF(2),VFR(6),o[1],0,0,0), C1,4); \
    GAPB(o[0]=__builtin_amdgcn_mfma_f32_32x32x16_bf16(PAF(3),VFR(3),o[0],0,0,0), C1,8); \
    GAPB(o[1]=__builtin_amdgcn_mfma_f32_32x32x16_bf16(PAF(3),VFR(7),o[1],0,0,0), C1,12); \
    }while(0)
  int t=1;
  #undef CMASK
  #define CMASK(P0,P1,t) do{}while(0)
  for(;t+7<NT;t+=2){
    STEP(pB0,pB1,pA0,pA1,t,true,true,true);     WAIT_BAR(2); RESC(); ROT();
    STEP(pA0,pA1,pB0,pB1,t+1,true,true,true);   WAIT_BAR(2); RESC(); ROT();
  }
  #undef CMASK
  #define CMASK(P0,P1,t) do{int jb_=(t)-(NT-4); if(jb_>=-2){int q2_=qrel,h2_=hi; asm volatile("":"+v"(q2_),"+v"(h2_)); abias(P0,P1,jb_,q2_,h2_,wid,Tb);} if(jb_>=0)cmask(P0,P1,jb_,qrel,hi);}while(0)
  #define ENDW(tt) do{ if((tt)+3<NT){WAIT_BAR(2);} else if((tt)+2<NT){WAIT_BAR(1);} else {WAIT_BAR(0);} }while(0)
  for(;t+1<NT;t+=2){
    STEP(pB0,pB1,pA0,pA1,t,(t+3<NT),(t+1<NT),(t+1<NT));       ENDW(t);   RESC(); ROT();
    STEP(pA0,pA1,pB0,pB1,t+1,(t+4<NT),(t+2<NT),(t+2<NT));     ENDW(t+1); RESC(); ROT();
  }
  STEP(pB0,pB1,pA0,pA1,NT-1,false,false,false); RESC();
  { float sacc=pB0[0]+pB0[1]; _Pragma("unroll") for(int r=2;r<16;++r)sacc+=pB0[r]; _Pragma("unroll") for(int r=0;r<16;++r)sacc+=pB1[r]; l_reg+=sacc;
    pw0=(u32x4){PKW(pB0,0),PKW(pB0,2),PKW(pB0,4),PKW(pB0,6)};pw1=(u32x4){PKW(pB0,8),PKW(pB0,10),PKW(pB0,12),PKW(pB0,14)};pw2=(u32x4){PKW(pB1,0),PKW(pB1,2),PKW(pB1,4),PKW(pB1,6)};pw3=(u32x4){PKW(pB1,8),PKW(pB1,10),PKW(pB1,12),PKW(pB1,14)};
    SBAR(); pv(o,vb0+sl_cur,PAF(0),PAF(1),PAF(2),PAF(3)); }
  #undef PKW
  #undef PAF
  #undef VFR
  #undef PIN
  #undef MX3
  #undef GAPA
  #undef GAPB
  #undef EX
  #undef VRD
  #undef KRD
  #undef STEP
  #undef ENDW
  {auto rr=__builtin_amdgcn_permlane32_swap(__float_as_uint(l_reg),__float_as_uint(l_reg),false,false);l_reg=__uint_as_float(rr[0])+__uint_as_float(rr[1]);}
  if(hi==0)wsf[32+r32]=l_reg;asm volatile("s_waitcnt lgkmcnt(0)":::"memory");
  float rli[16];
  #pragma unroll
  for(int r=0;r<16;++r)rli[r]=__builtin_amdgcn_rcpf(wsf[32+crow(r,hi)]);
  bf16*Ow=O+(rowbase+q0+wid*QBLK)*DM+h*D;
  { bf16*stg=(bf16*)(shm+LDS_OST)+wid*2048;
    #pragma unroll
    for(int r=0;r<16;++r){const int orow=crow(r,hi);
      #pragma unroll
      for(int d0=0;d0<2;++d0)stg[orow*64+d0*32+r32]=__float2bfloat16(o[d0][r]*rli[r]);}
    asm volatile("s_waitcnt lgkmcnt(0)":::"memory");
    #pragma unroll
    for(int i=0;i<4;++i){const int row=i*8+(lane>>3),ch=lane&7; const u32x4 v=*(const u32x4*)(stg+row*64+ch*8); ATTN_STORE16(Ow+(long)row*DM+ch*8,v);} }
  asm volatile("s_waitcnt lgkmcnt(0)\n\ts_barrier":::"memory");
  #undef DMA_K
  #undef DMA_V
  #undef CMASK
  #undef START
  #undef RESC
  #undef ROT
  #undef NEGM_SET
}
constexpr int ATTN_LDS_BYTES=LDS_BYTES;
struct AttnTensors { const bf16* Q; const bf16* K; const bf16* V; bf16* O; const float* KM; const float* TB; };
struct AttnUnit { int bh; int qb; };
struct StaticOrder {
  int vcu,G;
  __device__ __forceinline__ explicit StaticOrder(int grid,int block):vcu((grid%8==0)?(block%8)*(grid/8)+block/8:block),G(grid){}
  __device__ __forceinline__ bool next(int i,AttnUnit&u)const{ const int p=vcu+(i>>1)*G; if(p>=BATCH*NHEAD*8)return false; const int s=p&7; u.bh=p>>3; u.qb=(i&1)?15-s:s; return true; }
  __device__ __forceinline__ void a_ready(const AttnUnit&)const{}
  __device__ __forceinline__ void done(const AttnUnit&)const{}
};
template<class Sched,int THRL=8> __device__ __forceinline__ void attn_phase(char*lds,const AttnTensors&T,const Sched&S){
  AttnUnit u;
  for(int i=0;S.next(i,u);++i){ S.a_ready(u); attn_unit<THRL>(u.bh/NHEAD,u.bh%NHEAD,u.qb,T.Q,T.K,T.V,T.O,T.KM+(size_t)u.bh*(16*64),T.TB+(u.bh%NHEAD)*512,lds); S.done(u); }
}
#undef SBAR
#undef WAIT_BAR
}
#define GAS __attribute__((address_space(1)))
#define LAS __attribute__((address_space(3)))
typedef unsigned short bf16;
typedef unsigned v4u __attribute__((ext_vector_type(4)));
typedef unsigned v2u __attribute__((ext_vector_type(2)));
typedef float f32x4 __attribute__((ext_vector_type(4)));
typedef short bf16x8 __attribute__((ext_vector_type(8)));
typedef GAS unsigned gu32;
typedef GAS unsigned long long gu64;
#define RLX_AGENT __ATOMIC_RELAXED, __HIP_MEMORY_SCOPE_AGENT
#define LDS_WAIT() asm volatile("s_waitcnt lgkmcnt(0)" ::: "memory")
#define VM_WAIT() asm volatile("s_waitcnt vmcnt(0)" ::: "memory")
__device__ __forceinline__ unsigned long long rt() { return __builtin_amdgcn_s_memrealtime(); }
__device__ __forceinline__ unsigned f2bf(float f) { unsigned u = __builtin_bit_cast(unsigned, f); return (u + 0x7fffu + ((u >> 16) & 1u)) >> 16; }
__device__ __forceinline__ unsigned pk2(float lo, float hi) { return f2bf(lo) | (f2bf(hi) << 16); }

#define XB_TMO      128
#define XB_XCNT(j)  (256  + 64 * (j))
#define XB_XSUB(j)  (1280 + 64 * (j))
#define XB_XGEN(j)  (2304 + 64 * (j))
#define XB_TOP      3328
#define XB_TOPGEN   3392
#define XCD_BAR_WORDS 3456
#define XB_SPIN_CAP (1u << 18)

__device__ __forceinline__ unsigned xb_ld(unsigned* p)              { return __hip_atomic_load(p, __ATOMIC_RELAXED, __HIP_MEMORY_SCOPE_AGENT); }
__device__ __forceinline__ unsigned xb_add(unsigned* p, unsigned v) { return __hip_atomic_fetch_add(p, v, __ATOMIC_RELAXED, __HIP_MEMORY_SCOPE_AGENT); }
__device__ __forceinline__ unsigned xb_xcc_id() { return (unsigned)__builtin_amdgcn_s_getreg((3 << 11) | 20) & 0xFu; }
#define XB_SPIN(cond, bar) do { unsigned _sp = 0; while (cond) { __builtin_amdgcn_s_sleep(1); \
    if ((++_sp & 255u) == 0u) { if (xb_ld(&(bar)[XB_TMO])) break; if (_sp > XB_SPIN_CAP) { atomicAdd(&(bar)[XB_TMO], 1u); break; } } } } while (0)

struct XcdBarrier {
    unsigned* bar; unsigned x;
    volatile LAS unsigned* st;
};

__device__ __forceinline__ XcdBarrier xcd_barrier_post(unsigned* bar, volatile LAS unsigned* st) {
    XcdBarrier b; b.bar = bar; b.x = xb_xcc_id(); b.st = st;
    if (threadIdx.x == 0) (void)xb_add(&bar[XB_XCNT(b.x)], 1u);
    return b;
}
__device__ __forceinline__ void xcd_barrier_complete(unsigned* bar, unsigned x, unsigned& nloc, unsigned& nx) {
    const unsigned G = gridDim.x * gridDim.y * gridDim.z;
    unsigned sum, cnt, mine, sp = 0u;
    for (;;) {
        sum = 0u; cnt = 0u; mine = 0u;
#pragma unroll
        for (unsigned j = 0; j < 16; ++j) { const unsigned c = xb_ld(&bar[XB_XCNT(j)]); sum += c; cnt += (c > 0u) ? 1u : 0u; mine = (j == x) ? c : mine; }
        if (sum == G) break;
        __builtin_amdgcn_s_sleep(1);
        if ((++sp & 255u) == 0u) { if (xb_ld(&bar[XB_TMO])) break; if (sp > XB_SPIN_CAP) { atomicAdd(&bar[XB_TMO], 1u); break; } }
    }
    nloc = mine > 0u ? mine : 1u; nx = cnt > 0u ? cnt : 1u;
}

__device__ __forceinline__ void xcd_barrier(const XcdBarrier& b) {
    asm volatile("s_waitcnt vmcnt(0)" ::: "memory");
    __syncthreads();
    if (threadIdx.x == 0) {
        unsigned* bar = b.bar;
        __builtin_amdgcn_s_waitcnt(0);
        unsigned nloc = b.st[0], nx = b.st[1];
        if (nloc == 0u) { xcd_barrier_complete(bar, b.x, nloc, nx); b.st[0] = nloc; b.st[1] = nx; }
        const unsigned old = xb_add(&bar[XB_XSUB(b.x)], 1u);
        const unsigned gen = old / nloc;
        if (old + 1u == (gen + 1u) * nloc) {
            __builtin_amdgcn_fence(__ATOMIC_RELEASE, "agent");
            asm volatile("s_waitcnt vmcnt(0)" ::: "memory");
            const unsigned og = xb_add(&bar[XB_TOP], 1u);
            const unsigned tg = og / nx;
            if (og + 1u == (tg + 1u) * nx) xb_add(&bar[XB_TOPGEN], 1u);
            else XB_SPIN(xb_ld(&bar[XB_TOPGEN]) == tg, bar);
            __builtin_amdgcn_fence(__ATOMIC_ACQUIRE, "agent");
            xb_add(&bar[XB_XGEN(b.x)], 1u);
            asm volatile("s_waitcnt vmcnt(0)" ::: "memory");
        } else {
            XB_SPIN(xb_ld(&bar[XB_XGEN(b.x)]) == gen, bar);
            __builtin_amdgcn_fence(__ATOMIC_ACQUIRE, "agent");
            asm volatile("s_waitcnt vmcnt(0)" ::: "memory");
        }
    }
    __syncthreads();
}

struct Frame {
    LAS unsigned char* lds;
    volatile LAS unsigned* MISC;
    gu32* ctl;
    int tid, lane, wave;
    int vcu, G;
};
__device__ __forceinline__ float wave_sum(float v) {
#pragma unroll
    for (int o = 1; o < 64; o <<= 1) v += __shfl_xor(v, o);
    return v;
}
__device__ __forceinline__ float wave_max(float v) {
#pragma unroll
    for (int o = 1; o < 64; o <<= 1) v = fmaxf(v, __shfl_xor(v, o));
    return v;
}
__device__ __forceinline__ float bf_lo(unsigned w) { return __uint_as_float(w << 16); }
__device__ __forceinline__ float bf_hi(unsigned w) { return __uint_as_float(w & 0xffff0000u); }
__device__ __forceinline__ float bf2f(bf16 h) { return __uint_as_float((unsigned)h << 16); }

__device__ __forceinline__ void p0_transpose_item(const float* W, int K, int N, bf16* WT, int row_off, LAS float* scr, int item, int lane) {
    const int nblk = N / 32, kb = item / nblk, nb = item % nblk, k0 = 64 * kb, n0 = 32 * nb;
#pragma unroll 8
    for (int i = 0; i < 32; ++i) { const int kk = 2 * i + (lane >> 5); scr[kk * 33 + (lane & 31)] = W[(size_t)(k0 + kk) * N + n0 + (lane & 31)]; }
    LDS_WAIT(); asm volatile("" ::: "memory");
    const int c = lane & 7;
#pragma unroll
    for (int j = 0; j < 4; ++j) { const int n = (lane >> 3) + 8 * j; const LAS float* s = scr + (8 * c) * 33 + n;
        v4u o; o.x = pk2(s[0 * 33], s[1 * 33]); o.y = pk2(s[2 * 33], s[3 * 33]); o.z = pk2(s[4 * 33], s[5 * 33]); o.w = pk2(s[6 * 33], s[7 * 33]);
        *(GAS v4u*)(WT + (size_t)(row_off + n0 + n) * K + k0 + 8 * c) = o; }
    LDS_WAIT(); asm volatile("" ::: "memory");
}
__device__ __forceinline__ unsigned pk4_fp8(float a, float b, float c, float d) { unsigned w = 0u; w = __builtin_amdgcn_cvt_pk_fp8_f32(a, b, w, false); w = __builtin_amdgcn_cvt_pk_fp8_f32(c, d, w, true); return w; }
__device__ __forceinline__ void p0_transpose_item_f8(const float* W, int K, int N, unsigned char* WT, int row_off, float scale, LAS unsigned char* scr, int item, int lane) {
    const int nblk = N / 32, kb = item / nblk, nb = item % nblk, k0 = 128 * kb, n0 = 32 * nb;
#pragma unroll 8
    for (int i = 0; i < 64; ++i) { const int kk = 2 * i + (lane >> 5); const float v = W[(size_t)(k0 + kk) * N + n0 + (lane & 31)] * scale;
        scr[(lane & 31) * 144 + kk] = (unsigned char)(__builtin_amdgcn_cvt_pk_fp8_f32(v, 0.f, 0u, false) & 0xffu); }
    LDS_WAIT(); asm volatile("" ::: "memory");
    const int c = lane & 7;
#pragma unroll
    for (int j = 0; j < 4; ++j) { const int n = (lane >> 3) + 8 * j; const v4u o = *(const LAS v4u*)(scr + n * 144 + 16 * c);
        *(GAS v4u*)(WT + (size_t)(row_off + n0 + n) * K + k0 + 16 * c) = o; }
    LDS_WAIT(); asm volatile("" ::: "memory");
}
__device__ __forceinline__ int up_row(int j) { const int v = j >= DFF, jj = v ? j - DFF : j; return (jj >> 7) * 256 + v * 128 + (jj & 127); }
__device__ __forceinline__ void rms_row_to_bf16(int lane, const float* xrow, const float* g, bf16* orow) {
    const GAS f32x4* xr = (const GAS f32x4*)xrow + lane; const GAS f32x4* gr = (const GAS f32x4*)g + lane;
    f32x4 v[8]; float s = 0.f;
#pragma unroll
    for (int j = 0; j < 8; ++j) { v[j] = xr[64 * j]; s += (v[j].x * v[j].x + v[j].y * v[j].y) + (v[j].z * v[j].z + v[j].w * v[j].w); }
    const float rstd = 1.0f / sqrtf(wave_sum(s) * (1.f / DM) + RMS_EPS);
    GAS unsigned long long* o8 = (GAS unsigned long long*)orow + lane;
#pragma unroll
    for (int j = 0; j < 8; ++j) { const f32x4 gg = gr[64 * j]; const f32x4 o = v[j] * rstd * gg;
        o8[64 * j] = (unsigned long long)pk2(o.x, o.y) | ((unsigned long long)pk2(o.z, o.w) << 32); }
}
__device__ __forceinline__ void rms_row1024_bf16(int lane, const bf16* irow, const float* g, bf16* orow) {
    float v[16]; float s = 0.f;
#pragma unroll
    for (int j = 0; j < 2; ++j) { const v4u w = *((const GAS v4u*)irow + lane + 64 * j);
        v[8 * j + 0] = bf_lo(w.x); v[8 * j + 1] = bf_hi(w.x); v[8 * j + 2] = bf_lo(w.y); v[8 * j + 3] = bf_hi(w.y);
        v[8 * j + 4] = bf_lo(w.z); v[8 * j + 5] = bf_hi(w.z); v[8 * j + 6] = bf_lo(w.w); v[8 * j + 7] = bf_hi(w.w); }
#pragma unroll
    for (int k = 0; k < 16; ++k) s += v[k] * v[k];
    const float rstd = 1.0f / sqrtf(wave_sum(s) * (1.f / 1024.f) + RMS_EPS);
#pragma unroll
    for (int j = 0; j < 2; ++j) { const f32x4 g0 = *((const GAS f32x4*)g + 2 * (lane + 64 * j)), g1 = *((const GAS f32x4*)g + 2 * (lane + 64 * j) + 1);
        v4u o; o.x = pk2(v[8 * j + 0] * rstd * g0.x, v[8 * j + 1] * rstd * g0.y); o.y = pk2(v[8 * j + 2] * rstd * g0.z, v[8 * j + 3] * rstd * g0.w);
        o.z = pk2(v[8 * j + 4] * rstd * g1.x, v[8 * j + 5] * rstd * g1.y); o.w = pk2(v[8 * j + 6] * rstd * g1.z, v[8 * j + 7] * rstd * g1.w);
        *((GAS v4u*)orow + lane + 64 * j) = o; }
}
__device__ __forceinline__ int t5_bucket(int dist) {
    if (dist < 16) return dist;
    const float lr = logf((float)dist / 16.0f) / logf(8.0f) * 16.0f;
    int b = 16 + (int)lr; return b < 31 ? b : 31;
}
__device__ __forceinline__ float gelu_tanh(float y) {
    const float u = 0.7978845608028654f * (y + 0.044715f * y * y * y);
    const float e = __builtin_amdgcn_exp2f(2.0f * LOG2E * u);
    const float th = 1.0f - 2.0f * __builtin_amdgcn_rcpf(e + 1.0f);
    return 0.5f * y * (1.0f + th);
}

struct Args { const float* in[23]; float* out; unsigned char* ws; int ph_lo, ph_hi, li, pad; };
__global__ void __launch_bounds__(NWAVES * 64, 2) skel_fwd(Args args) {
    extern __shared__ __attribute__((aligned(16))) unsigned char lds[];
    Frame F;
    F.lds = (LAS unsigned char*)lds;
    F.MISC = (volatile LAS unsigned*)(F.lds + MISC_OFF);
    F.tid = threadIdx.x; F.lane = F.tid & 63; F.wave = __builtin_amdgcn_readfirstlane(F.tid >> 6);
    F.G = gridDim.x; { const int bx = blockIdx.x; F.vcu = (F.G % 8 == 0) ? (bx % 8) * (F.G / 8) + bx / 8 : bx; }
    unsigned char* ws = args.ws;
    F.ctl = (gu32*)(ws + WS_CTL);
    const float* x = args.in[0]; const float* norm_mix = args.in[1]; const float* w_in = args.in[2]; const float* rel_bias = args.in[3];
    const float* lam_re = args.in[4]; const float* lam_im = args.in[5]; const float* log_dt = args.in[6];
    const float* b_re = args.in[7]; const float* b_im = args.in[8]; const float* c_re = args.in[9]; const float* c_im = args.in[10]; const float* d_skip = args.in[11];
    const float* w_glu = args.in[12]; const float* b_glu = args.in[13]; const float* norm_attn = args.in[14]; const float* norm_ssm = args.in[15];
    const float* w_out = args.in[16]; const float* norm_ffn = args.in[17]; const float* w_up = args.in[18]; const float* conv_w = args.in[19]; const float* conv_b = args.in[20];
    const float* w_down = args.in[21]; const float* norm_final = args.in[22];
    float* out = args.out;
    bf16* Wt_in = (bf16*)(ws + WS_WIN); bf16* Wt_glu = (bf16*)(ws + WS_WGLU); bf16* Wt_out = (bf16*)(ws + WS_WOUT); unsigned char* Wt_up = (unsigned char*)(ws + WS_WUP); unsigned char* Wt_down = (unsigned char*)(ws + WS_WDOWN);
    bf16* XN = (bf16*)(ws + WS_XN); bf16* QB = (bf16*)(ws + WS_Q); bf16* KB = (bf16*)(ws + WS_K); bf16* VB = (bf16*)(ws + WS_V);
    bf16* YB = (bf16*)(ws + WS_Y); bf16* ZB = (bf16*)(ws + WS_Z); unsigned char* X1G = (unsigned char*)(ws + WS_X1G); unsigned char* ACT = (unsigned char*)(ws + WS_ACT);
    float* SSQ = (float*)(ws + WS_SSQ); float* KMEAN = (float*)(ws + WS_KMEAN); float* T5B = (float*)(ws + WS_T5B);
    bf16* A2 = (bf16*)(ws + WS_A2); float* SBUF = (float*)(ws + WS_S); bf16* BTS = (bf16*)(ws + WS_BTS); bf16* BT2 = (bf16*)(ws + WS_BT2);

    for (int u = F.tid; u < (LDS_BYTES - LDSCTL_OFF) / 4; u += NWAVES * 64) ((LAS unsigned*)(F.lds + LDSCTL_OFF))[u] = 0u;
    __syncthreads();
    XcdBarrier bar; bar.bar = (unsigned*)(F.ctl + CW_BAR); bar.x = 0; bar.st = nullptr;
    if (N_LAUNCHES == 1) bar = xcd_barrier_post((unsigned*)(F.ctl + CW_BAR), F.MISC + 8);
#define GRID_BAR() do { if (N_LAUNCHES == 1) xcd_barrier(bar); } while (0)
    const int lo = args.ph_lo, hi = args.ph_hi;
#define IN(k) (lo <= (k) && (k) < hi)
#define BOTH(k) (IN(k) && IN((k) + 1))
    const int gw = F.vcu * NWAVES + F.wave, NGW = F.G * NWAVES;
    const int gt = gw * 64 + F.lane, NGT = NGW * 64;

    if (IN(0)) {
        {
            LAS float* L = (LAS float*)(F.lds + RING_OFF);
            LAS float* pwr = L; LAS float* pwi = pwr + 33 * 65; LAS float* bbr = pwi + 33 * 65; LAS float* bbi = bbr + 1024;
            LAS float* ccr = bbi + 1024; LAS float* cci = ccr + 16 * 65; LAS float* dsk = cci + 16 * 65; LAS float* Kd = dsk + 16;
            for (int it = blockIdx.x; it < SG * 4; it += F.G) {
                const int g = it >> 2, q = it & 3;
                __syncthreads();
                const float dt = expf(log_dt[g]);
                for (int i = F.tid; i < 33 * 64; i += NWAVES * 64) { const int d = i >> 6, p = i & 63; const float lr = lam_re[g * SP + p], li = lam_im[g * SP + p];
                    const float mag = expf(lr * dt * (float)d), ang = li * dt * (float)d; pwr[d * 65 + p] = mag * cosf(ang); pwi[d * 65 + p] = mag * sinf(ang); }
                for (int i = F.tid; i < 64 * 16; i += NWAVES * 64) { const int p = i >> 4; const float lr = lam_re[g * SP + p], li = lam_im[g * SP + p];
                    const float er = expf(lr * dt), lbr = er * cosf(li * dt), lbi = er * sinf(li * dt);
                    const float nr = lbr - 1.0f, ni = lbi, den = lr * lr + li * li, cr_ = (nr * lr + ni * li) / den, ci_ = (ni * lr - nr * li) / den;
                    const float bre = b_re[(size_t)(g * SP) * SC + i], bim = b_im[(size_t)(g * SP) * SC + i];
                    bbr[i] = cr_ * bre - ci_ * bim; bbi[i] = cr_ * bim + ci_ * bre; }
                for (int i = F.tid; i < 16 * 64; i += NWAVES * 64) { const int h = i >> 6, p = i & 63; ccr[h * 65 + p] = c_re[(size_t)(g * SC) * SP + i]; cci[h * 65 + p] = c_im[(size_t)(g * SC) * SP + i]; }
                if (F.tid < 16) dsk[F.tid] = d_skip[g * SC + F.tid];
                __syncthreads();
                {
                    const int d = F.tid >> 4, h = F.tid & 15; float a16[16];
#pragma unroll
                    for (int e = 0; e < 16; ++e) a16[e] = 0.f;
                    for (int p = 0; p < 64; ++p) { const float cr = ccr[h * 65 + p], ci = cci[h * 65 + p], pr = pwr[d * 65 + p], pi = pwi[d * 65 + p];
                        const float ar = cr * pr - ci * pi, ai_ = cr * pi + ci * pr;
#pragma unroll
                        for (int e = 0; e < 16; ++e) a16[e] += ar * bbr[p * 16 + e] - ai_ * bbi[p * 16 + e]; }
                    const float dd = dsk[h];
#pragma unroll
                    for (int e = 0; e < 16; ++e) Kd[(d * 16 + h) * 16 + e] = a16[e] + ((d == 0 && e == h) ? dd : 0.f);
                }
                __syncthreads();
                for (int i = F.tid; i < 128 * 80; i += NWAVES * 64) {
                    const int rl = i / 80, k8 = i - rl * 80, n = q * 128 + rl, t = n >> 4, h = n & 15; float v[8];
                    if (k8 < 64) { const int s = k8 >> 1, h0 = (k8 & 1) * 8;
                        if (s <= t) { const LAS float* kp = Kd + ((t - s) * 16 + h) * 16 + h0;
#pragma unroll
                            for (int e = 0; e < 8; ++e) v[e] = kp[e]; }
                        else {
#pragma unroll
                            for (int e = 0; e < 8; ++e) v[e] = 0.f; } }
                    else { const int j0 = (k8 - 64) * 8, p0 = j0 & 63; const bool im = j0 >= 64;
#pragma unroll
                        for (int e = 0; e < 8; ++e) { const int p = p0 + e; const float cr = ccr[h * 65 + p], ci = cci[h * 65 + p], pr = pwr[(t + 1) * 65 + p], pi = pwi[(t + 1) * 65 + p];
                            v[e] = im ? -(cr * pi + ci * pr) : (cr * pr - ci * pi); } }
                    v4u o; o.x = pk2(v[0], v[1]); o.y = pk2(v[2], v[3]); o.z = pk2(v[4], v[5]); o.w = pk2(v[6], v[7]);
                    *(GAS v4u*)(BT2 + ((size_t)(g * 512 + n)) * 640 + k8 * 8) = o;
                }
                for (int i = F.tid; i < 64 * 64; i += NWAVES * 64) {
                    const int rl = i >> 6, k8 = i & 63, j = q * 64 + rl; float v[8];
                    if (j < 128) { const int p = j & 63, s = k8 >> 1, h0 = (k8 & 1) * 8; const bool im = j >= 64; const float pr = pwr[(31 - s) * 65 + p], pi = pwi[(31 - s) * 65 + p];
#pragma unroll
                        for (int e = 0; e < 8; ++e) { const float br = bbr[p * 16 + h0 + e], bi = bbi[p * 16 + h0 + e]; v[e] = im ? (pr * bi + pi * br) : (pr * br - pi * bi); } }
                    else {
#pragma unroll
                        for (int e = 0; e < 8; ++e) v[e] = 0.f; }
                    v4u o; o.x = pk2(v[0], v[1]); o.y = pk2(v[2], v[3]); o.z = pk2(v[4], v[5]); o.w = pk2(v[6], v[7]);
                    *(GAS v4u*)(BTS + ((size_t)(g * 256 + j)) * 512 + k8 * 8) = o;
                }
            }
            __syncthreads();
        }
        LAS float* scr = (LAS float*)(F.lds + RING_OFF + F.wave * 16384);
        constexpr int I_IN = (DM / 64) * (INC / 32), I_GLU = (SW / 64) * (SW / 32), I_OUT = (DM / 64) * (DM / 32), I_UP = (DM / (F8_UP ? 128 : 64)) * (DFF2 / 32), I_DN = (DFF / (F8_DN ? 128 : 64)) * (DM / 32);
        constexpr int NITEMS = I_IN + I_GLU + I_OUT + I_UP + I_DN;
        for (int it = gw; it < NITEMS; it += NGW) {
            int r = it;
            if (r < I_IN) { p0_transpose_item(w_in, DM, INC, Wt_in, 0, scr, r, F.lane); continue; } r -= I_IN;
            if (r < I_GLU) { p0_transpose_item(w_glu, SW, SW, Wt_glu, 0, scr, r, F.lane); continue; } r -= I_GLU;
            if (r < I_OUT) { p0_transpose_item(w_out, DM, DM, Wt_out, 0, scr, r, F.lane); continue; } r -= I_OUT;
            if (r < I_UP) { const int n0 = 32 * (r % (DFF2 / 32)), ro = up_row(n0) - n0;
                if (F8_UP) p0_transpose_item_f8(w_up, DM, DFF2, Wt_up, ro, WSCALE, (LAS unsigned char*)scr, r, F.lane); else p0_transpose_item(w_up, DM, DFF2, (bf16*)Wt_up, ro, scr, r, F.lane); continue; } r -= I_UP;
            if (F8_DN) p0_transpose_item_f8(w_down, DFF, DM, Wt_down, 0, WSCALE, (LAS unsigned char*)scr, r, F.lane); else p0_transpose_item(w_down, DFF, DM, (bf16*)Wt_down, 0, scr, r, F.lane);
        }
        for (int m = gw; m < M; m += NGW) rms_row_to_bf16(F.lane, x + (size_t)m * DM, norm_mix, XN + (size_t)m * DM);
        for (int i = gt; i < AH * 512; i += NGT) { const int h = i >> 9, d = i & 511; T5B[i] = LOG2E * rel_bias[t5_bucket(d) * AH + h]; }
        if (BOTH(0)) GRID_BAR();
    }

    if (IN(1)) {
        pg8::Gemm g{XN, Wt_in, M, INC, DM}; pg8::StaticOrder S; S.init(M, INC, F.G, (int)blockIdx.x);
        pg8::EpiQKVU E{QB, (size_t)(WS_K - WS_Q) / 2, A2, C2};
        pg8::gemm_phase<pg8::EpiQKVU, pg8::StaticOrder, PG8_ALIGN, PG8_SP2>(F.lds + RING_OFF, g, S, E);
        if (BOTH(1)) GRID_BAR();
    }

    if (IN(2)) {
        for (int it = gw; it < BATCH * AH * NBLK; it += NGW) {
            const int n = it % NBLK, h = (it / NBLK) % AH, b = it / (NBLK * AH);
            const bf16* kp = KB + ((size_t)(b * SEQ + n * MOBA_BLK + (F.lane >> 3))) * AW + h * HD + (F.lane & 7) * 8;
            float a[8];
#pragma unroll
            for (int k = 0; k < 8; ++k) a[k] = 0.f;
            for (int i = 0; i < 32; ++i) { const v4u w = *(const GAS v4u*)(kp + (size_t)i * 8 * AW);
                a[0] += bf_lo(w.x); a[1] += bf_hi(w.x); a[2] += bf_lo(w.y); a[3] += bf_hi(w.y); a[4] += bf_lo(w.z); a[5] += bf_hi(w.z); a[6] += bf_lo(w.w); a[7] += bf_hi(w.w); }
#pragma unroll
            for (int k = 0; k < 8; ++k) { a[k] += __shfl_xor(a[k], 8); a[k] += __shfl_xor(a[k], 16); a[k] += __shfl_xor(a[k], 32); }
            if (F.lane < 8) { float* o = KMEAN + (size_t)it * HD + F.lane * 8;
#pragma unroll
                for (int k = 0; k < 8; ++k) o[k] = a[k] * (1.0f / MOBA_BLK); }
        }
#if SSM_FAST
        if ((int)blockIdx.x < SG) { const int g = blockIdx.x;
            { pg8::Gemm g1{A2, BTS, 0, 0, 512, 640, 512}; pg8::GroupOrder S1{g, 1, g}; pg8::EpiS E1{SBUF};
              pg8::gemm_phase<pg8::EpiS, pg8::GroupOrder, false, PG8_SP2>(F.lds + RING_OFF, g1, S1, E1); }
            VM_WAIT(); __syncthreads();
            if (F.tid < 128) { const int b = F.tid >> 6, p = F.tid & 63;
                const float lr = lam_re[g * SP + p], li = lam_im[g * SP + p], dt = expf(log_dt[g]);
                const float mag = expf(lr * dt * 32.0f), ang = li * dt * 32.0f, l32r = mag * cosf(ang), l32i = mag * sinf(ang);
                float xr = 0.f, xi = 0.f;
                const unsigned* sp = (const unsigned*)(SBUF + ((size_t)g * 256 + b * 128) * 128 + p);
                bf16* xp = A2 + ((size_t)(g * 256 + b * 128)) * 640 + 512 + p;
                for (int c0 = 0; c0 < 128; c0 += 8) { float sr[8], si[8];
#pragma unroll
                    for (int k = 0; k < 8; ++k) { sr[k] = __uint_as_float(__hip_atomic_load(sp + (size_t)(c0 + k) * 128, __ATOMIC_RELAXED, __HIP_MEMORY_SCOPE_AGENT));
                                                  si[k] = __uint_as_float(__hip_atomic_load(sp + (size_t)(c0 + k) * 128 + 64, __ATOMIC_RELAXED, __HIP_MEMORY_SCOPE_AGENT)); }
#pragma unroll
                    for (int k = 0; k < 8; ++k) { xp[(size_t)(c0 + k) * 640] = (bf16)f2bf(xr); xp[(size_t)(c0 + k) * 640 + 64] = (bf16)f2bf(xi);
                        const float nxr = l32r * xr - l32i * xi + sr[k], nxi = l32r * xi + l32i * xr + si[k]; xr = nxr; xi = nxi; } }
            }
            VM_WAIT(); __syncthreads();
            { pg8::Gemm g2{A2, BT2, 0, 0, 640, 640, 640}; pg8::GroupOrder S2{g, 2, 2 * g}; pg8::EpiY E2{YB};
              pg8::gemm_phase<pg8::EpiY, pg8::GroupOrder, PG8_ALIGN, PG8_SP2>(F.lds + RING_OFF, g2, S2, E2); }
        }
#else
        for (int it = gw; it < BATCH * SG; it += NGW) {
            const int g = it % SG, b = it / SG, p = F.lane;
            const float lr = lam_re[g * SP + p], li = lam_im[g * SP + p], dt = expf(log_dt[g]);
            const float er = expf(lr * dt), lbr = er * cosf(li * dt), lbi = er * sinf(li * dt);
            const float nr = lbr - 1.0f, ni = lbi, den = lr * lr + li * li;
            const float cr_ = (nr * lr + ni * li) / den, ci_ = (ni * lr - nr * li) / den;
            float bbr[16], bbi[16], ccr[16], cci[16];
#pragma unroll
            for (int h = 0; h < 16; ++h) { const float bre = b_re[(size_t)(g * SP + p) * SC + h], bim = b_im[(size_t)(g * SP + p) * SC + h];
                bbr[h] = cr_ * bre - ci_ * bim; bbi[h] = cr_ * bim + ci_ * bre;
                ccr[h] = c_re[(size_t)(g * SC + h) * SP + p]; cci[h] = c_im[(size_t)(g * SC + h) * SP + p]; }
            const float dsk = d_skip[g * SC + (F.lane & 15)];
            float xr = 0.f, xi = 0.f;
            const bf16* up = A2 + (size_t)(g * 256 + b * 128) * 640;
            v4u n0 = *(const GAS v4u*)(up), n1 = *(const GAS v4u*)(up + 8);
            for (int t = 0; t < SEQ; ++t) {
                const v4u c0 = n0, c1 = n1;
                if (t + 1 < SEQ) { const bf16* un = up + (size_t)((t + 1) >> 5) * 640 + ((t + 1) & 31) * 16; n0 = *(const GAS v4u*)(un); n1 = *(const GAS v4u*)(un + 8); }
                float uf[16];
                uf[0] = bf_lo(c0.x); uf[1] = bf_hi(c0.x); uf[2] = bf_lo(c0.y); uf[3] = bf_hi(c0.y); uf[4] = bf_lo(c0.z); uf[5] = bf_hi(c0.z); uf[6] = bf_lo(c0.w); uf[7] = bf_hi(c0.w);
                uf[8] = bf_lo(c1.x); uf[9] = bf_hi(c1.x); uf[10] = bf_lo(c1.y); uf[11] = bf_hi(c1.y); uf[12] = bf_lo(c1.z); uf[13] = bf_hi(c1.z); uf[14] = bf_lo(c1.w); uf[15] = bf_hi(c1.w);
                float bur = 0.f, bui = 0.f;
#pragma unroll
                for (int h = 0; h < 16; ++h) { bur += uf[h] * bbr[h]; bui += uf[h] * bbi[h]; }
                const float nxr = lbr * xr - lbi * xi + bur, nxi = lbr * xi + lbi * xr + bui; xr = nxr; xi = nxi;
                float yv = 0.f;
#pragma unroll
                for (int h = 0; h < 16; ++h) { const float v = wave_sum(xr * ccr[h] - xi * cci[h]); if (F.lane == h) yv = v + dsk * uf[h]; }
                if (F.lane < 16) YB[(size_t)(b * SEQ + t) * SW + g * SC + F.lane] = (bf16)f2bf(gelu_tanh(yv));
            }
        }
#endif
        if (BOTH(2)) GRID_BAR();
    }

    if (IN(3)) {
        static_assert(attn_body::ATTN_LDS_BYTES <= RING_BYTES && attn_body::ATTN_PITCH == AW, "attention body geometry vs frame");
        const attn_body::AttnTensors AT{(const attn_body::bf16*)QB, (const attn_body::bf16*)KB, (const attn_body::bf16*)VB, (attn_body::bf16*)QB, KMEAN, T5B};
        const attn_body::StaticOrder S((int)F.G, (int)blockIdx.x);
        attn_body::attn_phase<attn_body::StaticOrder>((char*)lds + RING_OFF, AT, S);
        if (BOTH(3)) GRID_BAR();
    }

    if (IN(4)) {
        pg8::Gemm g{YB, Wt_glu, M, SW, SW}; pg8::StaticOrder S; S.init(M, SW, F.G, (int)blockIdx.x);
        pg8::EpiGlu E{YB, ZB, SW, b_glu};
        pg8::gemm_phase<pg8::EpiGlu, pg8::StaticOrder, PG8_ALIGN, PG8_SP2>(F.lds + RING_OFF, g, S, E);
        if (BOTH(4)) GRID_BAR();
    }

    if (IN(5)) {
        for (int m = gw; m < M; m += NGW) {
            rms_row1024_bf16(F.lane, QB + (size_t)m * AW, norm_attn, XN + (size_t)m * DM);
            rms_row1024_bf16(F.lane, ZB + (size_t)m * SW, norm_ssm, XN + (size_t)m * DM + AW);
        }
        if (BOTH(5)) GRID_BAR();
    }

    if (IN(6)) {
        pg8::Gemm g{XN, Wt_out, M, DM, DM}; pg8::StaticOrder S; S.init(M, DM, F.G, (int)blockIdx.x);
        pg8::EpiResid1<F8_UP> E{x, out, X1G, norm_ffn, SSQ, DM};
        pg8::gemm_phase<pg8::EpiResid1<F8_UP>, pg8::StaticOrder, PG8_ALIGN, PG8_SP2>(F.lds + RING_OFF, g, S, E);
        if (BOTH(6)) GRID_BAR();
    }

    if (IN(7)) {
        pg8::Gemm g{(const bf16*)X1G, (const bf16*)Wt_up, 0, 0, F8_UP ? DM / 2 : DM, 0, 0}; pg8::UpOrder S; S.init_up(F.G, (int)blockIdx.x);
        pg8::EpiConv<F8_DN> E{ACT, SSQ, conv_w, conv_b, (LAS float*)(F.lds + XL_OFF), 1.0f / DM, RMS_EPS, F8_UP ? 1.0f / WSCALE : 1.0f};
        pg8::gemm_phase<pg8::EpiConv<F8_DN>, pg8::UpOrder, true, PG8_SP2, F8_UP>(F.lds + RING_OFF, g, S, E);
        if (BOTH(7)) GRID_BAR();
    }


    if (IN(9)) {
        pg8::Gemm g{(const bf16*)ACT, (const bf16*)Wt_down, M, DM, F8_DN ? DFF / 2 : DFF, 0, 0}; pg8::StaticOrder S; S.init(M, DM, F.G, (int)blockIdx.x);
        pg8::EpiResid2 E{out, DM, F8_DN ? 1.0f / WSCALE : 1.0f};
        pg8::gemm_phase<pg8::EpiResid2, pg8::StaticOrder, PG8_ALIGN, PG8_SP2, F8_DN>(F.lds + RING_OFF, g, S, E);
        if (BOTH(9)) GRID_BAR();
    }

    if (IN(10)) {
        for (int m = gw; m < M; m += NGW) {
            GAS f32x4* xr = (GAS f32x4*)(out + (size_t)m * DM) + F.lane; const GAS f32x4* gr = (const GAS f32x4*)norm_final + F.lane;
            f32x4 v[8]; float s = 0.f;
#pragma unroll
            for (int j = 0; j < 8; ++j) { v[j] = xr[64 * j]; s += (v[j].x * v[j].x + v[j].y * v[j].y) + (v[j].z * v[j].z + v[j].w * v[j].w); }
            const float rstd = 1.0f / sqrtf(wave_sum(s) * (1.f / DM) + RMS_EPS);
#pragma unroll
            for (int j = 0; j < 8; ++j) xr[64 * j] = v[j] * rstd * gr[64 * j];
        }
    }
#undef IN
#undef BOTH
}

extern "C" void kernel_launch(void* const* d_in, const int* in_sizes, int n_in, void* d_out, int out_size, void* d_ws, size_t ws_size, hipStream_t stream) {
    static int grid = 0;
    if (grid == 0) {
        if (n_in != 23 || in_sizes[0] != M * DM || out_size != M * DM || ws_size < WS_END) { fprintf(stderr, "kernel_launch: unexpected shapes: n_in %d in0 %d out %d ws %zu (need %zu); nothing launched\n", n_in, n_in > 0 ? in_sizes[0] : -1, out_size, ws_size, (size_t)WS_END); grid = -1; return; }
        int dev = 0, cus = 0, per_cu = 0;
        if (hipGetDevice(&dev) != hipSuccess || hipDeviceGetAttribute(&cus, hipDeviceAttributeMultiprocessorCount, dev) != hipSuccess) { fprintf(stderr, "kernel_launch: device query failed\n"); grid = -1; return; }
        if (hipFuncSetAttribute((const void*)skel_fwd, hipFuncAttributeMaxDynamicSharedMemorySize, LDS_BYTES) != hipSuccess) { fprintf(stderr, "kernel_launch: hipFuncSetAttribute failed\n"); grid = -1; return; }
        if (hipOccupancyMaxActiveBlocksPerMultiprocessor(&per_cu, (const void*)skel_fwd, NWAVES * 64, LDS_BYTES) != hipSuccess || per_cu < 1)
            fprintf(stderr, "kernel_launch: note: occupancy query reports %d workgroups per CU\n", per_cu);
        (void)hipGetLastError();
        grid = cus;
        if (grid < SG) { fprintf(stderr, "kernel_launch: needs >= %d CUs\n", SG); grid = -1; return; }
    }
    if (grid < 0) return;
    if (hipMemsetAsync((char*)d_ws + WS_CTL, 0, CTL_ZERO_BYTES, stream) != hipSuccess) { fprintf(stderr, "kernel_launch: hipMemsetAsync failed\n"); return; }
    Args a{};
    for (int i = 0; i < 23; ++i) a.in[i] = (const float*)d_in[i];
    a.out = (float*)d_out; a.ws = (unsigned char*)d_ws;
    for (int li = 0; li < N_LAUNCHES; ++li) {
        a.ph_lo = (N_LAUNCHES == 1) ? 0 : li; a.ph_hi = (N_LAUNCHES == 1) ? NPH : li + 1; a.li = li;
        hipLaunchKernelGGL(skel_fwd, dim3(grid), dim3(NWAVES * 64), LDS_BYTES, stream, a);
        const hipError_t le = hipPeekAtLastError();
        if (le != hipSuccess) { fprintf(stderr, "kernel_launch: launch %d failed: %s\n", li, hipGetErrorName(le)); break; }
    }
}
```

```cpp
#define F8_UP 1
#define F8_DN 1
#ifndef SSM_FAST
#define SSM_FAST 1
#endif
#ifndef F8_UP
#define F8_UP 1
#endif
#ifndef F8_DN
#define F8_DN 1
#endif
#include <hip/hip_runtime.h>
#include <cstdio>
#include <cstdint>
namespace pg8 {
#define PG8_LAS __attribute__((address_space(3)))
typedef unsigned short bf16_t;
typedef short bf16x8 __attribute__((ext_vector_type(8)));
typedef float f32x4 __attribute__((ext_vector_type(4)));
typedef unsigned u32x4 __attribute__((ext_vector_type(4)));
constexpr int BM = 256, BK = 64, HALF = 128, HTB = HALF * BK * 2  , STAGE_BYTES = 8 * HTB, NXCD = 8, WGM = 8;

__host__ __device__ __forceinline__ int lds_byte(int r, int c) { const int st = (r >> 4) * 2 + (c >> 5), rr = r & 15, cc = c & 31, ob = rr * 64 + cc * 2; return st * 1024 + (ob ^ (((ob >> 9) & 1) << 5)); }
__host__ __device__ __forceinline__ void stage_rc(int b, int& R, int& C) { const int st = b / 1024, sb = b % 1024, swz = sb ^ (((sb >> 9) & 1) << 5); R = (st >> 1) * 16 + swz / 64; C = (st & 1) * 32 + (swz % 64) / 2; }
__host__ __device__ __forceinline__ int perm32(int rho) { const int n = rho >> 4, i = rho & 15; return 8 * (i >> 2) + 4 * n + (i & 3); }

struct Unit { int pm, pn; };
struct Gemm { const bf16_t* A; const bf16_t* Bt; int M, N, K; int lda, ldb; };

struct StaticOrder {
    int nM, nN, nwg, G, c;
    __host__ __device__ void init(int M, int N, int G_, int c_) { nM = M / BM; nN = N / BM; nwg = nM * nN; G = G_; c = c_; }
    __host__ __device__ bool next(int i, Unit& u) const {
        const long L = (long)i * G + c; if (L >= nwg) return false;
        int wgid = (int)L; { const int q = nwg / NXCD, r = nwg % NXCD, xcd = wgid % NXCD, off = wgid / NXCD; wgid = (xcd < r ? xcd * (q + 1) : r * (q + 1) + (xcd - r) * q) + off; }
        const int nig = WGM * nN, gid = wgid / nig, fm = gid * WGM, gsz = (nM - fm) < WGM ? (nM - fm) : WGM;
        u.pm = fm + ((wgid % nig) % gsz); u.pn = (wgid % nig) / gsz; return true;
    }
    __device__ __forceinline__ void a_ready(const Unit&) const {}
    __device__ __forceinline__ void done(const Unit&) const {}
    __device__ __forceinline__ int arow(const Unit& u) const { return u.pm * BM; }
};

__device__ __forceinline__ unsigned cvt_pk_bf16(float lo, float hi) { unsigned r; asm volatile("v_cvt_pk_bf16_f32 %0, %1, %2" : "=v"(r) : "v"(lo), "v"(hi)); return r; }
typedef float f32x2 __attribute__((ext_vector_type(2)));
__device__ __forceinline__ f32x2 gelu_pk(f32x2 v) {
    const f32x2 av = __builtin_elementwise_abs(v), d = av * 0.2316418882f + 1.0f;
    f32x2 t; t.x = __builtin_amdgcn_rcpf(d.x); t.y = __builtin_amdgcn_rcpf(d.y);
    f32x2 q = t * 0.5307027145f + (-0.7265760135f); q = q * t + 0.7107068705f; q = q * t + (-0.142248368f); q = q * t + 0.127414796f; q = q * t;
    const f32x2 s = (v * v) * (-0.72134752044f);
    f32x2 e; e.x = __builtin_amdgcn_exp2f(s.x); e.y = __builtin_amdgcn_exp2f(s.y);
    const f32x2 m = v * (q * e), r = v - m;
    f32x2 o; o.x = v.x < 0.f ? m.x : r.x; o.y = v.y < 0.f ? m.y : r.y; return o;
}

template <int ACT  > struct EpiBf16 {
    static constexpr bool PERM = true, AFTER_DRAIN = false; static_assert(ACT == 0 || ACT == 1, "EpiBf16: ACT is 0 (none) or 1 (gelu_pk)");
    bf16_t* O; int ldc; const float* bias; int split_cols; size_t split_stride; float scale0;
    __device__ __forceinline__ void operator()(const f32x4 (&acc)[2][2][4][2], const Unit& u, int wr, int wc, int fr, int fq) const {
        const int row0 = u.pm * BM + wr * 64 + fr; int colt = u.pn * BM; bf16_t* base = O;
        float sc = 1.f; if (split_cols) { const int t = colt / split_cols; base += (size_t)t * split_stride; colt -= t * split_cols; if (t == 0) sc = scale0; }
        const int col0 = colt + wc * 32 + 8 * fq, bcol0 = u.pn * BM + wc * 32 + 8 * fq;
        f32x4 bv[2][2];
#pragma unroll
        for (int bj = 0; bj < 2; ++bj)
#pragma unroll
            for (int n = 0; n < 2; ++n) bv[bj][n] = bias ? *(const f32x4*)(bias + bcol0 + bj * HALF + 4 * n) : (f32x4){0.f, 0.f, 0.f, 0.f};
#pragma unroll
        for (int ai = 0; ai < 2; ++ai)
#pragma unroll
            for (int m = 0; m < 4; ++m) { bf16_t* rowp = base + (size_t)(row0 + ai * HALF + m * 16) * ldc + col0;
#pragma unroll
                for (int bj = 0; bj < 2; ++bj) { f32x4 v0 = acc[ai][bj][m][0] + bv[bj][0], v1 = acc[ai][bj][m][1] + bv[bj][1];
                    if (ACT == 1) { f32x2 a = gelu_pk((f32x2){v0[0], v0[1]}), b = gelu_pk((f32x2){v0[2], v0[3]}), c = gelu_pk((f32x2){v1[0], v1[1]}), d = gelu_pk((f32x2){v1[2], v1[3]});
                        v0 = (f32x4){a.x, a.y, b.x, b.y}; v1 = (f32x4){c.x, c.y, d.x, d.y}; }
                    v0 = v0 * sc; v1 = v1 * sc; u32x4 w; w.x = cvt_pk_bf16(v0[0], v0[1]); w.y = cvt_pk_bf16(v0[2], v0[3]); w.z = cvt_pk_bf16(v1[0], v1[1]); w.w = cvt_pk_bf16(v1[2], v1[3]);
                    *(u32x4*)(rowp + bj * HALF) = w; } }
    }
};

typedef unsigned u32x2 __attribute__((ext_vector_type(2)));
__device__ __forceinline__ unsigned pk4_fp8(float a, float b, float c, float d) {
    unsigned w = 0u; w = __builtin_amdgcn_cvt_pk_fp8_f32(a, b, w, false); w = __builtin_amdgcn_cvt_pk_fp8_f32(c, d, w, true); return w; }
__device__ __forceinline__ float bf_lo(unsigned w) { return __uint_as_float(w << 16); }
__device__ __forceinline__ float bf_hi(unsigned w) { return __uint_as_float(w & 0xffff0000u); }
__device__ __forceinline__ float sigmoid_f(float v) { return __builtin_amdgcn_rcpf(1.0f + __builtin_amdgcn_exp2f(-1.4426950408889634f * v)); }
struct EpiGlu {
    static constexpr bool PERM = true, AFTER_DRAIN = false;
    const bf16_t* Y; bf16_t* Z; int ldc; const float* bias;
    __device__ __forceinline__ void operator()(const f32x4 (&acc)[2][2][4][2], const Unit& u, int wr, int wc, int fr, int fq) const {
        const int row0 = u.pm * BM + wr * 64 + fr, col0 = u.pn * BM + wc * 32 + 8 * fq;
        f32x4 bv[2][2];
#pragma unroll
        for (int bj = 0; bj < 2; ++bj)
#pragma unroll
            for (int n = 0; n < 2; ++n) bv[bj][n] = *(const f32x4*)(bias + col0 + bj * HALF + 4 * n);
#pragma unroll
        for (int ai = 0; ai < 2; ++ai)
#pragma unroll
            for (int m = 0; m < 4; ++m) { const size_t off = (size_t)(row0 + ai * HALF + m * 16) * ldc + col0;
#pragma unroll
                for (int bj = 0; bj < 2; ++bj) { const u32x4 yv = *(const u32x4*)(Y + off + bj * HALF);
                    const f32x4 v0 = acc[ai][bj][m][0] + bv[bj][0], v1 = acc[ai][bj][m][1] + bv[bj][1];
                    u32x4 w;
                    w.x = cvt_pk_bf16(bf_lo(yv.x) * sigmoid_f(v0[0]), bf_hi(yv.x) * sigmoid_f(v0[1]));
                    w.y = cvt_pk_bf16(bf_lo(yv.y) * sigmoid_f(v0[2]), bf_hi(yv.y) * sigmoid_f(v0[3]));
                    w.z = cvt_pk_bf16(bf_lo(yv.z) * sigmoid_f(v1[0]), bf_hi(yv.z) * sigmoid_f(v1[1]));
                    w.w = cvt_pk_bf16(bf_lo(yv.w) * sigmoid_f(v1[2]), bf_hi(yv.w) * sigmoid_f(v1[3]));
                    *(u32x4*)(Z + off + bj * HALF) = w; } }
    }
};
template <bool F8O> struct EpiResid1 {
    static constexpr bool PERM = true, AFTER_DRAIN = false;
    const float* X; float* X1; unsigned char* X1G; const float* gw; float* ssq; int ldc;
    __device__ __forceinline__ void operator()(const f32x4 (&acc)[2][2][4][2], const Unit& u, int wr, int wc, int fr, int fq) const {
        const int row0 = u.pm * BM + wr * 64 + fr, col0 = u.pn * BM + wc * 32 + 8 * fq;
        f32x4 gv[2][2];
#pragma unroll
        for (int bj = 0; bj < 2; ++bj)
#pragma unroll
            for (int n = 0; n < 2; ++n) gv[bj][n] = *(const f32x4*)(gw + col0 + bj * HALF + 4 * n);
#pragma unroll
        for (int ai = 0; ai < 2; ++ai)
#pragma unroll
            for (int m = 0; m < 4; ++m) { const int row = row0 + ai * HALF + m * 16; const size_t off = (size_t)row * ldc + col0; float s = 0.f;
#pragma unroll
                for (int bj = 0; bj < 2; ++bj) {
                    const f32x4 v0 = *(const f32x4*)(X + off + bj * HALF) + acc[ai][bj][m][0], v1 = *(const f32x4*)(X + off + bj * HALF + 4) + acc[ai][bj][m][1];
                    *(f32x4*)(X1 + off + bj * HALF) = v0; *(f32x4*)(X1 + off + bj * HALF + 4) = v1;
                    s += (v0[0] * v0[0] + v0[1] * v0[1]) + (v0[2] * v0[2] + v0[3] * v0[3]) + (v1[0] * v1[0] + v1[1] * v1[1]) + (v1[2] * v1[2] + v1[3] * v1[3]);
                    const f32x4 g0 = v0 * gv[bj][0], g1 = v1 * gv[bj][1];
                    if constexpr (F8O) { u32x2 w; w.x = pk4_fp8(g0[0], g0[1], g0[2], g0[3]); w.y = pk4_fp8(g1[0], g1[1], g1[2], g1[3]); *(u32x2*)(X1G + off + bj * HALF) = w; }
                    else { u32x4 w; w.x = cvt_pk_bf16(g0[0], g0[1]); w.y = cvt_pk_bf16(g0[2], g0[3]); w.z = cvt_pk_bf16(g1[0], g1[1]); w.w = cvt_pk_bf16(g1[2], g1[3]); *(u32x4*)((bf16_t*)X1G + off + bj * HALF) = w; } }
                s += __shfl_xor(s, 16); s += __shfl_xor(s, 32);
                if (fq == 0) ssq[(size_t)row * 32 + u.pn * 4 + wc] = s; }
    }
};
struct EpiUp {
    static constexpr bool PERM = true, AFTER_DRAIN = false;
    bf16_t* O; int ldc; const float* ssq; float inv_n, eps, wscale;
    __device__ __forceinline__ void operator()(const f32x4 (&acc)[2][2][4][2], const Unit& u, int wr, int wc, int fr, int fq) const {
        const int row0 = u.pm * BM + wr * 64 + fr, col0 = u.pn * BM + wc * 32 + 8 * fq;
#pragma unroll
        for (int ai = 0; ai < 2; ++ai)
#pragma unroll
            for (int m = 0; m < 4; ++m) { const int row = row0 + ai * HALF + m * 16; const f32x4* sp = (const f32x4*)(ssq + (size_t)row * 32);
                f32x4 t = sp[0];
#pragma unroll
                for (int k = 1; k < 8; ++k) t += sp[k];
                const float rstd = __builtin_amdgcn_rsqf(((t[0] + t[1]) + (t[2] + t[3])) * inv_n + eps) * wscale;
                bf16_t* rowp = O + (size_t)row * ldc + col0;
#pragma unroll
                for (int bj = 0; bj < 2; ++bj) { const f32x4 v0 = acc[ai][bj][m][0] * rstd, v1 = acc[ai][bj][m][1] * rstd; u32x4 w;
                    w.x = cvt_pk_bf16(v0[0], v0[1]); w.y = cvt_pk_bf16(v0[2], v0[3]); w.z = cvt_pk_bf16(v1[0], v1[1]); w.w = cvt_pk_bf16(v1[2], v1[3]);
                    *(u32x4*)(rowp + bj * HALF) = w; } }
    }
};
struct EpiResid2 {
    static constexpr bool PERM = true, AFTER_DRAIN = false;
    float* OUT; int ldc; float wscale;
    __device__ __forceinline__ void operator()(const f32x4 (&acc)[2][2][4][2], const Unit& u, int wr, int wc, int fr, int fq) const {
        const int row0 = u.pm * BM + wr * 64 + fr, col0 = u.pn * BM + wc * 32 + 8 * fq;
#pragma unroll
        for (int ai = 0; ai < 2; ++ai)
#pragma unroll
            for (int m = 0; m < 4; ++m) { float* rowp = OUT + (size_t)(row0 + ai * HALF + m * 16) * ldc + col0;
#pragma unroll
                for (int bj = 0; bj < 2; ++bj) { f32x4* p = (f32x4*)(rowp + bj * HALF); const f32x4 a = p[0], b = p[1]; p[0] = a + acc[ai][bj][m][0] * wscale; p[1] = b + acc[ai][bj][m][1] * wscale; } }
    }
};
__device__ __forceinline__ float gelu_tanh_f(float y) {
    const float u = 0.7978845608028654f * (y + 0.044715f * y * y * y);
    const float e = __builtin_amdgcn_exp2f(2.0f * 1.4426950408889634f * u);
    return 0.5f * y * (2.0f - 2.0f * __builtin_amdgcn_rcpf(e + 1.0f));
}
struct EpiQKVU {
    static constexpr bool PERM = true, AFTER_DRAIN = false;
    bf16_t* Q; size_t split_stride; bf16_t* A2; float scale0;
    __device__ __forceinline__ void operator()(const f32x4 (&acc)[2][2][4][2], const Unit& u, int wr, int wc, int fr, int fq) const {
        const int row0 = u.pm * BM + wr * 64 + fr; const int colt = u.pn * BM, t = colt >> 10, col0 = (colt & 1023) + wc * 32 + 8 * fq;
        const float sc = (t == 0) ? scale0 : 1.f;
#pragma unroll
        for (int ai = 0; ai < 2; ++ai)
#pragma unroll
            for (int m = 0; m < 4; ++m) { const int row = row0 + ai * HALF + m * 16;
#pragma unroll
                for (int bj = 0; bj < 2; ++bj) { const int c = col0 + bj * HALF; const f32x4 v0 = acc[ai][bj][m][0] * sc, v1 = acc[ai][bj][m][1] * sc; u32x4 w;
                    w.x = cvt_pk_bf16(v0[0], v0[1]); w.y = cvt_pk_bf16(v0[2], v0[3]); w.z = cvt_pk_bf16(v1[0], v1[1]); w.w = cvt_pk_bf16(v1[2], v1[3]);
                    if (t < 3) *(u32x4*)(Q + (size_t)t * split_stride + (size_t)row * 1024 + c) = w;
                    else { const int b = row >> 12, tok = row & 4095; *(u32x4*)(A2 + ((size_t)((c >> 4) * 256 + b * 128 + (tok >> 5)) * 640 + (tok & 31) * 16 + (c & 15))) = w; } } }
    }
};
struct EpiS {
    static constexpr bool PERM = false, AFTER_DRAIN = false;
    float* S;
    __device__ __forceinline__ void operator()(const f32x4 (&acc)[2][2][4][2], const Unit& u, int wr, int wc, int fr, int fq) const {
        const int row0 = wr * 64 + fr, col0 = wc * 32 + 4 * fq;
#pragma unroll
        for (int ai = 0; ai < 2; ++ai)
#pragma unroll
            for (int m = 0; m < 4; ++m) { float* rowp = S + ((size_t)u.pm * 256 + row0 + ai * HALF + m * 16) * 128 + col0;
#pragma unroll
                for (int n = 0; n < 2; ++n) *(f32x4*)(rowp + n * 16) = acc[ai][0][m][n]; }
    }
};
struct EpiY {
    static constexpr bool PERM = true, AFTER_DRAIN = false;
    bf16_t* Y;
    __device__ __forceinline__ void operator()(const f32x4 (&acc)[2][2][4][2], const Unit& u, int wr, int wc, int fr, int fq) const {
        const int row0 = wr * 64 + fr, col0 = (u.pn & 1) * BM + wc * 32 + 8 * fq, g = u.pm;
#pragma unroll
        for (int ai = 0; ai < 2; ++ai)
#pragma unroll
            for (int m = 0; m < 4; ++m) { const int R = row0 + ai * HALF + m * 16, b = R >> 7, c = R & 127;
#pragma unroll
                for (int bj = 0; bj < 2; ++bj) { const int cl = col0 + bj * HALF, t = cl >> 4, h0 = cl & 15; const f32x4 v0 = acc[ai][bj][m][0], v1 = acc[ai][bj][m][1]; u32x4 w;
                    w.x = cvt_pk_bf16(gelu_tanh_f(v0[0]), gelu_tanh_f(v0[1])); w.y = cvt_pk_bf16(gelu_tanh_f(v0[2]), gelu_tanh_f(v0[3]));
                    w.z = cvt_pk_bf16(gelu_tanh_f(v1[0]), gelu_tanh_f(v1[1])); w.w = cvt_pk_bf16(gelu_tanh_f(v1[2]), gelu_tanh_f(v1[3]));
                    *(u32x4*)(Y + (size_t)(b * 4096 + c * 32 + t) * 1024 + g * 16 + h0) = w; } }
    }
};
struct GroupOrder {
    int g, nu, pn0;
    __device__ __forceinline__ bool next(int i, Unit& u) const { if (i >= nu) return false; u.pm = g; u.pn = pn0 + i; return true; }
    __device__ __forceinline__ void a_ready(const Unit&) const {}
    __device__ __forceinline__ void done(const Unit&) const {}
    __device__ __forceinline__ int arow(const Unit& u) const { return u.pm * BM; }
};
__host__ __device__ __forceinline__ int up_arow(int pm) { const int i = pm % 17, b = pm / 17; return b * 4096 + (i == 16 ? 3840 : 254 * i); }
template <int CTRL> __device__ __forceinline__ float dppf(float oldv, float src) {
    return __int_as_float(__builtin_amdgcn_update_dpp(__float_as_int(oldv), __float_as_int(src), CTRL, 0xf, 0xf, false)); }
template <bool F8O> struct EpiConv {
    static constexpr bool PERM = true, AFTER_DRAIN = false;
    unsigned char* ACT; const float* ssq; const float* cw; const float* cb; PG8_LAS float* xl; float inv_n, eps, wscale;
    __device__ __forceinline__ void operator()(const f32x4 (&acc)[2][2][4][2], const Unit& u, int wr, int wc, int fr_, int fq_) const {
        constexpr int DFFc = 5632;
        int tid = threadIdx.x, fr = fr_, fq = fq_; asm volatile("" : "+v"(tid), "+v"(fr), "+v"(fq));
        const int wid = wr * 4 + wc;
        const int arow0 = up_arow(u.pm); const bool first = (u.pm % 17) == 0;
        PG8_LAS float* rs = xl; PG8_LAS float* hal = xl + 256;
        {
            const f32x4* sp = (const f32x4*)(ssq + (size_t)(arow0 + (tid >> 1)) * 32 + (tid & 1) * 16);
            const f32x4 t = (sp[0] + sp[1]) + (sp[2] + sp[3]); float s = (t[0] + t[1]) + (t[2] + t[3]); s += __shfl_xor(s, 1);
            if ((tid & 1) == 0) rs[tid >> 1] = __builtin_amdgcn_rsqf(s * inv_n + eps) * wscale;
        }
        if (fr >= 14) {
#pragma unroll
            for (int ai = 0; ai < 2; ++ai)
#pragma unroll
                for (int bj = 0; bj < 2; ++bj)
#pragma unroll
                    for (int n = 0; n < 2; ++n) *(PG8_LAS f32x4*)(hal + ((wid * 2 + ai) * 2 + (fr - 14)) * 64 + fq * 16 + bj * 8 + n * 4) = acc[ai][bj][3][n];
        }
        asm volatile("s_waitcnt lgkmcnt(0)" ::: "memory"); __builtin_amdgcn_s_barrier(); asm volatile("" ::: "memory");
        const int jg = u.pn * 128 + wc * 32 + 8 * fq;
#pragma unroll
        for (int ai = 0; ai < 2; ++ai) {
            const int R0 = 128 * ai + 64 * wr;
            unsigned keep[4];
#pragma unroll
            for (int n = 0; n < 2; ++n) {
                f32x4 wg[3], wv[3], bgv, bvv; int jw = jg + 4 * n; asm volatile("" : "+v"(jw));
#pragma unroll
                for (int k = 0; k < 3; ++k) { wg[k] = *(const f32x4*)(cw + (size_t)k * (2 * DFFc) + jw); wv[k] = *(const f32x4*)(cw + (size_t)k * (2 * DFFc) + DFFc + jw); }
                bgv = *(const f32x4*)(cb + jw); bvv = *(const f32x4*)(cb + DFFc + jw);
                f32x4 o1g, o2g, o1v, o2v;
                if (ai == 0 && wr == 0) { o1g = (f32x4){0.f, 0.f, 0.f, 0.f}; o2g = o1g; o1v = o1g; o2v = o1g; }
                else { const int pw = (ai == 0) ? wc : (wr == 0 ? 4 + wc : wc), pai = (ai == 1 && wr == 1) ? 1 : 0;
                    const float r15 = rs[R0 - 1], r14 = rs[R0 - 2]; const PG8_LAS float* hp = hal + ((pw * 2 + pai) * 2) * 64 + fq * 16 + n * 4;
                    const f32x4 g14 = *(const PG8_LAS f32x4*)(hp) * r14, g15 = *(const PG8_LAS f32x4*)(hp + 64) * r15, v14 = *(const PG8_LAS f32x4*)(hp + 8) * r14, v15 = *(const PG8_LAS f32x4*)(hp + 64 + 8) * r15;
                    o1g = g15; o1v = v15; o2g = (fr == 0) ? g14 : g15; o2v = (fr == 0) ? v14 : v15; }
#pragma unroll
                for (int m = 0; m < 4; ++m) { const int rl = R0 + 16 * m + fr; const float rr = rs[rl];
                    const f32x4 cg = acc[ai][0][m][n] * rr, cv = acc[ai][1][m][n] * rr; f32x4 a;
#pragma unroll
                    for (int e = 0; e < 4; ++e) {
                        const float g1 = dppf<0x111>(o1g[e], cg[e]), g2 = dppf<0x112>(o2g[e], cg[e]), v1 = dppf<0x111>(o1v[e], cv[e]), v2 = dppf<0x112>(o2v[e], cv[e]);
                        const float xg = cg[e] * wg[2][e] + g1 * wg[1][e] + g2 * wg[0][e] + bgv[e], xv = cv[e] * wv[2][e] + v1 * wv[1][e] + v2 * wv[0][e] + bvv[e];
                        a[e] = xg * __builtin_amdgcn_rcpf(1.0f + __builtin_amdgcn_exp2f(-1.4426950408889634f * xg)) * xv;
                        o1g[e] = dppf<0x121>(cg[e], cg[e]); o2g[e] = dppf<0x122>(cg[e], cg[e]); o1v[e] = dppf<0x121>(cv[e], cv[e]); o2v[e] = dppf<0x122>(cv[e], cv[e]); }
                    const bool st = first || rl >= 2; const size_t row = (size_t)(arow0 + rl);
                    if constexpr (F8O) { unsigned w = pk4_fp8(a[0], a[1], a[2], a[3]); asm volatile("" : "+v"(w));
                        if (n == 0) keep[m] = w; else if (st) { u32x2 o; o.x = keep[m]; o.y = w; *(u32x2*)(ACT + row * DFFc + jg) = o; } }
                    else { u32x2 o; o.x = cvt_pk_bf16(a[0], a[1]); o.y = cvt_pk_bf16(a[2], a[3]); if (st) *(u32x2*)((bf16_t*)ACT + row * DFFc + jg + 4 * n) = o; }
                    __builtin_amdgcn_sched_barrier(0);
                }
            }
        }
    }
};
struct UpOrder : StaticOrder {
    __host__ __device__ void init_up(int G_, int c_) { nM = 34; nN = 44; nwg = nM * nN; G = G_; c = c_; }
    __device__ __forceinline__ int arow(const Unit& u) const { return up_arow(u.pm); }
};

struct PairOrder : StaticOrder {
    __device__ __forceinline__ bool next(int i, Unit& u) const { if (i >= 1) return false; u.pm = c >> 3; u.pn = c & 7; return true; }
};
typedef int v4i32_t __attribute__((ext_vector_type(4)));
typedef int v8i32_t __attribute__((ext_vector_type(8)));
__device__ __forceinline__ f32x4 mfma8(bf16x8 b0, bf16x8 b1, bf16x8 a0, bf16x8 a1, f32x4 c) {
    const v8i32_t bb = __builtin_shufflevector(__builtin_bit_cast(v4i32_t, b0), __builtin_bit_cast(v4i32_t, b1), 0, 1, 2, 3, 4, 5, 6, 7);
    const v8i32_t aa = __builtin_shufflevector(__builtin_bit_cast(v4i32_t, a0), __builtin_bit_cast(v4i32_t, a1), 0, 1, 2, 3, 4, 5, 6, 7);
    return __builtin_amdgcn_mfma_scale_f32_16x16x128_f8f6f4(bb, aa, c, 0, 0, 0, 0, 0, 0);
}
template <class Epi, class Sched, bool ALIGN_EPI = false, bool SP2 = false, bool F8 = false>
__device__ __forceinline__ void gemm_phase(PG8_LAS unsigned char* lds, const Gemm g, const Sched& S, const Epi& E) {
    const int tid = threadIdx.x, wid = __builtin_amdgcn_readfirstlane(tid >> 6), lane = tid & 63, wr = wid >> 2, wc = wid & 3, fr = lane & 15, fq = lane >> 4;
    const int K = g.K, nt = K / BK, lda = g.lda ? g.lda : K, ldb = g.ldb ? g.ldb : K;
    unsigned voffA[2], voffB[2];
#pragma unroll
    for (int i = 0; i < 2; ++i) { int R, C; stage_rc(tid * 16 + i * 8192, R, C); const int Rb = Epi::PERM ? ((R & ~31) + perm32(R & 31)) : R;
        voffA[i] = (unsigned)(R * lda + C) * 2u; voffB[i] = (unsigned)(Rb * ldb + C) * 2u; }
    const size_t kstep = (size_t)(BK * 2);
    const size_t hstepA = (size_t)HALF * lda * 2, hstepB = (size_t)HALF * ldb * 2;
    const size_t tstepA = 2 * hstepA, tstepB = 2 * hstepB;
    const unsigned ldsw = (unsigned)wid * 1024u;
    const int aoff = lds_byte(wr * 64 + fr, fq * 8), boff = lds_byte(wc * 32 + fr, fq * 8);
#define PG8_SA(b, h) (((b) * 2 + (h)) * HTB)
#define PG8_SB(b, h) ((4 + (b) * 2 + (h)) * HTB)
#define PG8_STAGE(bufoff, gbase, voff) do { _Pragma("unroll") for (int _i = 0; _i < 2; ++_i) \
        __builtin_amdgcn_global_load_lds((const unsigned*)((const char*)(gbase) + (voff)[_i]), (PG8_LAS unsigned*)(lds + (bufoff) + ldsw + _i * 8192), 16, 0, 0); } while (0)
#define PG8_LD8(addr) __builtin_shufflevector(*(const PG8_LAS v4i32_t*)(addr), *(const PG8_LAS v4i32_t*)((addr) + 1024), 0, 1, 2, 3, 4, 5, 6, 7)
#define PG8_LDA(dst, b, h) do { if constexpr (F8) { _Pragma("unroll") for (int m = 0; m < 4; ++m) dst##8[m] = PG8_LD8(lds + PG8_SA(b, h) + aoff + m * 2048); } else { \
        _Pragma("unroll") for (int m = 0; m < 4; ++m) _Pragma("unroll") for (int k = 0; k < 2; ++k) dst[m][k] = *(const PG8_LAS bf16x8*)(lds + PG8_SA(b, h) + aoff + m * 2048 + k * 1024); } } while (0)
#define PG8_LDB(dst, b, h) do { if constexpr (F8) { _Pragma("unroll") for (int n = 0; n < 2; ++n) dst##8[n] = PG8_LD8(lds + PG8_SB(b, h) + boff + n * 2048); } else { \
        _Pragma("unroll") for (int n = 0; n < 2; ++n) _Pragma("unroll") for (int k = 0; k < 2; ++k) dst[n][k] = *(const PG8_LAS bf16x8*)(lds + PG8_SB(b, h) + boff + n * 2048 + k * 1024); } } while (0)
#define PG8_MMA(ai, bj, At, Bt) do { __builtin_amdgcn_s_setprio(1); \
        if constexpr (F8) { _Pragma("unroll") for (int m = 0; m < 4; ++m) _Pragma("unroll") for (int n = 0; n < 2; ++n) asm volatile("v_mfma_f32_16x16x128_f8f6f4 %0, %1, %2, %0" : "+v"(acc[ai][bj][m][n]) : "v"(Bt##8[n]), "v"(At##8[m])); } \
        else { _Pragma("unroll") for (int m = 0; m < 4; ++m) _Pragma("unroll") for (int n = 0; n < 2; ++n) _Pragma("unroll") for (int k = 0; k < 2; ++k) \
        acc[ai][bj][m][n] = __builtin_amdgcn_mfma_f32_16x16x32_bf16(Bt[n][k], At[m][k], acc[ai][bj][m][n], 0, 0, 0); } __builtin_amdgcn_s_setprio(0); } while (0)
#define PG8_WAIT_V(n) asm volatile("s_waitcnt vmcnt(" #n ")" ::: "memory")
#define PG8_WAIT_L(n) asm volatile("s_waitcnt lgkmcnt(" #n ")" ::: "memory")
#define PG8_BAR __builtin_amdgcn_s_barrier()
#define PG8_SCHED __builtin_amdgcn_sched_barrier(0)
    Unit cur, nxt; int ui = 0;
    if (!S.next(0, cur)) return;
    f32x4 acc[2][2][4][2];
#pragma unroll
    for (int a = 0; a < 2; ++a)
#pragma unroll
        for (int b = 0; b < 2; ++b)
#pragma unroll
            for (int m = 0; m < 4; ++m)
#pragma unroll
                for (int n = 0; n < 2; ++n) acc[a][b][m][n] = (f32x4){0.f, 0.f, 0.f, 0.f};
    bf16x8 At[4][2], B0[2][2], B1[2][2]; v8i32_t At8[4], B08[2], B18[2];
    const char* cA = (const char*)g.A + (size_t)S.arow(cur) * lda * 2; const char* cB = (const char*)g.Bt + (size_t)cur.pn * tstepB;
    S.a_ready(cur);
    if constexpr (SP2) {
        PG8_STAGE(PG8_SB(0, 0), cB, voffB); PG8_STAGE(PG8_SB(0, 1), cB + hstepB, voffB); PG8_STAGE(PG8_SA(0, 0), cA, voffA); PG8_STAGE(PG8_SA(0, 1), cA + hstepA, voffA);
        if (wr == 1) PG8_BAR;
        PG8_WAIT_V(2); PG8_BAR;
        PG8_STAGE(PG8_SB(1, 0), cB + kstep, voffB); PG8_STAGE(PG8_SA(1, 0), cA + kstep, voffA); PG8_STAGE(PG8_SB(1, 1), cB + hstepB + kstep, voffB);
        PG8_WAIT_V(6); PG8_BAR;
    } else {
        PG8_STAGE(PG8_SB(0, 0), cB, voffB); PG8_STAGE(PG8_SA(0, 0), cA, voffA); PG8_STAGE(PG8_SB(0, 1), cB + hstepB, voffB); PG8_STAGE(PG8_SA(0, 1), cA + hstepA, voffA);
        if (wr == 1) PG8_BAR;
        PG8_WAIT_V(4); PG8_BAR;
        PG8_STAGE(PG8_SB(1, 0), cB + kstep, voffB); PG8_STAGE(PG8_SA(1, 0), cA + kstep, voffA); PG8_STAGE(PG8_SB(1, 1), cB + hstepB + kstep, voffB);
        PG8_WAIT_V(6); PG8_BAR;
    }
    for (;;) {
        const bool has_next = S.next(ui + 1, nxt);
        const char* nA = has_next ? (const char*)g.A + (size_t)S.arow(nxt) * lda * 2 : cA; const char* nB = has_next ? (const char*)g.Bt + (size_t)nxt.pn * tstepB : cB;
        for (int t = 0; t < nt; t += 2) {
            const bool last = (t == nt - 2);
            const char* a1 = cA + (size_t)(t + 1) * kstep;
            const char* a2 = last ? nA : cA + (size_t)(t + 2) * kstep; const char* b2 = last ? nB : cB + (size_t)(t + 2) * kstep;
            const char* a3 = a2 + kstep; const char* b3 = b2 + kstep;
            if (last && has_next) S.a_ready(nxt);
            if constexpr (SP2) {
            PG8_LDB(B0, 0, 0); PG8_LDB(B1, 0, 1); PG8_SCHED; PG8_LDA(At, 0, 0); PG8_STAGE(PG8_SA(1, 1), a1 + hstepA, voffA);
            PG8_WAIT_V(8); PG8_WAIT_L(0); PG8_BAR; PG8_MMA(0, 0, At, B0); PG8_MMA(0, 1, At, B1); PG8_BAR; PG8_SCHED;
            PG8_LDA(At, 0, 1); PG8_STAGE(PG8_SB(0, 0), b2, voffB); PG8_STAGE(PG8_SB(0, 1), b2 + hstepB, voffB); PG8_STAGE(PG8_SA(0, 0), a2, voffA);
            PG8_WAIT_V(8); PG8_WAIT_L(0); PG8_BAR; PG8_MMA(1, 0, At, B0); PG8_MMA(1, 1, At, B1); PG8_BAR; PG8_SCHED;
            PG8_LDB(B0, 1, 0); PG8_LDB(B1, 1, 1); PG8_SCHED; PG8_LDA(At, 1, 0); PG8_STAGE(PG8_SA(0, 1), a2 + hstepA, voffA);
            PG8_WAIT_V(8); PG8_WAIT_L(0); PG8_BAR; PG8_MMA(0, 0, At, B0); PG8_MMA(0, 1, At, B1); PG8_BAR; PG8_SCHED;
            PG8_LDA(At, 1, 1); PG8_STAGE(PG8_SB(1, 0), b3, voffB); PG8_STAGE(PG8_SB(1, 1), b3 + hstepB, voffB); PG8_STAGE(PG8_SA(1, 0), a3, voffA);
            PG8_WAIT_V(8); PG8_WAIT_L(0); PG8_BAR; PG8_MMA(1, 0, At, B0); PG8_MMA(1, 1, At, B1); PG8_BAR; PG8_SCHED;
            } else {
            PG8_LDB(B0, 0, 0); PG8_SCHED; PG8_LDA(At, 0, 0); PG8_STAGE(PG8_SA(1, 1), a1 + hstepA, voffA);
            PG8_WAIT_L(8); PG8_BAR; PG8_WAIT_L(0); PG8_MMA(0, 0, At, B0); PG8_BAR; PG8_SCHED;
            PG8_LDB(B1, 0, 1); PG8_STAGE(PG8_SB(0, 0), b2, voffB);
            PG8_BAR; PG8_WAIT_L(0); PG8_MMA(0, 1, At, B1); PG8_BAR;
            PG8_LDA(At, 0, 1); PG8_STAGE(PG8_SA(0, 0), a2, voffA);
            PG8_BAR; PG8_WAIT_L(0); PG8_MMA(1, 0, At, B0); PG8_BAR; PG8_SCHED;
            PG8_STAGE(PG8_SB(0, 1), b2 + hstepB, voffB);
            PG8_WAIT_V(6); PG8_BAR; PG8_MMA(1, 1, At, B1); PG8_BAR;
            PG8_LDB(B0, 1, 0); PG8_SCHED; PG8_LDA(At, 1, 0); PG8_STAGE(PG8_SA(0, 1), a2 + hstepA, voffA);
            PG8_WAIT_L(8); PG8_BAR; PG8_WAIT_L(0); PG8_MMA(0, 0, At, B0); PG8_BAR; PG8_SCHED;
            PG8_LDB(B1, 1, 1); PG8_STAGE(PG8_SB(1, 0), b3, voffB);
            PG8_BAR; PG8_WAIT_L(0); PG8_MMA(0, 1, At, B1); PG8_BAR;
            PG8_LDA(At, 1, 1); PG8_STAGE(PG8_SA(1, 0), a3, voffA);
            PG8_BAR; PG8_WAIT_L(0); PG8_MMA(1, 0, At, B0); PG8_BAR; PG8_SCHED;
            PG8_STAGE(PG8_SB(1, 1), b3 + hstepB, voffB);
            PG8_WAIT_V(6); PG8_BAR; PG8_MMA(1, 1, At, B1); PG8_BAR;
            }
        }
        if constexpr (ALIGN_EPI) { if (wr == 0) PG8_BAR; }
        if constexpr (F8) {
            asm volatile("s_nop 15\n\ts_nop 15" : "+v"(acc[0][0][0][0]), "+v"(acc[0][0][0][1]), "+v"(acc[0][0][1][0]), "+v"(acc[0][0][1][1]), "+v"(acc[0][0][2][0]), "+v"(acc[0][0][2][1]), "+v"(acc[0][0][3][0]), "+v"(acc[0][0][3][1]),
                                                  "+v"(acc[0][1][0][0]), "+v"(acc[0][1][0][1]), "+v"(acc[0][1][1][0]), "+v"(acc[0][1][1][1]), "+v"(acc[0][1][2][0]), "+v"(acc[0][1][2][1]), "+v"(acc[0][1][3][0]), "+v"(acc[0][1][3][1]));
            asm volatile("" : "+v"(acc[1][0][0][0]), "+v"(acc[1][0][0][1]), "+v"(acc[1][0][1][0]), "+v"(acc[1][0][1][1]), "+v"(acc[1][0][2][0]), "+v"(acc[1][0][2][1]), "+v"(acc[1][0][3][0]), "+v"(acc[1][0][3][1]),
                              "+v"(acc[1][1][0][0]), "+v"(acc[1][1][0][1]), "+v"(acc[1][1][1][0]), "+v"(acc[1][1][1][1]), "+v"(acc[1][1][2][0]), "+v"(acc[1][1][2][1]), "+v"(acc[1][1][3][0]), "+v"(acc[1][1][3][1])); }
        if constexpr (!Epi::AFTER_DRAIN) { E(acc, cur, wr, wc, fr, fq); S.done(cur); }
        if (!has_next) break;
#pragma unroll
        for (int a = 0; a < 2; ++a)
#pragma unroll
            for (int b = 0; b < 2; ++b)
#pragma unroll
                for (int m = 0; m < 4; ++m)
#pragma unroll
                    for (int n = 0; n < 2; ++n) acc[a][b][m][n] = (f32x4){0.f, 0.f, 0.f, 0.f};
        cur = nxt; cA = nA; cB = nB; ++ui;
        if constexpr (ALIGN_EPI) { if (wr == 1) PG8_BAR; }
    }
    PG8_WAIT_V(0);
    if constexpr (!ALIGN_EPI) { if (wr == 0) PG8_BAR; }
    PG8_BAR;
    if constexpr (Epi::AFTER_DRAIN) { E.fused(acc, cur, wr, wc, fr, fq, lds, wid, lane); S.done(cur); }
#undef PG8_SA
#undef PG8_SB
#undef PG8_STAGE
#undef PG8_LDA
#undef PG8_LD8
#undef PG8_LDB
#undef PG8_MMA
#undef PG8_WAIT_V
#undef PG8_WAIT_L
#undef PG8_BAR
#undef PG8_SCHED
}
}

#ifndef PG8_SP2
#define PG8_SP2 true
#endif
#ifndef PG8_ALIGN
#define PG8_ALIGN true
#endif
#include <cmath>

constexpr int NWAVES = 8;
constexpr int NPH = 11;
#ifndef MK_N_LAUNCHES
#define MK_N_LAUNCHES 1
#endif
constexpr int N_LAUNCHES = MK_N_LAUNCHES;
static_assert(N_LAUNCHES == 1 || N_LAUNCHES == NPH, "MK_N_LAUNCHES is 1 or NPH");

constexpr int BATCH = 2, SEQ = 4096, DM = 2048, M = BATCH * SEQ;
constexpr int AH = 16, HD = 64, AW = AH * HD;
constexpr int SG = 64, SC = 16, SW = SG * SC, SP = 64;
constexpr int INC = 3 * AW + SW;
constexpr int MOBA_BLK = 256, NBLK = SEQ / MOBA_BLK, TOPK = 3;
constexpr int DFF = 5632, DFF2 = 2 * DFF;
constexpr float RMS_EPS = 1e-6f;
constexpr float LOG2E = 1.4426950408889634f;
constexpr float WSCALE = 64.0f;
constexpr float C2 = 0.125f * LOG2E;

constexpr size_t MiB = 1u << 20;
constexpr size_t WS_CTL = 0, CTL_ZERO_BYTES = 1 * MiB;
constexpr size_t WS_WDOWN = 1 * MiB;
constexpr size_t WS_WIN = 23 * MiB;
constexpr size_t WS_WGLU = 39 * MiB;
constexpr size_t WS_WOUT = 41 * MiB;
constexpr size_t WS_WUP = 49 * MiB;
constexpr size_t WS_XN = 93 * MiB;
constexpr size_t WS_Q = 125 * MiB, WS_K = 141 * MiB, WS_V = 157 * MiB;
constexpr size_t WS_Y = 173 * MiB, WS_Z = 189 * MiB;
constexpr size_t WS_A2 = 205 * MiB, WS_S = 225 * MiB, WS_BTS = 233 * MiB, WS_BT2 = 249 * MiB;
constexpr size_t WS_X1G = 289 * MiB;
constexpr size_t WS_SSQ = 321 * MiB;
constexpr size_t WS_KMEAN = 322 * MiB;
constexpr size_t WS_T5B = 323 * MiB;
constexpr size_t WS_ACT = 125 * MiB;
constexpr size_t WS_END = 324 * MiB;
static_assert(WS_ACT + (size_t)M * DFF * 2 <= WS_X1G && WS_BT2 + (size_t)SG * 512 * 640 * 2 <= WS_X1G && WS_WUP + (size_t)DFF2 * DM * 2 <= WS_XN, "d_ws map");
constexpr int CW_TMO = 0, CW_CODE = 1;
constexpr int CW_BAR = 4096;

constexpr int RING_OFF = 0, RING_BYTES = 131072;
constexpr int LDSCTL_OFF = RING_BYTES, MISC_OFF = LDSCTL_OFF + 320, XL_OFF = MISC_OFF + 128, XL_BYTES = 9216;
constexpr int LDS_BYTES = 147456;
static_assert(XL_OFF % 16 == 0 && XL_OFF + XL_BYTES <= LDS_BYTES, "LDS map");

#include <hip/hip_bf16.h>
#include <cmath>
namespace attn_body {
using bf16=__hip_bfloat16;
using bf16x8=__attribute__((ext_vector_type(8)))short;
using s16x4=__attribute__((ext_vector_type(4)))short;
using f32x16=__attribute__((ext_vector_type(16)))float;
using u32x4=__attribute__((ext_vector_type(4)))unsigned;
using f32x4_=__attribute__((ext_vector_type(4)))float;
constexpr int BATCH=2,NHEAD=16,SEQ=4096,D=64,DM=NHEAD*D;
constexpr int NW=8,QBLK=32,QB=QBLK*NW,KVBLK=64,NQB=SEQ/QB;
constexpr int ATTN_PITCH=DM, ATTN_UNIT_ROWS=QB;
__device__ __forceinline__ int crow(int r,int hi){return (r&3)+8*(r>>2)+4*hi;}
#define SBAR() __builtin_amdgcn_sched_barrier(0)
__device__ __forceinline__ void cmask(f32x16&p0,f32x16&p1,int jb,int qrel,int hi){
  const float NEG=-INFINITY; int kb=64*jb+4*hi;
  #pragma unroll
  for(int r=0;r<16;++r){int kv=kb+(r&3)+8*(r>>2); if(kv>qrel)p0[r]=NEG; if(kv+32>qrel)p1[r]=NEG;}
}

typedef __attribute__((address_space(3))) const float* lds_cfptr;
__device__ __forceinline__ void abias(f32x16&p0,f32x16&p1,int jb,int qrel,int hi,int wid,lds_cfptr Tp){
  if(32*wid-64*jb-63>=113)return;
  const lds_cfptr tb=Tp+(255-59+qrel-64*jb-4*hi);
  #pragma unroll
  for(int r=0;r<16;++r){ p0[r]+=tb[59-((r&3)+8*(r>>2))]; p1[r]+=tb[27-((r&3)+8*(r>>2))]; }
}
constexpr int NSLOT=3, SLOTB=8192;
constexpr int LDS_K=0, LDS_V=NSLOT*SLOTB, LDS_WS=2*NSLOT*SLOTB, LDS_OST=LDS_WS+NW*64*4, LDS_KM=LDS_OST+NW*4096, LDS_BIAS=LDS_KM+4096, LDS_BYTES=LDS_BIAS+2560;
constexpr float C2=0.125f*1.4426950408889634f;
__device__ __forceinline__ void glds16(const void*gsrc,unsigned lds_dst){unsigned keep;
  asm volatile("s_mov_b32 %0, m0\n\ts_mov_b32 m0, %2\n\ts_nop 0\n\tglobal_load_lds_dwordx4 %1, off\n\ts_mov_b32 m0, %0":"=&s"(keep):"v"(gsrc),"s"(lds_dst):"memory");}
__device__ __forceinline__ float max3f(float a,float b,float c){float r;asm("v_max3_f32 %0, %1, %2, %3":"=v"(r):"v"(a),"v"(b),"v"(c));return r;}
__device__ __forceinline__ float max2f(float a,float b){float r;asm("v_max_f32_e32 %0, %1, %2":"=v"(r):"v"(a),"v"(b));return r;}
__device__ __forceinline__ float fadd_s(float a,float b){float r;asm("v_add_f32_e32 %0, %1, %2":"=v"(r):"v"(a),"v"(b));return r;}
__device__ __forceinline__ float fsub_s(float a,float b){float r;asm("v_sub_f32_e32 %0, %1, %2":"=v"(r):"v"(a),"v"(b));return r;}
typedef float f32x2_t __attribute__((ext_vector_type(2))); typedef __bf16 bf16x2_t __attribute__((ext_vector_type(2)));
__device__ __forceinline__ unsigned cvtpk_s(float lo,float hi){f32x2_t v={lo,hi};bf16x2_t b=__builtin_convertvector(v,bf16x2_t);return __builtin_bit_cast(unsigned,b);}
#define WAIT_BAR(N) asm volatile("s_waitcnt vmcnt(" #N ") lgkmcnt(0)\n\ts_barrier":::"memory")

__device__ __forceinline__ void qkt(f32x16&p0,f32x16&p1,const char*Kslot,const bf16x8*qr,const f32x16&negm,int r32,int hi){
  const char*kb=Kslot+hi*1024+r32*16;
  #pragma unroll
  for(int d0=0;d0<4;++d0){
    const bf16x8 b0=*reinterpret_cast<const bf16x8*>(kb+d0*2048);
    const bf16x8 b1=*reinterpret_cast<const bf16x8*>(kb+d0*2048+512);
    if(d0==0){p0=__builtin_amdgcn_mfma_f32_32x32x16_bf16(b0,qr[0],negm,0,0,0);p1=__builtin_amdgcn_mfma_f32_32x32x16_bf16(b1,qr[0],negm,0,0,0);}
    else{p0=__builtin_amdgcn_mfma_f32_32x32x16_bf16(b0,qr[d0],p0,0,0,0);p1=__builtin_amdgcn_mfma_f32_32x32x16_bf16(b1,qr[d0],p1,0,0,0);}}
}
typedef __attribute__((address_space(3))) const char* lds_cptr;
typedef short v4i16_t __attribute__((ext_vector_type(4)));
__device__ __forceinline__ void kload8(bf16x8*kf,lds_cptr kp){
  kf[0]=*(const __attribute__((address_space(3))) bf16x8*)(kp);      kf[1]=*(const __attribute__((address_space(3))) bf16x8*)(kp+512);
  kf[2]=*(const __attribute__((address_space(3))) bf16x8*)(kp+2048); kf[3]=*(const __attribute__((address_space(3))) bf16x8*)(kp+2560);
  kf[4]=*(const __attribute__((address_space(3))) bf16x8*)(kp+4096); kf[5]=*(const __attribute__((address_space(3))) bf16x8*)(kp+4608);
  kf[6]=*(const __attribute__((address_space(3))) bf16x8*)(kp+6144); kf[7]=*(const __attribute__((address_space(3))) bf16x8*)(kp+6656);
}
__device__ __forceinline__ void kload2(bf16x8*kf,lds_cptr kp,int j){ kf[2*j]=*(const __attribute__((address_space(3))) bf16x8*)(kp+j*2048); kf[2*j+1]=*(const __attribute__((address_space(3))) bf16x8*)(kp+j*2048+512); }
__device__ __forceinline__ s16x4 vtr(lds_cptr p){ return __builtin_bit_cast(s16x4,__builtin_amdgcn_ds_read_tr16_b64_v4i16((__attribute__((address_space(3))) v4i16_t*)p)); }
__device__ __forceinline__ float rowmax(const f32x16&p0,const f32x16&p1){
  float a=max3f(p0[0],p0[1],p1[0]),b=max3f(p0[2],p0[3],p1[1]);a=max3f(a,p1[2],p1[3]);
  #pragma unroll
  for(int r=4;r<16;r+=4){a=max3f(a,p0[r],p0[r+1]);b=max3f(b,p0[r+2],p0[r+3]);a=max3f(a,p1[r],p1[r+1]);b=max3f(b,p1[r+2],p1[r+3]);}
  const float m=max2f(a,b);
  auto rr=__builtin_amdgcn_permlane32_swap(__float_as_uint(m),__float_as_uint(m),false,false);
  return max2f(__uint_as_float(rr[0]),__uint_as_float(rr[1]));
}
__device__ __forceinline__ void pv(f32x16*o,int vb,bf16x8 pa0,bf16x8 pa1,bf16x8 pa2,bf16x8 pa3){
  #pragma unroll
  for(int d0=0;d0<2;++d0){s16x4 lo[4],hi[4];
    #pragma unroll
    for(int ks=0;ks<4;++ks){
      asm volatile("ds_read_b64_tr_b16 %0,%1 offset:%c2":"=&v"(lo[ks]):"v"(vb),"i"(d0*4096+ks*1024):"memory");
      asm volatile("ds_read_b64_tr_b16 %0,%1 offset:%c2":"=&v"(hi[ks]):"v"(vb),"i"(d0*4096+ks*1024+512):"memory");}
    asm volatile("s_waitcnt lgkmcnt(0)":::"memory");SBAR();
    #define PK(k) (bf16x8){lo[k][0],lo[k][1],lo[k][2],lo[k][3],hi[k][0],hi[k][1],hi[k][2],hi[k][3]}
    o[d0]=__builtin_amdgcn_mfma_f32_32x32x16_bf16(pa0,PK(0),o[d0],0,0,0);
    o[d0]=__builtin_amdgcn_mfma_f32_32x32x16_bf16(pa1,PK(1),o[d0],0,0,0);
    o[d0]=__builtin_amdgcn_mfma_f32_32x32x16_bf16(pa2,PK(2),o[d0],0,0,0);
    o[d0]=__builtin_amdgcn_mfma_f32_32x32x16_bf16(pa3,PK(3),o[d0],0,0,0);
    #undef PK
  }
}

#ifndef ATTN_STORE16
#define ATTN_STORE16(p,v) (*(u32x4*)(p)=(v))
#endif
template<int THRL> __device__ __forceinline__ void attn_unit(int b,int h,int qb,const bf16*Q,const bf16*__restrict__ K,const bf16*__restrict__ V,bf16*O,const float*KM,const float*TB,char*shm){
  int tid_=threadIdx.x; asm volatile("":"+v"(tid_));
  const int tid=tid_,lane=tid&63,r32=lane&31,hi=lane>>5; const int wid=__builtin_amdgcn_readfirstlane(tid>>6);
  const long rowbase=(long)b*SEQ; const int q0=qb*QB;
  const bf16*Qw=Q+(rowbase+q0+wid*QBLK)*DM+h*D;
  const bf16*Kh=K+rowbase*DM+h*D,*Vh=V+rowbase*DM+h*D;
  const unsigned lds0=(unsigned)(uintptr_t)shm;
  float*wsf=(float*)(shm+LDS_WS)+wid*64;
  const bf16*ksrc=Kh+(long)lane*DM+wid*8;
  const bf16*vsrc=Vh+(long)(16*(wid&3)+(lane>>2))*DM+(wid>>2)*32+(lane&3)*8;
  const unsigned kdst=lds0+LDS_K+wid*1024, vdst=lds0+LDS_V+wid*1024;
  #define DMA_K(t,slot) glds16(ksrc+(long)(t)*KVBLK*DM,(unsigned)__builtin_amdgcn_readfirstlane(kdst+(slot)))
  #define DMA_V(t,slot) glds16(vsrc+(long)(t)*KVBLK*DM,(unsigned)__builtin_amdgcn_readfirstlane(vdst+(slot)))
  const int vb0=(int)(lds0+LDS_V)+((lane>>4)&1)*32+(lane&3)*8+(4*hi+((lane&15)>>2))*64;
  const char*Kbase=shm+LDS_K; bf16x8 kf[8];
  const lds_cptr shm3=(lds_cptr)shm; const lds_cptr kp0=shm3+LDS_K+hi*1024+r32*16; const lds_cptr vp0=shm3+LDS_V+((lane>>4)&1)*32+(lane&3)*8+(4*hi+((lane&15)>>2))*64;
  const int NT=(q0+QB)/KVBLK;
  DMA_K(0,0);DMA_V(0,0);DMA_K(1,SLOTB);
  bf16x8 qr[4];
  #pragma unroll
  for(int d0=0;d0<4;++d0)qr[d0]=*reinterpret_cast<const bf16x8*>(&Qw[(long)r32*DM+d0*16+hi*8]);
  { typedef float f32x2_ __attribute__((ext_vector_type(2))); int tid2=tid; asm volatile("":"+v"(tid2));
    *(__attribute__((address_space(3))) f32x2_*)((__attribute__((address_space(3))) char*)shm3+LDS_KM+tid2*8)=*(const f32x2_*)(KM+tid2*2);
    for(int i_=tid2;i_<640;i_+=512){ const int d_=i_-255; *(__attribute__((address_space(3))) float*)((__attribute__((address_space(3))) char*)shm3+LDS_BIAS+i_*4)=(d_>=0&&d_<128)?TB[d_]-TB[511]:0.f; } }
  const lds_cfptr Tb=(lds_cfptr)(shm3+LDS_BIAS);
  float mhat=0.f,l_reg=0.f;f32x16 o[2];o[0]=f32x16{};o[1]=f32x16{};f32x16 negm=f32x16{};asm volatile("":"+v"(negm));
  unsigned selm=1u<<qb;
  #define NEGM_SET(tn) do{ const float cv_=((selm>>((tn)>>2))&1u)?-mhat:-INFINITY; _Pragma("unroll") for(int r=0;r<16;++r)negm[r]=cv_; asm volatile("":"+v"(negm)); }while(0)
  const int qrel=wid*QBLK+r32;
  #define CMASK(P0,P1,t) do{int jb_=(t)-(NT-4); if(jb_>=-2){int q2_=qrel,h2_=hi; asm volatile("":"+v"(q2_),"+v"(h2_)); abias(P0,P1,jb_,q2_,h2_,wid,Tb);} if(jb_>=0)cmask(P0,P1,jb_,qrel,hi);}while(0)
  bool resc=false;
  #define START(P0,P1) do{ const float rm=rowmax(P0,P1); resc=false; \
    { const float dl=(rm>-1e30f)?rm:0.f; mhat=fadd_s(mhat,dl); \
      _Pragma("unroll") for(int r=0;r<16;++r){P0[r]=fsub_s(P0[r],dl);P1[r]=fsub_s(P1[r],dl);} \
      NEGM_SET(1); } \
    _Pragma("unroll") for(int r=0;r<16;++r)P0[r]=__builtin_amdgcn_exp2f(P0[r]); }while(0)
  #define RESC() do{ if(resc){ asm volatile("s_waitcnt lgkmcnt(0)":::"memory"); \
      _Pragma("unroll") for(int d_=0;d_<2;++d_) _Pragma("unroll") for(int r=0;r<16;++r)o[d_][r]*=wsf[crow(r,hi)]; } }while(0)
  f32x16 pA0,pA1,pB0,pB1;
  int sl_prev=0,sl_cur=0,sl_next=SLOTB;
  #define ROT() do{sl_prev=sl_cur;sl_cur=sl_next;sl_next=(sl_next==(NSLOT-1)*SLOTB)?0:sl_next+SLOTB;}while(0)
  DMA_K(2,2*SLOTB);
  WAIT_BAR(3);
  { float qf[32]; int hi2=hi; asm volatile("":"+v"(hi2));
    #pragma unroll
    for(int d0=0;d0<4;++d0)
      #pragma unroll
      for(int j=0;j<8;++j)qf[d0*8+j]=__uint_as_float(((unsigned)(unsigned short)qr[d0][j])<<16);
    float v1=-INFINITY,v2=-INFINITY,v3=-INFINITY; int i1=-1,i2=-1,i3=-1;
    const __attribute__((address_space(3))) float* kml=(const __attribute__((address_space(3))) float*)(shm3+LDS_KM)+8*hi2;
    for(int n=0;n<qb;++n){ float a=0.f;
      #pragma unroll
      for(int d0=0;d0<4;++d0){ const f32x4_ k0=*(const __attribute__((address_space(3))) f32x4_*)(kml+n*64+16*d0), k1=*(const __attribute__((address_space(3))) f32x4_*)(kml+n*64+16*d0+4);
        a+=qf[d0*8+0]*k0[0]+qf[d0*8+1]*k0[1]+qf[d0*8+2]*k0[2]+qf[d0*8+3]*k0[3]+qf[d0*8+4]*k1[0]+qf[d0*8+5]*k1[1]+qf[d0*8+6]*k1[2]+qf[d0*8+7]*k1[3]; }
      { auto rr=__builtin_amdgcn_permlane32_swap(__float_as_uint(a),__float_as_uint(a),false,false); a=__uint_as_float(rr[0])+__uint_as_float(rr[1]); }
      if(a>v1){v3=v2;i3=i2;v2=v1;i2=i1;v1=a;i1=n;} else if(a>v2){v3=v2;i3=i2;v2=a;i2=n;} else if(a>v3){v3=a;i3=n;} }
    if(i1>=0)selm|=1u<<i1; if(i2>=0)selm|=1u<<i2; if(i3>=0)selm|=1u<<i3; }
  NEGM_SET(0);
  qkt(pA0,pA1,Kbase,qr,negm,r32,hi);asm volatile("s_nop 15\n\ts_nop 7":"+v"(pA0),"+v"(pA1));CMASK(pA0,pA1,0);
  START(pA0,pA1);
  _Pragma("unroll") for(int r=0;r<16;++r)pA1[r]=__builtin_amdgcn_exp2f(pA1[r]);
  WAIT_BAR(0);
  DMA_K(3,0);DMA_V(1,SLOTB);
  ROT();
  kload8(kf,kp0+sl_cur);
  WAIT_BAR(2);
  s16x4 vlo[8],vhi[8]; u32x4 pw0,pw1,pw2,pw3;
  #define PKW(P,B) cvtpk_s(P[B],P[B+1])
  #define PAF(k) __builtin_bit_cast(bf16x8,pw##k)
  #define VFR(i) (bf16x8){vlo[i][0],vlo[i][1],vlo[i][2],vlo[i][3],vhi[i][0],vhi[i][1],vhi[i][2],vhi[i][3]}
  #define PIN(x) asm volatile("":"+v"(x))
  #define MX3(a,b,c) __builtin_fmaxf(__builtin_fmaxf((a),(b)),(c))
  #define GAPA(MF,A0,A1,A2,A3,W0,W1,PW) do{ MF; sacc+=A0; sacc+=A1; sacc+=A2; sacc+=A3; PIN(sacc); W0; W1; PIN(PW); SBAR(); }while(0)
  #define EX(v) __builtin_amdgcn_exp2f(v)
  #define GAPB(MF,X,B) do{ MF; X[B]=EX(X[B]); X[B+1]=EX(X[B+1]); X[B+2]=EX(X[B+2]); X[B+3]=EX(X[B+3]); PIN(X); SBAR(); }while(0)
  #define VRD(i) do{ vlo[i]=vtr(vp_+(((i)>>2)*4096+((i)&3)*1024)); vhi[i]=vtr(vp_+(((i)>>2)*4096+((i)&3)*1024+512)); }while(0)
  #define KRD(G,j) do{ if(G){ kload2(kf,kp0+sl_next,j); SBAR(); } }while(0)
  #define STEP(C0,C1,P0,P1,t,GK,GV,GL) do{ SBAR(); \
    const lds_cptr vp_=vp0+sl_prev; \
    VRD(0); SBAR(); float sacc=(P0[0]+P0[1]); \
    GAPA(C0=__builtin_amdgcn_mfma_f32_32x32x16_bf16(kf[0],qr[0],negm,0,0,0), P0[2],P0[3],P0[4],P0[5],     pw0[0]=PKW(P0,0), pw0[1]=PKW(P0,2), pw0); \
    VRD(4); SBAR(); GAPA(C1=__builtin_amdgcn_mfma_f32_32x32x16_bf16(kf[1],qr[0],negm,0,0,0), P0[6],P0[7],P0[8],P0[9],     pw0[2]=PKW(P0,4), pw0[3]=PKW(P0,6), pw0); \
    VRD(1); SBAR(); GAPA(C0=__builtin_amdgcn_mfma_f32_32x32x16_bf16(kf[2],qr[1],C0,0,0,0),   P0[10],P0[11],P0[12],P0[13], pw1[0]=PKW(P0,8), pw1[1]=PKW(P0,10), pw1); \
    VRD(5); SBAR(); GAPA(C1=__builtin_amdgcn_mfma_f32_32x32x16_bf16(kf[3],qr[1],C1,0,0,0),   P0[14],P0[15],P1[0],P1[1],   pw1[2]=PKW(P0,12),pw1[3]=PKW(P0,14), pw1); \
    VRD(2); SBAR(); GAPA(C0=__builtin_amdgcn_mfma_f32_32x32x16_bf16(kf[4],qr[2],C0,0,0,0),   P1[2],P1[3],P1[4],P1[5],     pw2[0]=PKW(P1,0), pw2[1]=PKW(P1,2), pw2); \
    VRD(6); SBAR(); GAPA(C1=__builtin_amdgcn_mfma_f32_32x32x16_bf16(kf[5],qr[2],C1,0,0,0),   P1[6],P1[7],P1[8],P1[9],     pw2[2]=PKW(P1,4), pw2[3]=PKW(P1,6), pw2); \
    VRD(3); SBAR(); GAPA(C0=__builtin_amdgcn_mfma_f32_32x32x16_bf16(kf[6],qr[3],C0,0,0,0),   P1[10],P1[11],P1[12],P1[13], pw3[0]=PKW(P1,8), pw3[1]=PKW(P1,10), pw3); \
    VRD(7); SBAR(); GAPA(C1=__builtin_amdgcn_mfma_f32_32x32x16_bf16(kf[7],qr[3],C1,0,0,0),   P1[14],P1[15],0.f,0.f,       pw3[2]=PKW(P1,12),pw3[3]=PKW(P1,14), pw3); \
    l_reg+=sacc; \
    if(GK){DMA_K((t)+3,sl_cur);} if(GV){DMA_V((t)+1,sl_next);} \
    CMASK(C0,C1,t); \
    { float a=MX3(C0[0],C0[1],C1[0]),b=MX3(C0[2],C0[3],C1[1]); a=MX3(a,C1[2],C1[3]); \
      _Pragma("unroll") for(int r=4;r<16;r+=4){a=MX3(a,C0[r],C0[r+1]);b=MX3(b,C0[r+2],C0[r+3]);a=MX3(a,C1[r],C1[r+1]);b=MX3(b,C1[r+2],C1[r+3]);} \
      float rm=__builtin_fmaxf(a,b); { auto rr=__builtin_amdgcn_permlane32_swap(__float_as_uint(rm),__float_as_uint(rm),false,false); rm=__builtin_fmaxf(__uint_as_float(rr[0]),__uint_as_float(rr[1])); } \
      resc=false; \
      if(__builtin_expect(__any(rm>(float)THRL),0)){ const float dl=__builtin_fmaxf(rm,0.f); mhat+=dl; \
        _Pragma("unroll") for(int r=0;r<16;++r){C0[r]-=dl;C1[r]-=dl;} \
        const float f=__builtin_amdgcn_exp2f(-dl); l_reg*=f; if(hi==0)wsf[r32]=f; resc=true; } \
      if(resc||((((t)+1)&3)==0)){ NEGM_SET((t)+1); } } \
    SBAR(); \
    GAPB(o[0]=__builtin_amdgcn_mfma_f32_32x32x16_bf16(PAF(0),VFR(0),o[0],0,0,0), C0,0); \
    GAPB(o[1]=__builtin_amdgcn_mfma_f32_32x32x16_bf16(PAF(0),VFR(4),o[1],0,0,0), C0,4); \
    KRD(GL,0); GAPB(o[0]=__builtin_amdgcn_mfma_f32_32x32x16_bf16(PAF(1),VFR(1),o[0],0,0,0), C0,8); \
    KRD(GL,1); GAPB(o[1]=__builtin_amdgcn_mfma_f32_32x32x16_bf16(PAF(1),VFR(5),o[1],0,0,0), C0,12); \
    KRD(GL,2); GAPB(o[0]=__builtin_amdgcn_mfma_f32_32x32x16_bf16(PAF(2),VFR(2),o[0],0,0,0), C1,0); \
    KRD(GL,3); GAPB(o[1]=__builtin_amdgcn_mfma_f32_32x32x16_bf16(PAF(2),VFR(6),o[1],0,0,0), C1,4); \
    GAPB(o[0]=__builtin_amdgcn_mfma_f32_32x32x16_bf16(PAF(3),VFR(3),o[0],0,0,0), C1,8); \
    GAPB(o[1]=__builtin_amdgcn_mfma_f32_32x32x16_bf16(PAF(3),VFR(7),o[1],0,0,0), C1,12); \
    }while(0)
  int t=1;
  #undef CMASK
  #define CMASK(P0,P1,t) do{}while(0)
  for(;t+7<NT;t+=2){
    STEP(pB0,pB1,pA0,pA1,t,true,true,true);     WAIT_BAR(2); RESC(); ROT();
    STEP(pA0,pA1,pB0,pB1,t+1,true,true,true);   WAIT_BAR(2); RESC(); ROT();
  }
  #undef CMASK
  #define CMASK(P0,P1,t) do{int jb_=(t)-(NT-4); if(jb_>=-2){int q2_=qrel,h2_=hi; asm volatile("":"+v"(q2_),"+v"(h2_)); abias(P0,P1,jb_,q2_,h2_,wid,Tb);} if(jb_>=0)cmask(P0,P1,jb_,qrel,hi);}while(0)
  #define ENDW(tt) do{ if((tt)+3<NT){WAIT_BAR(2);} else if((tt)+2<NT){WAIT_BAR(1);} else {WAIT_BAR(0);} }while(0)
  for(;t+1<NT;t+=2){
    STEP(pB0,pB1,pA0,pA1,t,(t+3<NT),(t+1<NT),(t+1<NT));       ENDW(t);   RESC(); ROT();
    STEP(pA0,pA1,pB0,pB1,t+1,(t+4<NT),(t+2<NT),(t+2<NT));     ENDW(t+1); RESC(); ROT();
  }
  STEP(pB0,pB1,pA0,pA1,NT-1,false,false,false); RESC();
  { float sacc=pB0[0]+pB0[1]; _Pragma("unroll") for(int r=2;r<16;++r)sacc+=pB0[r]; _Pragma("unroll") for(int r=0;r<16;++r)sacc+=pB1[r]; l_reg+=sacc;
    pw0=(u32x4){PKW(pB0,0),PKW(pB0,2),PKW(pB0,4),PKW(pB0,6)};pw1=(u32x4){PKW(pB0,8),PKW(pB0,10),PKW(pB0,12),PKW(pB0,14)};pw2=(u32x4){PKW(pB1,0),PKW(pB1,2),PKW(pB1,4),PKW(pB1,6)};pw3=(u32x4){PKW(pB1,8),PKW(pB1,10),PKW(pB1,12),PKW(pB1,14)};
    SBAR(); pv(o,vb0+sl_cur,PAF(0),PAF(1),PAF(2),PAF(3)); }
  #undef PKW
  #undef PAF
  #undef VFR
  #undef PIN
  #undef MX3
  #undef GAPA
  #undef GAPB
  #undef EX
  #undef VRD
  #undef KRD
  #undef STEP
  #undef ENDW
  {auto rr=__builtin_amdgcn_permlane32_swap(__float_as_uint(l_reg),__float_as_uint(l_reg),false,false);l_reg=__uint_as_float(rr[0])+__uint_as_float(rr[1]);}
  if(hi==0)wsf[32+r32]=l_reg;asm volatile("s_waitcnt lgkmcnt(0)":::"memory");
  float rli[16];
  #pragma unroll
  for(int r=0;r<16;++r)rli[r]=__builtin_amdgcn_rcpf(wsf[32+crow(r,hi)]);
  bf16*Ow=O+(rowbase+q0+wid*QBLK)*DM+h*D;
  { bf16*stg=(bf16*)(shm+LDS_OST)+wid*2048;
    #pragma unroll
    for(int r=0;r<16;++r){const int orow=crow(r,hi);
      #pragma unroll
      for(int d0=0;d0<2;++d0)stg[orow*64+d0*32+r32]=__float2bfloat16(o[d0][r]*rli[r]);}
    asm volatile("s_waitcnt lgkmcnt(0)":::"memory");
    #pragma unroll
    for(int i=0;i<4;++i){const int row=i*8+(lane>>3),ch=lane&7; const u32x4 v=*(const u32x4*)(stg+row*64+ch*8); ATTN_STORE16(Ow+(long)row*DM+ch*8,v);} }
  asm volatile("s_waitcnt lgkmcnt(0)\n\ts_barrier":::"memory");
  #undef DMA_K
  #undef DMA_V
  #undef CMASK
  #undef START
  #undef RESC
  #undef ROT
  #undef NEGM_SET
}
constexpr int ATTN_LDS_BYTES=LDS_BYTES;
struct AttnTensors { const bf16* Q; const bf16* K; const bf16* V; bf16* O; const float* KM; const float* TB; };
struct AttnUnit { int bh; int qb; };
struct StaticOrder {
  int vcu,G;
  __device__ __forceinline__ explicit StaticOrder(int grid,int block):vcu((grid%8==0)?(block%8)*(grid/8)+block/8:block),G(grid){}
  __device__ __forceinline__ bool next(int i,AttnUnit&u)const{ const int p=vcu+(i>>1)*G; if(p>=BATCH*NHEAD*8)return false; const int s=p&7; u.bh=p>>3; u.qb=(i&1)?15-s:s; return true; }
  __device__ __forceinline__ void a_ready(const AttnUnit&)const{}
  __device__ __forceinline__ void done(const AttnUnit&)const{}
};
template<class Sched,int THRL=8> __device__ __forceinline__ void attn_phase(char*lds,const AttnTensors&T,const Sched&S){
  AttnUnit u;
  for(int i=0;S.next(i,u);++i){ S.a_ready(u); attn_unit<THRL>(u.bh/NHEAD,u.bh%NHEAD,u.qb,T.Q,T.K,T.V,T.O,T.KM+(size_t)u.bh*(16*64),T.TB+(u.bh%NHEAD)*512,lds); S.done(u); }
}
#undef SBAR
#undef WAIT_BAR
}
#define GAS __attribute__((address_space(1)))
#define LAS __attribute__((address_space(3)))
typedef unsigned short bf16;
typedef unsigned v4u __attribute__((ext_vector_type(4)));
typedef unsigned v2u __attribute__((ext_vector_type(2)));
typedef float f32x4 __attribute__((ext_vector_type(4)));
typedef short bf16x8 __attribute__((ext_vector_type(8)));
typedef GAS unsigned gu32;
typedef GAS unsigned long long gu64;
#define RLX_AGENT __ATOMIC_RELAXED, __HIP_MEMORY_SCOPE_AGENT
#define LDS_WAIT() asm volatile("s_waitcnt lgkmcnt(0)" ::: "memory")
#define VM_WAIT() asm volatile("s_waitcnt vmcnt(0)" ::: "memory")
__device__ __forceinline__ unsigned long long rt() { return __builtin_amdgcn_s_memrealtime(); }
__device__ __forceinline__ unsigned f2bf(float f) { unsigned u = __builtin_bit_cast(unsigned, f); return (u + 0x7fffu + ((u >> 16) & 1u)) >> 16; }
__device__ __forceinline__ unsigned pk2(float lo, float hi) { return f2bf(lo) | (f2bf(hi) << 16); }

#define XB_TMO      128
#define XB_XCNT(j)  (256  + 64 * (j))
#define XB_XSUB(j)  (1280 + 64 * (j))
#define XB_XGEN(j)  (2304 + 64 * (j))
#define XB_TOP      3328
#define XB_TOPGEN   3392
#define XCD_BAR_WORDS 3456
#define XB_SPIN_CAP (1u << 18)

__device__ __forceinline__ unsigned xb_ld(unsigned* p)              { return __hip_atomic_load(p, __ATOMIC_RELAXED, __HIP_MEMORY_SCOPE_AGENT); }
__device__ __forceinline__ unsigned xb_add(unsigned* p, unsigned v) { return __hip_atomic_fetch_add(p, v, __ATOMIC_RELAXED, __HIP_MEMORY_SCOPE_AGENT); }
__device__ __forceinline__ unsigned xb_xcc_id() { return (unsigned)__builtin_amdgcn_s_getreg((3 << 11) | 20) & 0xFu; }
#define XB_SPIN(cond, bar) do { unsigned _sp = 0; while (cond) { __builtin_amdgcn_s_sleep(1); \
    if ((++_sp & 255u) == 0u) { if (xb_ld(&(bar)[XB_TMO])) break; if (_sp > XB_SPIN_CAP) { atomicAdd(&(bar)[XB_TMO], 1u); break; } } } } while (0)

struct XcdBarrier {
    unsigned* bar; unsigned x;
    volatile LAS unsigned* st;
};

__device__ __forceinline__ XcdBarrier xcd_barrier_post(unsigned* bar, volatile LAS unsigned* st) {
    XcdBarrier b; b.bar = bar; b.x = xb_xcc_id(); b.st = st;
    if (threadIdx.x == 0) (void)xb_add(&bar[XB_XCNT(b.x)], 1u);
    return b;
}
__device__ __forceinline__ void xcd_barrier_complete(unsigned* bar, unsigned x, unsigned& nloc, unsigned& nx) {
    const unsigned G = gridDim.x * gridDim.y * gridDim.z;
    unsigned sum, cnt, mine, sp = 0u;
    for (;;) {
        sum = 0u; cnt = 0u; mine = 0u;
#pragma unroll
        for (unsigned j = 0; j < 16; ++j) { const unsigned c = xb_ld(&bar[XB_XCNT(j)]); sum += c; cnt += (c > 0u) ? 1u : 0u; mine = (j == x) ? c : mine; }
        if (sum == G) break;
        __builtin_amdgcn_s_sleep(1);
        if ((++sp & 255u) == 0u) { if (xb_ld(&bar[XB_TMO])) break; if (sp > XB_SPIN_CAP) { atomicAdd(&bar[XB_TMO], 1u); break; } }
    }
    nloc = mine > 0u ? mine : 1u; nx = cnt > 0u ? cnt : 1u;
}

__device__ __forceinline__ void xcd_barrier(const XcdBarrier& b) {
    asm volatile("s_waitcnt vmcnt(0)" ::: "memory");
    __syncthreads();
    if (threadIdx.x == 0) {
        unsigned* bar = b.bar;
        __builtin_amdgcn_s_waitcnt(0);
        unsigned nloc = b.st[0], nx = b.st[1];
        if (nloc == 0u) { xcd_barrier_complete(bar, b.x, nloc, nx); b.st[0] = nloc; b.st[1] = nx; }
        const unsigned old = xb_add(&bar[XB_XSUB(b.x)], 1u);
        const unsigned gen = old / nloc;
        if (old + 1u == (gen + 1u) * nloc) {
            __builtin_amdgcn_fence(__ATOMIC_RELEASE, "agent");
            asm volatile("s_waitcnt vmcnt(0)" ::: "memory");
            const unsigned og = xb_add(&bar[XB_TOP], 1u);
            const unsigned tg = og / nx;
            if (og + 1u == (tg + 1u) * nx) xb_add(&bar[XB_TOPGEN], 1u);
            else XB_SPIN(xb_ld(&bar[XB_TOPGEN]) == tg, bar);
            __builtin_amdgcn_fence(__ATOMIC_ACQUIRE, "agent");
            xb_add(&bar[XB_XGEN(b.x)], 1u);
            asm volatile("s_waitcnt vmcnt(0)" ::: "memory");
        } else {
            XB_SPIN(xb_ld(&bar[XB_XGEN(b.x)]) == gen, bar);
            __builtin_amdgcn_fence(__ATOMIC_ACQUIRE, "agent");
            asm volatile("s_waitcnt vmcnt(0)" ::: "memory");
        }
    }
    __syncthreads();
}

struct Frame {
    LAS unsigned char* lds;
    volatile LAS unsigned* MISC;
    gu32* ctl;
    int tid, lane, wave;
    int vcu, G;
};
__device__ __forceinline__ float wave_sum(float v) {
#pragma unroll
    for (int o = 1; o < 64; o <<= 1) v += __shfl_xor(v, o);
    return v;
}
__device__ __forceinline__ float wave_max(float v) {
#pragma unroll
    for (int o = 1; o < 64; o <<= 1) v = fmaxf(v, __shfl_xor(v, o));
    return v;
}
__device__ __forceinline__ float bf_lo(unsigned w) { return __uint_as_float(w << 16); }
__device__ __forceinline__ float bf_hi(unsigned w) { return __uint_as_float(w & 0xffff0000u); }
__device__ __forceinline__ float bf2f(bf16 h) { return __uint_as_float((unsigned)h << 16); }

__device__ __forceinline__ void p0_transpose_item(const float* W, int K, int N, bf16* WT, int row_off, LAS float* scr, int item, int lane) {
    const int nblk = N / 32, kb = item / nblk, nb = item % nblk, k0 = 64 * kb, n0 = 32 * nb;
#pragma unroll 8
    for (int i = 0; i < 32; ++i) { const int kk = 2 * i + (lane >> 5); scr[kk * 33 + (lane & 31)] = W[(size_t)(k0 + kk) * N + n0 + (lane & 31)]; }
    LDS_WAIT(); asm volatile("" ::: "memory");
    const int c = lane & 7;
#pragma unroll
    for (int j = 0; j < 4; ++j) { const int n = (lane >> 3) + 8 * j; const LAS float* s = scr + (8 * c) * 33 + n;
        v4u o; o.x = pk2(s[0 * 33], s[1 * 33]); o.y = pk2(s[2 * 33], s[3 * 33]); o.z = pk2(s[4 * 33], s[5 * 33]); o.w = pk2(s[6 * 33], s[7 * 33]);
        *(GAS v4u*)(WT + (size_t)(row_off + n0 + n) * K + k0 + 8 * c) = o; }
    LDS_WAIT(); asm volatile("" ::: "memory");
}
__device__ __forceinline__ unsigned pk4_fp8(float a, float b, float c, float d) { unsigned w = 0u; w = __builtin_amdgcn_cvt_pk_fp8_f32(a, b, w, false); w = __builtin_amdgcn_cvt_pk_fp8_f32(c, d, w, true); return w; }
__device__ __forceinline__ void p0_transpose_item_f8(const float* W, int K, int N, unsigned char* WT, int row_off, float scale, LAS unsigned char* scr, int item, int lane) {
    const int nblk = N / 32, kb = item / nblk, nb = item % nblk, k0 = 128 * kb, n0 = 32 * nb;
#pragma unroll 8
    for (int i = 0; i < 64; ++i) { const int kk = 2 * i + (lane >> 5); const float v = W[(size_t)(k0 + kk) * N + n0 + (lane & 31)] * scale;
        scr[(lane & 31) * 144 + kk] = (unsigned char)(__builtin_amdgcn_cvt_pk_fp8_f32(v, 0.f, 0u, false) & 0xffu); }
    LDS_WAIT(); asm volatile("" ::: "memory");
    const int c = lane & 7;
#pragma unroll
    for (int j = 0; j < 4; ++j) { const int n = (lane >> 3) + 8 * j; const v4u o = *(const LAS v4u*)(scr + n * 144 + 16 * c);
        *(GAS v4u*)(WT + (size_t)(row_off + n0 + n) * K + k0 + 16 * c) = o; }
    LDS_WAIT(); asm volatile("" ::: "memory");
}
__device__ __forceinline__ int up_row(int j) { const int v = j >= DFF, jj = v ? j - DFF : j; return (jj >> 7) * 256 + v * 128 + (jj & 127); }
__device__ __forceinline__ void rms_row_to_bf16(int lane, const float* xrow, const float* g, bf16* orow) {
    const GAS f32x4* xr = (const GAS f32x4*)xrow + lane; const GAS f32x4* gr = (const GAS f32x4*)g + lane;
    f32x4 v[8]; float s = 0.f;
#pragma unroll
    for (int j = 0; j < 8; ++j) { v[j] = xr[64 * j]; s += (v[j].x * v[j].x + v[j].y * v[j].y) + (v[j].z * v[j].z + v[j].w * v[j].w); }
    const float rstd = 1.0f / sqrtf(wave_sum(s) * (1.f / DM) + RMS_EPS);
    GAS unsigned long long* o8 = (GAS unsigned long long*)orow + lane;
#pragma unroll
    for (int j = 0; j < 8; ++j) { const f32x4 gg = gr[64 * j]; const f32x4 o = v[j] * rstd * gg;
        o8[64 * j] = (unsigned long long)pk2(o.x, o.y) | ((unsigned long long)pk2(o.z, o.w) << 32); }
}
__device__ __forceinline__ void rms_row1024_bf16(int lane, const bf16* irow, const float* g, bf16* orow) {
    float v[16]; float s = 0.f;
#pragma unroll
    for (int j = 0; j < 2; ++j) { const v4u w = *((const GAS v4u*)irow + lane + 64 * j);
        v[8 * j + 0] = bf_lo(w.x); v[8 * j + 1] = bf_hi(w.x); v[8 * j + 2] = bf_lo(w.y); v[8 * j + 3] = bf_hi(w.y);
        v[8 * j + 4] = bf_lo(w.z); v[8 * j + 5] = bf_hi(w.z); v[8 * j + 6] = bf_lo(w.w); v[8 * j + 7] = bf_hi(w.w); }
#pragma unroll
    for (int k = 0; k < 16; ++k) s += v[k] * v[k];
    const float rstd = 1.0f / sqrtf(wave_sum(s) * (1.f / 1024.f) + RMS_EPS);
#pragma unroll
    for (int j = 0; j < 2; ++j) { const f32x4 g0 = *((const GAS f32x4*)g + 2 * (lane + 64 * j)), g1 = *((const GAS f32x4*)g + 2 * (lane + 64 * j) + 1);
        v4u o; o.x = pk2(v[8 * j + 0] * rstd * g0.x, v[8 * j + 1] * rstd * g0.y); o.y = pk2(v[8 * j + 2] * rstd * g0.z, v[8 * j + 3] * rstd * g0.w);
        o.z = pk2(v[8 * j + 4] * rstd * g1.x, v[8 * j + 5] * rstd * g1.y); o.w = pk2(v[8 * j + 6] * rstd * g1.z, v[8 * j + 7] * rstd * g1.w);
        *((GAS v4u*)orow + lane + 64 * j) = o; }
}
__device__ __forceinline__ int t5_bucket(int dist) {
    if (dist < 16) return dist;
    const float lr = logf((float)dist / 16.0f) / logf(8.0f) * 16.0f;
    int b = 16 + (int)lr; return b < 31 ? b : 31;
}
__device__ __forceinline__ float gelu_tanh(float y) {
    const float u = 0.7978845608028654f * (y + 0.044715f * y * y * y);
    const float e = __builtin_amdgcn_exp2f(2.0f * LOG2E * u);
    const float th = 1.0f - 2.0f * __builtin_amdgcn_rcpf(e + 1.0f);
    return 0.5f * y * (1.0f + th);
}

struct Args { const float* in[23]; float* out; unsigned char* ws; int ph_lo, ph_hi, li, pad; };
__global__ void __launch_bounds__(NWAVES * 64, 2) skel_fwd(Args args) {
    extern __shared__ __attribute__((aligned(16))) unsigned char lds[];
    Frame F;
    F.lds = (LAS unsigned char*)lds;
    F.MISC = (volatile LAS unsigned*)(F.lds + MISC_OFF);
    F.tid = threadIdx.x; F.lane = F.tid & 63; F.wave = __builtin_amdgcn_readfirstlane(F.tid >> 6);
    F.G = gridDim.x; { const int bx = blockIdx.x; F.vcu = (F.G % 8 == 0) ? (bx % 8) * (F.G / 8) + bx / 8 : bx; }
    unsigned char* ws = args.ws;
    F.ctl = (gu32*)(ws + WS_CTL);
    const float* x = args.in[0]; const float* norm_mix = args.in[1]; const float* w_in = args.in[2]; const float* rel_bias = args.in[3];
    const float* lam_re = args.in[4]; const float* lam_im = args.in[5]; const float* log_dt = args.in[6];
    const float* b_re = args.in[7]; const float* b_im = args.in[8]; const float* c_re = args.in[9]; const float* c_im = args.in[10]; const float* d_skip = args.in[11];
    const float* w_glu = args.in[12]; const float* b_glu = args.in[13]; const float* norm_attn = args.in[14]; const float* norm_ssm = args.in[15];
    const float* w_out = args.in[16]; const float* norm_ffn = args.in[17]; const float* w_up = args.in[18]; const float* conv_w = args.in[19]; const float* conv_b = args.in[20];
    const float* w_down = args.in[21]; const float* norm_final = args.in[22];
    float* out = args.out;
    bf16* Wt_in = (bf16*)(ws + WS_WIN); bf16* Wt_glu = (bf16*)(ws + WS_WGLU); bf16* Wt_out = (bf16*)(ws + WS_WOUT); unsigned char* Wt_up = (unsigned char*)(ws + WS_WUP); unsigned char* Wt_down = (unsigned char*)(ws + WS_WDOWN);
    bf16* XN = (bf16*)(ws + WS_XN); bf16* QB = (bf16*)(ws + WS_Q); bf16* KB = (bf16*)(ws + WS_K); bf16* VB = (bf16*)(ws + WS_V);
    bf16* YB = (bf16*)(ws + WS_Y); bf16* ZB = (bf16*)(ws + WS_Z); unsigned char* X1G = (unsigned char*)(ws + WS_X1G); unsigned char* ACT = (unsigned char*)(ws + WS_ACT);
    float* SSQ = (float*)(ws + WS_SSQ); float* KMEAN = (float*)(ws + WS_KMEAN); float* T5B = (float*)(ws + WS_T5B);
    bf16* A2 = (bf16*)(ws + WS_A2); float* SBUF = (float*)(ws + WS_S); bf16* BTS = (bf16*)(ws + WS_BTS); bf16* BT2 = (bf16*)(ws + WS_BT2);

    for (int u = F.tid; u < (LDS_BYTES - LDSCTL_OFF) / 4; u += NWAVES * 64) ((LAS unsigned*)(F.lds + LDSCTL_OFF))[u] = 0u;
    __syncthreads();
    XcdBarrier bar; bar.bar = (unsigned*)(F.ctl + CW_BAR); bar.x = 0; bar.st = nullptr;
    if (N_LAUNCHES == 1) bar = xcd_barrier_post((unsigned*)(F.ctl + CW_BAR), F.MISC + 8);
#define GRID_BAR() do { if (N_LAUNCHES == 1) xcd_barrier(bar); } while (0)
    const int lo = args.ph_lo, hi = args.ph_hi;
#define IN(k) (lo <= (k) && (k) < hi)
#define BOTH(k) (IN(k) && IN((k) + 1))
    const int gw = F.vcu * NWAVES + F.wave, NGW = F.G * NWAVES;
    const int gt = gw * 64 + F.lane, NGT = NGW * 64;

    if (IN(0)) {
        {
            LAS float* L = (LAS float*)(F.lds + RING_OFF);
            LAS float* pwr = L; LAS float* pwi = pwr + 33 * 65; LAS float* bbr = pwi + 33 * 65; LAS float* bbi = bbr + 1024;
            LAS float* ccr = bbi + 1024; LAS float* cci = ccr + 16 * 65; LAS float* dsk = cci + 16 * 65; LAS float* Kd = dsk + 16;
            for (int it = blockIdx.x; it < SG * 4; it += F.G) {
                const int g = it >> 2, q = it & 3;
                __syncthreads();
                const float dt = expf(log_dt[g]);
                for (int i = F.tid; i < 33 * 64; i += NWAVES * 64) { const int d = i >> 6, p = i & 63; const float lr = lam_re[g * SP + p], li = lam_im[g * SP + p];
                    const float mag = expf(lr * dt * (float)d), ang = li * dt * (float)d; pwr[d * 65 + p] = mag * cosf(ang); pwi[d * 65 + p] = mag * sinf(ang); }
                for (int i = F.tid; i < 64 * 16; i += NWAVES * 64) { const int p = i >> 4; const float lr = lam_re[g * SP + p], li = lam_im[g * SP + p];
                    const float er = expf(lr * dt), lbr = er * cosf(li * dt), lbi = er * sinf(li * dt);
                    const float nr = lbr - 1.0f, ni = lbi, den = lr * lr + li * li, cr_ = (nr * lr + ni * li) / den, ci_ = (ni * lr - nr * li) / den;
                    const float bre = b_re[(size_t)(g * SP) * SC + i], bim = b_im[(size_t)(g * SP) * SC + i];
                    bbr[i] = cr_ * bre - ci_ * bim; bbi[i] = cr_ * bim + ci_ * bre; }
                for (int i = F.tid; i < 16 * 64; i += NWAVES * 64) { const int h = i >> 6, p = i & 63; ccr[h * 65 + p] = c_re[(size_t)(g * SC) * SP + i]; cci[h * 65 + p] = c_im[(size_t)(g * SC) * SP + i]; }
                if (F.tid < 16) dsk[F.tid] = d_skip[g * SC + F.tid];
                __syncthreads();
                {
                    const int d = F.tid >> 4, h = F.tid & 15; float a16[16];
#pragma unroll
                    for (int e = 0; e < 16; ++e) a16[e] = 0.f;
                    for (int p = 0; p < 64; ++p) { const float cr = ccr[h * 65 + p], ci = cci[h * 65 + p], pr = pwr[d * 65 + p], pi = pwi[d * 65 + p];
                        const float ar = cr * pr - ci * pi, ai_ = cr * pi + ci * pr;
#pragma unroll
                        for (int e = 0; e < 16; ++e) a16[e] += ar * bbr[p * 16 + e] - ai_ * bbi[p * 16 + e]; }
                    const float dd = dsk[h];
#pragma unroll
                    for (int e = 0; e < 16; ++e) Kd[(d * 16 + h) * 16 + e] = a16[e] + ((d == 0 && e == h) ? dd : 0.f);
                }
                __syncthreads();
                for (int i = F.tid; i < 128 * 80; i += NWAVES * 64) {
                    const int rl = i / 80, k8 = i - rl * 80, n = q * 128 + rl, t = n >> 4, h = n & 15; float v[8];
                    if (k8 < 64) { const int s = k8 >> 1, h0 = (k8 & 1) * 8;
                        if (s <= t) { const LAS float* kp = Kd + ((t - s) * 16 + h) * 16 + h0;
#pragma unroll
                            for (int e = 0; e < 8; ++e) v[e] = kp[e]; }
                        else {
#pragma unroll
                            for (int e = 0; e < 8; ++e) v[e] = 0.f; } }
                    else { const int j0 = (k8 - 64) * 8, p0 = j0 & 63; const bool im = j0 >= 64;
#pragma unroll
                        for (int e = 0; e < 8; ++e) { const int p = p0 + e; const float cr = ccr[h * 65 + p], ci = cci[h * 65 + p], pr = pwr[(t + 1) * 65 + p], pi = pwi[(t + 1) * 65 + p];
                            v[e] = im ? -(cr * pi + ci * pr) : (cr * pr - ci * pi); } }
                    v4u o; o.x = pk2(v[0], v[1]); o.y = pk2(v[2], v[3]); o.z = pk2(v[4], v[5]); o.w = pk2(v[6], v[7]);
                    *(GAS v4u*)(BT2 + ((size_t)(g * 512 + n)) * 640 + k8 * 8) = o;
                }
                for (int i = F.tid; i < 64 * 64; i += NWAVES * 64) {
                    const int rl = i >> 6, k8 = i & 63, j = q * 64 + rl; float v[8];
                    if (j < 128) { const int p = j & 63, s = k8 >> 1, h0 = (k8 & 1) * 8; const bool im = j >= 64; const float pr = pwr[(31 - s) * 65 + p], pi = pwi[(31 - s) * 65 + p];
#pragma unroll
                        for (int e = 0; e < 8; ++e) { const float br = bbr[p * 16 + h0 + e], bi = bbi[p * 16 + h0 + e]; v[e] = im ? (pr * bi + pi * br) : (pr * br - pi * bi); } }
                    else {
#pragma unroll
                        for (int e = 0; e < 8; ++e) v[e] = 0.f; }
                    v4u o; o.x = pk2(v[0], v[1]); o.y = pk2(v[2], v[3]); o.z = pk2(v[4], v[5]); o.w = pk2(v[6], v[7]);
                    *(GAS v4u*)(BTS + ((size_t)(g * 256 + j)) * 512 + k8 * 8) = o;
                }
            }
            __syncthreads();
        }
        LAS float* scr = (LAS float*)(F.lds + RING_OFF + F.wave * 16384);
        constexpr int I_IN = (DM / 64) * (INC / 32), I_GLU = (SW / 64) * (SW / 32), I_OUT = (DM / 64) * (DM / 32), I_UP = (DM / (F8_UP ? 128 : 64)) * (DFF2 / 32), I_DN = (DFF / (F8_DN ? 128 : 64)) * (DM / 32);
        constexpr int NITEMS = I_IN + I_GLU + I_OUT + I_UP + I_DN;
        for (int it = gw; it < NITEMS; it += NGW) {
            int r = it;
            if (r < I_IN) { p0_transpose_item(w_in, DM, INC, Wt_in, 0, scr, r, F.lane); continue; } r -= I_IN;
            if (r < I_GLU) { p0_transpose_item(w_glu, SW, SW, Wt_glu, 0, scr, r, F.lane); continue; } r -= I_GLU;
            if (r < I_OUT) { p0_transpose_item(w_out, DM, DM, Wt_out, 0, scr, r, F.lane); continue; } r -= I_OUT;
            if (r < I_UP) { const int n0 = 32 * (r % (DFF2 / 32)), ro = up_row(n0) - n0;
                if (F8_UP) p0_transpose_item_f8(w_up, DM, DFF2, Wt_up, ro, WSCALE, (LAS unsigned char*)scr, r, F.lane); else p0_transpose_item(w_up, DM, DFF2, (bf16*)Wt_up, ro, scr, r, F.lane); continue; } r -= I_UP;
            if (F8_DN) p0_transpose_item_f8(w_down, DFF, DM, Wt_down, 0, WSCALE, (LAS unsigned char*)scr, r, F.lane); else p0_transpose_item(w_down, DFF, DM, (bf16*)Wt_down, 0, scr, r, F.lane);
        }
        for (int m = gw; m < M; m += NGW) rms_row_to_bf16(F.lane, x + (size_t)m * DM, norm_mix, XN + (size_t)m * DM);
        for (int i = gt; i < AH * 512; i += NGT) { const int h = i >> 9, d = i & 511; T5B[i] = LOG2E * rel_bias[t5_bucket(d) * AH + h]; }
        if (BOTH(0)) GRID_BAR();
    }

    if (IN(1)) {
        pg8::Gemm g{XN, Wt_in, M, INC, DM}; pg8::StaticOrder S; S.init(M, INC, F.G, (int)blockIdx.x);
        pg8::EpiQKVU E{QB, (size_t)(WS_K - WS_Q) / 2, A2, C2};
        pg8::gemm_phase<pg8::EpiQKVU, pg8::StaticOrder, PG8_ALIGN, PG8_SP2>(F.lds + RING_OFF, g, S, E);
        if (BOTH(1)) GRID_BAR();
    }

    if (IN(2)) {
        for (int it = gw; it < BATCH * AH * NBLK; it += NGW) {
            const int n = it % NBLK, h = (it / NBLK) % AH, b = it / (NBLK * AH);
            const bf16* kp = KB + ((size_t)(b * SEQ + n * MOBA_BLK + (F.lane >> 3))) * AW + h * HD + (F.lane & 7) * 8;
            float a[8];
#pragma unroll
            for (int k = 0; k < 8; ++k) a[k] = 0.f;
            for (int i = 0; i < 32; ++i) { const v4u w = *(const GAS v4u*)(kp + (size_t)i * 8 * AW);
                a[0] += bf_lo(w.x); a[1] += bf_hi(w.x); a[2] += bf_lo(w.y); a[3] += bf_hi(w.y); a[4] += bf_lo(w.z); a[5] += bf_hi(w.z); a[6] += bf_lo(w.w); a[7] += bf_hi(w.w); }
#pragma unroll
            for (int k = 0; k < 8; ++k) { a[k] += __shfl_xor(a[k], 8); a[k] += __shfl_xor(a[k], 16); a[k] += __shfl_xor(a[k], 32); }
            if (F.lane < 8) { float* o = KMEAN + (size_t)it * HD + F.lane * 8;
#pragma unroll
                for (int k = 0; k < 8; ++k) o[k] = a[k] * (1.0f / MOBA_BLK); }
        }
#if SSM_FAST
        if ((int)blockIdx.x < SG) { const int g = blockIdx.x;
            { pg8::Gemm g1{A2, BTS, 0, 0, 512, 640, 512}; pg8::GroupOrder S1{g, 1, g}; pg8::EpiS E1{SBUF};
              pg8::gemm_phase<pg8::EpiS, pg8::GroupOrder, false, PG8_SP2>(F.lds + RING_OFF, g1, S1, E1); }
            VM_WAIT(); __syncthreads();
            if (F.tid < 128) { const int b = F.tid >> 6, p = F.tid & 63;
                const float lr = lam_re[g * SP + p], li = lam_im[g * SP + p], dt = expf(log_dt[g]);
                const float mag = expf(lr * dt * 32.0f), ang = li * dt * 32.0f, l32r = mag * cosf(ang), l32i = mag * sinf(ang);
                float xr = 0.f, xi = 0.f;
                const unsigned* sp = (const unsigned*)(SBUF + ((size_t)g * 256 + b * 128) * 128 + p);
                bf16* xp = A2 + ((size_t)(g * 256 + b * 128)) * 640 + 512 + p;
                for (int c0 = 0; c0 < 128; c0 += 8) { float sr[8], si[8];
#pragma unroll
                    for (int k = 0; k < 8; ++k) { sr[k] = __uint_as_float(__hip_atomic_load(sp + (size_t)(c0 + k) * 128, __ATOMIC_RELAXED, __HIP_MEMORY_SCOPE_AGENT));
                                                  si[k] = __uint_as_float(__hip_atomic_load(sp + (size_t)(c0 + k) * 128 + 64, __ATOMIC_RELAXED, __HIP_MEMORY_SCOPE_AGENT)); }
#pragma unroll
                    for (int k = 0; k < 8; ++k) { xp[(size_t)(c0 + k) * 640] = (bf16)f2bf(xr); xp[(size_t)(c0 + k) * 640 + 64] = (bf16)f2bf(xi);
                        const float nxr = l32r * xr - l32i * xi + sr[k], nxi = l32r * xi + l32i * xr + si[k]; xr = nxr; xi = nxi; } }
            }
            VM_WAIT(); __syncthreads();
            { pg8::Gemm g2{A2, BT2, 0, 0, 640, 640, 640}; pg8::GroupOrder S2{g, 2, 2 * g}; pg8::EpiY E2{YB};
              pg8::gemm_phase<pg8::EpiY, pg8::GroupOrder, PG8_ALIGN, PG8_SP2>(F.lds + RING_OFF, g2, S2, E2); }
        }
#else
        for (int it = gw; it < BATCH * SG; it += NGW) {
            const int g = it % SG, b = it / SG, p = F.lane;
            const float lr = lam_re[g * SP + p], li = lam_im[g * SP + p], dt = expf(log_dt[g]);
            const float er = expf(lr * dt), lbr = er * cosf(li * dt), lbi = er * sinf(li * dt);
            const float nr = lbr - 1.0f, ni = lbi, den = lr * lr + li * li;
            const float cr_ = (nr * lr + ni * li) / den, ci_ = (ni * lr - nr * li) / den;
            float bbr[16], bbi[16], ccr[16], cci[16];
#pragma unroll
            for (int h = 0; h < 16; ++h) { const float bre = b_re[(size_t)(g * SP + p) * SC + h], bim = b_im[(size_t)(g * SP + p) * SC + h];
                bbr[h] = cr_ * bre - ci_ * bim; bbi[h] = cr_ * bim + ci_ * bre;
                ccr[h] = c_re[(size_t)(g * SC + h) * SP + p]; cci[h] = c_im[(size_t)(g * SC + h) * SP + p]; }
            const float dsk = d_skip[g * SC + (F.lane & 15)];
            float xr = 0.f, xi = 0.f;
            const bf16* up = A2 + (size_t)(g * 256 + b * 128) * 640;
            v4u n0 = *(const GAS v4u*)(up), n1 = *(const GAS v4u*)(up + 8);
            for (int t = 0; t < SEQ; ++t) {
                const v4u c0 = n0, c1 = n1;
                if (t + 1 < SEQ) { const bf16* un = up + (size_t)((t + 1) >> 5) * 640 + ((t + 1) & 31) * 16; n0 = *(const GAS v4u*)(un); n1 = *(const GAS v4u*)(un + 8); }
                float uf[16];
                uf[0] = bf_lo(c0.x); uf[1] = bf_hi(c0.x); uf[2] = bf_lo(c0.y); uf[3] = bf_hi(c0.y); uf[4] = bf_lo(c0.z); uf[5] = bf_hi(c0.z); uf[6] = bf_lo(c0.w); uf[7] = bf_hi(c0.w);
                uf[8] = bf_lo(c1.x); uf[9] = bf_hi(c1.x); uf[10] = bf_lo(c1.y); uf[11] = bf_hi(c1.y); uf[12] = bf_lo(c1.z); uf[13] = bf_hi(c1.z); uf[14] = bf_lo(c1.w); uf[15] = bf_hi(c1.w);
                float bur = 0.f, bui = 0.f;
#pragma unroll
                for (int h = 0; h < 16; ++h) { bur += uf[h] * bbr[h]; bui += uf[h] * bbi[h]; }
                const float nxr = lbr * xr - lbi * xi + bur, nxi = lbr * xi + lbi * xr + bui; xr = nxr; xi = nxi;
                float yv = 0.f;
#pragma unroll
                for (int h = 0; h < 16; ++h) { const float v = wave_sum(xr * ccr[h] - xi * cci[h]); if (F.lane == h) yv = v + dsk * uf[h]; }
                if (F.lane < 16) YB[(size_t)(b * SEQ + t) * SW + g * SC + F.lane] = (bf16)f2bf(gelu_tanh(yv));
            }
        }
#endif
        if (BOTH(2)) GRID_BAR();
    }

    if (IN(3)) {
        static_assert(attn_body::ATTN_LDS_BYTES <= RING_BYTES && attn_body::ATTN_PITCH == AW, "attention body geometry vs frame");
        const attn_body::AttnTensors AT{(const attn_body::bf16*)QB, (const attn_body::bf16*)KB, (const attn_body::bf16*)VB, (attn_body::bf16*)QB, KMEAN, T5B};
        const attn_body::StaticOrder S((int)F.G, (int)blockIdx.x);
        attn_body::attn_phase<attn_body::StaticOrder>((char*)lds + RING_OFF, AT, S);
        if (BOTH(3)) GRID_BAR();
    }

    if (IN(4)) {
        pg8::Gemm g{YB, Wt_glu, M, SW, SW}; pg8::StaticOrder S; S.init(M, SW, F.G, (int)blockIdx.x);
        pg8::EpiGlu E{YB, ZB, SW, b_glu};
        pg8::gemm_phase<pg8::EpiGlu, pg8::StaticOrder, PG8_ALIGN, PG8_SP2>(F.lds + RING_OFF, g, S, E);
        if (BOTH(4)) GRID_BAR();
    }

    if (IN(5)) {
        for (int m = gw; m < M; m += NGW) {
            rms_row1024_bf16(F.lane, QB + (size_t)m * AW, norm_attn, XN + (size_t)m * DM);
            rms_row1024_bf16(F.lane, ZB + (size_t)m * SW, norm_ssm, XN + (size_t)m * DM + AW);
        }
        if (BOTH(5)) GRID_BAR();
    }

    if (IN(6)) {
        pg8::Gemm g{XN, Wt_out, M, DM, DM}; pg8::PairOrder S; S.init(M, DM, F.G, (int)blockIdx.x);
        pg8::EpiResid1<F8_UP> E{x, out, X1G, norm_ffn, SSQ, DM};
        pg8::gemm_phase<pg8::EpiResid1<F8_UP>, pg8::PairOrder, PG8_ALIGN, PG8_SP2>(F.lds + RING_OFF, g, S, E);
        if (BOTH(6)) GRID_BAR();
    }

    if (IN(7)) {
        pg8::Gemm g{(const bf16*)X1G, (const bf16*)Wt_up, 0, 0, F8_UP ? DM / 2 : DM, 0, 0}; pg8::UpOrder S; S.init_up(F.G, (int)blockIdx.x);
        pg8::EpiConv<F8_DN> E{ACT, SSQ, conv_w, conv_b, (LAS float*)(F.lds + XL_OFF), 1.0f / DM, RMS_EPS, F8_UP ? 1.0f / WSCALE : 1.0f};
        pg8::gemm_phase<pg8::EpiConv<F8_DN>, pg8::UpOrder, true, PG8_SP2, F8_UP>(F.lds + RING_OFF, g, S, E);
        if (BOTH(7)) GRID_BAR();
    }


    if (IN(9)) {
        pg8::Gemm g{(const bf16*)ACT, (const bf16*)Wt_down, M, DM, F8_DN ? DFF / 2 : DFF, 0, 0}; pg8::StaticOrder S; S.init(M, DM, F.G, (int)blockIdx.x);
        pg8::EpiResid2 E{out, DM, F8_DN ? 1.0f / WSCALE : 1.0f};
        pg8::gemm_phase<pg8::EpiResid2, pg8::StaticOrder, PG8_ALIGN, PG8_SP2, F8_DN>(F.lds + RING_OFF, g, S, E);
        if (BOTH(9)) GRID_BAR();
    }

    if (IN(10)) {
        for (int m = gw; m < M; m += NGW) {
            GAS f32x4* xr = (GAS f32x4*)(out + (size_t)m * DM) + F.lane; const GAS f32x4* gr = (const GAS f32x4*)norm_final + F.lane;
            f32x4 v[8]; float s = 0.f;
#pragma unroll
            for (int j = 0; j < 8; ++j) { v[j] = xr[64 * j]; s += (v[j].x * v[j].x + v[j].y * v[j].y) + (v[j].z * v[j].z + v[j].w * v[j].w); }
            const float rstd = 1.0f / sqrtf(wave_sum(s) * (1.f / DM) + RMS_EPS);
#pragma unroll
            for (int j = 0; j < 8; ++j) xr[64 * j] = v[j] * rstd * gr[64 * j];
        }
    }
#undef IN
#undef BOTH
}

extern "C" void kernel_launch(void* const* d_in, const int* in_sizes, int n_in, void* d_out, int out_size, void* d_ws, size_t ws_size, hipStream_t stream) {
    static int grid = 0;
    if (grid == 0) {
        if (n_in != 23 || in_sizes[0] != M * DM || out_size != M * DM || ws_size < WS_END) { fprintf(stderr, "kernel_launch: unexpected shapes: n_in %d in0 %d out %d ws %zu (need %zu); nothing launched\n", n_in, n_in > 0 ? in_sizes[0] : -1, out_size, ws_size, (size_t)WS_END); grid = -1; return; }
        int dev = 0, cus = 0, per_cu = 0;
        if (hipGetDevice(&dev) != hipSuccess || hipDeviceGetAttribute(&cus, hipDeviceAttributeMultiprocessorCount, dev) != hipSuccess) { fprintf(stderr, "kernel_launch: device query failed\n"); grid = -1; return; }
        if (hipFuncSetAttribute((const void*)skel_fwd, hipFuncAttributeMaxDynamicSharedMemorySize, LDS_BYTES) != hipSuccess) { fprintf(stderr, "kernel_launch: hipFuncSetAttribute failed\n"); grid = -1; return; }
        if (hipOccupancyMaxActiveBlocksPerMultiprocessor(&per_cu, (const void*)skel_fwd, NWAVES * 64, LDS_BYTES) != hipSuccess || per_cu < 1)
            fprintf(stderr, "kernel_launch: note: occupancy query reports %d workgroups per CU\n", per_cu);
        (void)hipGetLastError();
        grid = cus;
        if (grid < SG) { fprintf(stderr, "kernel_launch: needs >= %d CUs\n", SG); grid = -1; return; }
    }
    if (grid < 0) return;
    if (hipMemsetAsync((char*)d_ws + WS_CTL, 0, CTL_ZERO_BYTES, stream) != hipSuccess) { fprintf(stderr, "kernel_launch: hipMemsetAsync failed\n"); return; }
    Args a{};
    for (int i = 0; i < 23; ++i) a.in[i] = (const float*)d_in[i];
    a.out = (float*)d_out; a.ws = (unsigned char*)d_ws;
    for (int li = 0; li < N_LAUNCHES; ++li) {
        a.ph_lo = (N_LAUNCHES == 1) ? 0 : li; a.ph_hi = (N_LAUNCHES == 1) ? NPH : li + 1; a.li = li;
        hipLaunchKernelGGL(skel_fwd, dim3(grid), dim3(NWAVES * 64), LDS_BYTES, stream, a);
        const hipError_t le = hipPeekAtLastError();
        if (le != hipSuccess) { fprintf(stderr, "kernel_launch: launch %d failed: %s\n", li, hipGetErrorName(le)); break; }
    }
}
```
